# Optimizing an MI355X kernel written in HIP

```python
import jax
import jax.numpy as jnp
from jax import lax
import numpy as np

D_MODEL = 2048
BATCH = 4
SEQ = 2048
DEPTH = 4

CHUNK = 64
QBLOCK = 128
ROPE_BASE = 10000.0
MAX_POS_OFFSET = 4096
NORM_EPS = 1e-6

RET_HEADS = 8
RET_QK_DIM = 128
RET_V_DIM = 128
RET_WIDTH = RET_HEADS * RET_V_DIM

LRU_WIDTH = 1024
LRU_BLOCKS = 8
LRU_BLOCK_DIM = LRU_WIDTH // LRU_BLOCKS
CONV_WIDTH = 4
LRU_C = 8.0

MLA_HEADS = 8
MLA_NOPE_DIM = 128
MLA_ROPE_DIM = 64
MLA_V_DIM = 128
MLA_Q_LORA = 512
MLA_KV_LORA = 512
MLA_WIDTH = MLA_HEADS * MLA_V_DIM

N_BRANCH = 3
MIX_WIDTH = RET_WIDTH + LRU_WIDTH + MLA_WIDTH
IN_SPLITS = (
    RET_HEADS * RET_QK_DIM,
    RET_HEADS * RET_QK_DIM,
    RET_WIDTH,
    RET_WIDTH,
    LRU_WIDTH,
    LRU_WIDTH,
    MLA_Q_LORA,
    MLA_KV_LORA,
    MLA_ROPE_DIM,
    MLA_WIDTH,
    N_BRANCH * D_MODEL,
)
IN_WIDTH = sum(IN_SPLITS)

kernel_name = 'hybrid_retention_rglru_mla_streaming_block'


def rms_norm(x, gain):
    xf = x.astype(jnp.float32)
    y = xf * lax.rsqrt(jnp.mean(xf * xf, axis=-1, keepdims=True) + NORM_EPS)
    return (y * gain.astype(jnp.float32)).astype(x.dtype)


def rope_tables(positions, dim):
    inv_freq = ROPE_BASE ** (-jnp.arange(0, dim, 2, dtype=jnp.float32) / dim)
    ang = positions.astype(jnp.float32)[:, :, None, None] * inv_freq
    return jnp.cos(ang), jnp.sin(ang)


def apply_rope(x, cos, sin):
    half = x.shape[-1] // 2
    xf = x.astype(jnp.float32)
    x1, x2 = xf[..., :half], xf[..., half:]
    return jnp.concatenate([x1 * cos - x2 * sin, x2 * cos + x1 * sin], axis=-1).astype(x.dtype)


def retention_branch(q, k, v, gate, gn, cos, sin):
    B, S = q.shape[:2]
    NC = S // CHUNK
    q = apply_rope(q.reshape(B, S, RET_HEADS, RET_QK_DIM), cos, sin) * (RET_QK_DIM ** -0.5)
    k = apply_rope(k.reshape(B, S, RET_HEADS, RET_QK_DIM), cos, sin)
    q = q.reshape(B, NC, CHUNK, RET_HEADS, RET_QK_DIM)
    k = k.reshape(B, NC, CHUNK, RET_HEADS, RET_QK_DIM)
    v = v.reshape(B, NC, CHUNK, RET_HEADS, RET_V_DIM)

    log_gamma = jnp.log1p(-jnp.exp2(-5.0 - jnp.arange(RET_HEADS, dtype=jnp.float32)))
    idx = jnp.arange(CHUNK, dtype=jnp.float32)
    intra_decay = jnp.exp(log_gamma[:, None, None] * jnp.abs(idx[:, None] - idx[None, :]))

    scores = jnp.einsum('bnihd,bnjhd->bhnij', q, k) * intra_decay[None, :, None]
    o_intra = jnp.einsum('bhnij,bnjhe->bnihe', scores, v)

    k_dec = k * jnp.exp(log_gamma[None, :] * (CHUNK - 1 - idx)[:, None])[None, None, :, :, None]
    kv_chunk = jnp.einsum('bnjhd,bnjhe->nbhde', k_dec, v)
    chunk_decay = jnp.exp(log_gamma * CHUNK)[None, :, None, None]

    def step(state, kv_n):
        return state * chunk_decay + kv_n, state

    _, prev_state = lax.scan(step, jnp.zeros(kv_chunk.shape[1:], kv_chunk.dtype), kv_chunk)
    q_dec = q * jnp.exp(log_gamma[None, :] * (idx + 1.0)[:, None])[None, None, :, :, None]
    o_inter = jnp.einsum('bnihd,nbhde->bnihe', q_dec, prev_state)

    o = (o_intra + o_inter).reshape(B, S, RET_HEADS, RET_V_DIM).astype(jnp.float32)
    mean = jnp.mean(o, axis=-1, keepdims=True)
    var = jnp.mean(jnp.square(o - mean), axis=-1, keepdims=True)
    o = ((o - mean) * lax.rsqrt(var + NORM_EPS)).reshape(B, S, RET_WIDTH) * gn.astype(jnp.float32)
    return o.astype(gate.dtype) * jax.nn.silu(gate)


def rglru_branch(xb, gate, conv_w, conv_b, wa, ba, wx, bx, lam):
    B, S, W = xb.shape
    xc = lax.conv_general_dilated(
        xb, conv_w[:, None, :].astype(xb.dtype), window_strides=(1,),
        padding=[(CONV_WIDTH - 1, 0)], dimension_numbers=('NWC', 'WIO', 'NWC'),
        feature_group_count=W) + conv_b
    xr = xc.reshape(B, S, LRU_BLOCKS, LRU_BLOCK_DIM)
    r = jax.nn.sigmoid(jnp.einsum('bsnc,ncd->bsnd', xr, wa).reshape(B, S, W) + ba)
    i = jax.nn.sigmoid(jnp.einsum('bsnc,ncd->bsnd', xr, wx).reshape(B, S, W) + bx)
    log_a = -LRU_C * r.astype(jnp.float32) * jax.nn.softplus(-lam.astype(jnp.float32))
    a = jnp.exp(log_a)
    b = jnp.sqrt(-jnp.expm1(2.0 * log_a)) * (i * xc).astype(jnp.float32)

    def combine(left, right):
        a1, b1 = left
        a2, b2 = right
        return a1 * a2, a2 * b1 + b2

    _, h = lax.associative_scan(combine, (a, b), axis=1)
    return h.astype(xb.dtype) * jax.nn.silu(gate)


def mla_branch(q_lat, kv_lat, k_rope, gate, q_norm, w_uq, kv_norm, w_ukv, cos, sin):
    B, S = q_lat.shape[:2]
    q = (rms_norm(q_lat, q_norm) @ w_uq).reshape(B, S, MLA_HEADS, MLA_NOPE_DIM + MLA_ROPE_DIM)
    q_nope = q[..., :MLA_NOPE_DIM]
    q_rope = apply_rope(q[..., MLA_NOPE_DIM:], cos, sin)
    kv = (rms_norm(kv_lat, kv_norm) @ w_ukv).reshape(B, S, MLA_HEADS, MLA_NOPE_DIM + MLA_V_DIM)
    k_nope, v = kv[..., :MLA_NOPE_DIM], kv[..., MLA_NOPE_DIM:]
    k_rope = apply_rope(k_rope[:, :, None, :], cos, sin)[:, :, 0]
    scale = (MLA_NOPE_DIM + MLA_ROPE_DIM) ** -0.5

    outs = []
    for qb in range(S // QBLOCK):
        qs, qe = qb * QBLOCK, (qb + 1) * QBLOCK
        s = (jnp.einsum('bqhd,bkhd->bhqk', q_nope[:, qs:qe], k_nope[:, :qe])
             + jnp.einsum('bqhr,bkr->bhqk', q_rope[:, qs:qe], k_rope[:, :qe]))
        s = s.astype(jnp.float32) * scale
        q_chunk = (qs + jnp.arange(QBLOCK)) // CHUNK
        k_chunk = jnp.arange(qe) // CHUNK
        mask = k_chunk[None, :] <= q_chunk[:, None]
        p = jax.nn.softmax(jnp.where(mask, s, -1e30), axis=-1).astype(v.dtype)
        outs.append(jnp.einsum('bhqk,bkhd->bqhd', p, v[:, :qe]))
    o = jnp.concatenate(outs, axis=1).reshape(B, S, MLA_WIDTH)
    return o * jax.nn.silu(gate)


def hybrid_layer(x, c_act, ada_w, ada_b, norm_pre, norm_post, w_in, ret_gn,
                 lru_conv_w, lru_conv_b, lru_wa, lru_ba, lru_wx, lru_bx, lru_lambda,
                 mla_q_norm, mla_w_uq, mla_kv_norm, mla_w_ukv, w_branch, w_out,
                 cos_ret, sin_ret, cos_mla, sin_mla):
    B, S, _ = x.shape
    mod = c_act @ ada_w + ada_b
    shift, scale, res_gate = jnp.split(mod, 3, axis=-1)
    h = rms_norm(x, norm_pre) * (1.0 + scale[:, None, :]) + shift[:, None, :]

    proj = h @ w_in
    offsets = [int(o) for o in np.cumsum(IN_SPLITS)[:-1]]
    (rq, rk, rv, rg, lx, lg, mq, mkv, mkr, mg, merge_logits) = jnp.split(proj, offsets, axis=-1)

    y_ret = retention_branch(rq, rk, rv, rg, ret_gn, cos_ret, sin_ret)
    y_lru = rglru_branch(lx, lg, lru_conv_w, lru_conv_b, lru_wa, lru_ba, lru_wx, lru_bx, lru_lambda)
    y_mla = mla_branch(mq, mkv, mkr, mg, mla_q_norm, mla_w_uq, mla_kv_norm, mla_w_ukv, cos_mla, sin_mla)

    gates = jax.nn.sigmoid(merge_logits.astype(jnp.float32)).astype(x.dtype).reshape(B, S, N_BRANCH, D_MODEL)
    wb_ret = w_branch[:RET_WIDTH]
    wb_lru = w_branch[RET_WIDTH:RET_WIDTH + LRU_WIDTH]
    wb_mla = w_branch[RET_WIDTH + LRU_WIDTH:]
    merged = (gates[:, :, 0] * (y_ret @ wb_ret)
              + gates[:, :, 1] * (y_lru @ wb_lru)
              + gates[:, :, 2] * (y_mla @ wb_mla))
    y = merged @ w_out
    return x + (1.0 + res_gate[:, None, :]) * rms_norm(y, norm_post)


def setup_inputs(seed: int = 0) -> dict:
    key = jax.random.key(seed)
    ks = jax.random.split(key, 24)
    f32 = jnp.float32

    def nrm(k, shape, s):
        return jax.random.normal(k, shape, f32) * s

    x = nrm(ks[0], (BATCH, SEQ, D_MODEL), 1.0)
    c = nrm(ks[1], (BATCH, D_MODEL), 1.0)
    positions = (jnp.arange(SEQ, dtype=jnp.int32)[None, :]
                 + jax.random.randint(ks[2], (BATCH, 1), 0, MAX_POS_OFFSET, dtype=jnp.int32))
    ada_w = nrm(ks[3], (DEPTH, D_MODEL, 3 * D_MODEL), 0.5 * D_MODEL ** -0.5)
    ada_b = nrm(ks[4], (DEPTH, 3 * D_MODEL), 0.01)
    norm_pre = 1.0 + nrm(ks[5], (DEPTH, D_MODEL), 0.01)
    norm_post = 1.0 + nrm(ks[6], (DEPTH, D_MODEL), 0.01)
    w_in = nrm(ks[7], (DEPTH, D_MODEL, IN_WIDTH), D_MODEL ** -0.5)
    ret_gn = 1.0 + nrm(ks[8], (DEPTH, RET_WIDTH), 0.01)
    lru_conv_w = nrm(ks[9], (DEPTH, CONV_WIDTH, LRU_WIDTH), CONV_WIDTH ** -0.5)
    lru_conv_b = nrm(ks[10], (DEPTH, LRU_WIDTH), 0.01)
    lru_wa = nrm(ks[11], (DEPTH, LRU_BLOCKS, LRU_BLOCK_DIM, LRU_BLOCK_DIM), LRU_BLOCK_DIM ** -0.5)
    lru_ba = nrm(ks[12], (DEPTH, LRU_WIDTH), 0.01)
    lru_wx = nrm(ks[13], (DEPTH, LRU_BLOCKS, LRU_BLOCK_DIM, LRU_BLOCK_DIM), LRU_BLOCK_DIM ** -0.5)
    lru_bx = nrm(ks[14], (DEPTH, LRU_WIDTH), 0.01)
    u = jax.random.uniform(ks[15], (DEPTH, LRU_WIDTH), f32, 0.9, 0.999)
    a0 = u ** (1.0 / LRU_C)
    lru_lambda = jnp.log(a0) - jnp.log1p(-a0)
    mla_q_norm = 1.0 + nrm(ks[16], (DEPTH, MLA_Q_LORA), 0.01)
    mla_w_uq = nrm(ks[17], (DEPTH, MLA_Q_LORA, MLA_HEADS * (MLA_NOPE_DIM + MLA_ROPE_DIM)), MLA_Q_LORA ** -0.5)
    mla_kv_norm = 1.0 + nrm(ks[18], (DEPTH, MLA_KV_LORA), 0.01)
    mla_w_ukv = nrm(ks[19], (DEPTH, MLA_KV_LORA, MLA_HEADS * (MLA_NOPE_DIM + MLA_V_DIM)), MLA_KV_LORA ** -0.5)
    w_branch = nrm(ks[20], (DEPTH, MIX_WIDTH, D_MODEL), (MIX_WIDTH // N_BRANCH) ** -0.5)
    w_out = nrm(ks[21], (DEPTH, D_MODEL, D_MODEL), D_MODEL ** -0.5)
    return {'x': x, 'c': c, 'positions': positions, 'ada_w': ada_w, 'ada_b': ada_b,
            'norm_pre': norm_pre, 'norm_post': norm_post, 'w_in': w_in, 'ret_gn': ret_gn,
            'lru_conv_w': lru_conv_w, 'lru_conv_b': lru_conv_b, 'lru_wa': lru_wa, 'lru_ba': lru_ba,
            'lru_wx': lru_wx, 'lru_bx': lru_bx, 'lru_lambda': lru_lambda,
            'mla_q_norm': mla_q_norm, 'mla_w_uq': mla_w_uq, 'mla_kv_norm': mla_kv_norm,
            'mla_w_ukv': mla_w_ukv, 'w_branch': w_branch, 'w_out': w_out}


def reference(x, c, positions, ada_w, ada_b, norm_pre, norm_post, w_in, ret_gn,
              lru_conv_w, lru_conv_b, lru_wa, lru_ba, lru_wx, lru_bx, lru_lambda,
              mla_q_norm, mla_w_uq, mla_kv_norm, mla_w_ukv, w_branch, w_out):
    c_act = jax.nn.silu(c)
    cos_ret, sin_ret = rope_tables(positions, RET_QK_DIM)
    cos_mla, sin_mla = rope_tables(positions, MLA_ROPE_DIM)
    for l in range(DEPTH):
        x = hybrid_layer(x, c_act, ada_w[l], ada_b[l], norm_pre[l], norm_post[l], w_in[l], ret_gn[l],
                         lru_conv_w[l], lru_conv_b[l], lru_wa[l], lru_ba[l], lru_wx[l], lru_bx[l],
                         lru_lambda[l], mla_q_norm[l], mla_w_uq[l], mla_kv_norm[l], mla_w_ukv[l],
                         w_branch[l], w_out[l], cos_ret, sin_ret, cos_mla, sin_mla)
    return x
```

```cpp
#include <hip/hip_runtime.h>
#include <hip/hip_cooperative_groups.h>
#include <cstdio>
namespace cg = cooperative_groups;

#ifndef MULTI_LAUNCH
#define MULTI_LAUNCH 0
#endif

#ifndef PMASK
#define PMASK 0xff
#endif
#ifndef VAR_NOEPI
#define VAR_NOEPI 0
#endif
#ifndef REPMASK
#define REPMASK 0
#endif
#define LAS __attribute__((address_space(3)))
typedef unsigned short bf16_t;
typedef short bf16x8 __attribute__((ext_vector_type(8)));
typedef float f32x4 __attribute__((ext_vector_type(4)));
typedef float f32x2 __attribute__((ext_vector_type(2)));
typedef unsigned u32x4 __attribute__((ext_vector_type(4)));
typedef unsigned u32x2 __attribute__((ext_vector_type(2)));

constexpr int T = 8192, D = 2048, SEQ = 2048, DEPTH = 4;
constexpr int LDP = 14336;
constexpr int NP1 = 14592;
constexpr int NIN = 14400;
constexpr float EPS = 1e-6f;
constexpr float QSCALE = 0.07216878364870322f * 1.4426950408889634f;
constexpr float RQSCALE = 0.08838834764831845f;

constexpr size_t al256(size_t x) { return (x + 255) & ~(size_t)255; }
constexpr size_t WS_WI = 0;
constexpr size_t WS_WUQ = WS_WI + al256((size_t)DEPTH * NP1 * 2048 * 2);
constexpr size_t WS_WUKV = WS_WUQ + al256((size_t)DEPTH * 1536 * 512 * 2);
constexpr size_t WS_WB = WS_WUKV + al256((size_t)DEPTH * 2048 * 512 * 2);
constexpr size_t WS_WO = WS_WB + al256((size_t)DEPTH * 2048 * 3072 * 2);
constexpr size_t WS_WA = WS_WO + al256((size_t)DEPTH * 2048 * 2048 * 2);
constexpr size_t WS_WX = WS_WA + al256((size_t)DEPTH * 8 * 128 * 128 * 2);
constexpr size_t WS_MOD = WS_WX + al256((size_t)DEPTH * 8 * 128 * 128 * 2);
constexpr size_t WS_COSR = WS_MOD + al256((size_t)DEPTH * 4 * 6144 * 4);
constexpr size_t WS_SINR = WS_COSR + al256((size_t)T * 64 * 4);
constexpr size_t WS_COSM = WS_SINR + al256((size_t)T * 64 * 4);
constexpr size_t WS_SINM = WS_COSM + al256((size_t)T * 32 * 4);
constexpr size_t WS_XCUR = WS_SINM + al256((size_t)T * 32 * 4);
constexpr size_t WS_HBUF = WS_XCUR + al256((size_t)T * D * 4);
constexpr size_t WS_PROJ = WS_HBUF + al256((size_t)T * D * 2);
constexpr size_t WS_KROPE = WS_PROJ + al256((size_t)T * LDP * 2);
constexpr size_t WS_RSQ = WS_KROPE + al256((size_t)T * 64 * 2);
constexpr size_t WS_QM = WS_RSQ + al256((size_t)T * 16 * 4);
constexpr size_t WS_KN = WS_QM + al256((size_t)T * 8 * 192 * 2);
constexpr size_t WS_VT = WS_KN + al256((size_t)T * 8 * 128 * 2);
constexpr size_t WS_TOT = WS_VT + al256((size_t)T * 8 * 128 * 2);
constexpr size_t WS_HLOC = WS_TOT + al256((size_t)4 * 8 * 8 * 16384 * 4);
constexpr size_t WS_ACUM = WS_HLOC + al256((size_t)T * 1024 * 4);
constexpr size_t WS_YCAT = WS_ACUM + al256((size_t)T * 1024 * 4);
constexpr size_t WS_MACC = WS_YCAT + al256((size_t)T * 3072 * 2);
constexpr size_t WS_MERGED = WS_MACC + al256((size_t)T * D * 4);
constexpr size_t WS_YBUF = WS_MERGED + al256((size_t)T * D * 2);
constexpr size_t WS_BAR = WS_YBUF + al256((size_t)T * D * 4);
constexpr size_t WS_LTOT = WS_BAR + al256((size_t)4096 * 4);
constexpr size_t WS_END = WS_LTOT + al256((size_t)2 * 128 * 1024 * 4);

struct Params {
    const float* in[22];
    const int* pos;
    float* out;
    char* ws;
    int ph_lo, ph_hi;
};

typedef const Params __attribute__((address_space(4)))* KP;
__device__ __forceinline__ KP get_kp() { KP k = (KP)__builtin_amdgcn_kernarg_segment_ptr(); asm volatile("" : "+s"(k)); return k; }

__device__ __forceinline__ float bf2f(unsigned h) { return __uint_as_float(h << 16); }
__device__ __forceinline__ bf16_t f2bf(float f) { unsigned u = __float_as_uint(f); return (bf16_t)((u + 0x7fffu + ((u >> 16) & 1u)) >> 16); }
__device__ __forceinline__ unsigned pk2(float lo, float hi) { unsigned r; asm("s_nop 1\n\tv_cvt_pk_bf16_f32 %0, %1, %2" : "=v"(r) : "v"(lo), "v"(hi)); return r; }
__device__ __forceinline__ float blo(unsigned w) { return __uint_as_float(w << 16); }
__device__ __forceinline__ float bhi(unsigned w) { return __uint_as_float(w & 0xffff0000u); }
__device__ __forceinline__ float sigmoidf_(float x) { return __builtin_amdgcn_rcpf(1.0f + __builtin_amdgcn_exp2f(-1.4426950408889634f * x)); }
__device__ __forceinline__ float shx(float v, int lane, int k) { return __int_as_float(__builtin_amdgcn_ds_bpermute((lane ^ k) << 2, __float_as_int(v))); }
__device__ __forceinline__ float dppf(float v, const int ctrl_sel) {
    int r;
    if (ctrl_sel == 0) r = __builtin_amdgcn_update_dpp(0, __float_as_int(v), 0xB1, 0xf, 0xf, true);
    else if (ctrl_sel == 1) r = __builtin_amdgcn_update_dpp(0, __float_as_int(v), 0x4E, 0xf, 0xf, true);
    else if (ctrl_sel == 2) r = __builtin_amdgcn_update_dpp(0, __float_as_int(v), 0x124, 0xf, 0xf, true);
    else r = __builtin_amdgcn_update_dpp(0, __float_as_int(v), 0x128, 0xf, 0xf, true);
    return __int_as_float(r);
}
__device__ __forceinline__ float row16_max(float v) { v = fmaxf(v, dppf(v, 0)); v = fmaxf(v, dppf(v, 1)); v = fmaxf(v, dppf(v, 2)); v = fmaxf(v, dppf(v, 3)); return v; }
__device__ __forceinline__ float row16_sum(float v) { v += dppf(v, 0); v += dppf(v, 1); v += dppf(v, 2); v += dppf(v, 3); return v; }

__device__ __forceinline__ void store4bf(bf16_t* p, f32x4 v) { u32x2 o; o.x = pk2(v[0], v[1]); o.y = pk2(v[2], v[3]); *(u32x2*)p = o; }
__device__ __forceinline__ f32x4 load4bf(const bf16_t* p) { u32x2 w = *(const u32x2*)p; f32x4 r; r[0] = blo(w.x); r[1] = bhi(w.x); r[2] = blo(w.y); r[3] = bhi(w.y); return r; }
#define MFMA16(a, b, c) __builtin_amdgcn_mfma_f32_16x16x32_bf16((a), (b), (c), 0, 0, 0)
#define WAIT_V0() asm volatile("s_waitcnt vmcnt(0)" ::: "memory")
#define WAIT_L0() asm volatile("s_waitcnt lgkmcnt(0)" ::: "memory")

__device__ __forceinline__ int lds_byte2(int r, int c) { int st = (r >> 4) * 2 + (c >> 5), ob = (r & 15) * 64 + (c & 31) * 2; return st * 1024 + (ob ^ (((ob >> 9) & 1) << 5)); }
__device__ __forceinline__ void stage_rc2(int b, int& R, int& C) { int st = b >> 10, sb = b & 1023, swz = sb ^ (((sb >> 9) & 1) << 5); R = (st >> 1) * 16 + swz / 64; C = (st & 1) * 32 + (swz % 64) / 2; }

#define ROWOFF(wr, mi) ((((mi) >> 2) * 128) + (wr) * 64 + (((mi) & 3) * 16))
__device__ __forceinline__ void gemm256(LAS char* lds, const bf16_t* __restrict__ Ab, int lda, const bf16_t* __restrict__ Bb, int ldb, int K, f32x4 (&acc)[8][4], bool zero_acc = true) {
    int tid = threadIdx.x; asm volatile("" : "+v"(tid));
    const int wid = tid >> 6, lane = tid & 63, wr = wid >> 2, wc = wid & 3, fr = lane & 15, fq = lane >> 4;
    unsigned voA[2], voB[2];
#pragma unroll
    for (int i = 0; i < 2; ++i) {
        int R, C; stage_rc2(tid * 16 + i * 8192, R, C);
        voA[i] = (unsigned)(R * lda + C) * 2u;
        { const int rho = R & 31; voB[i] = (unsigned)(((R >> 5) * 64 + 8 * ((rho & 15) >> 2) + 4 * (rho >> 4) + (rho & 3)) * ldb + C) * 2u; }
    }
    const int swz = fr * 64 + ((fq * 16) ^ ((fr >> 3) << 5));
    const int aoff = wr * 8192 + swz, boff = wc * 4096 + swz, ldsw = wid * 1024;
    const size_t ahalf = (size_t)128 * lda * 2, bhalf = (size_t)32 * ldb * 2;
    if (zero_acc) {
#pragma unroll
        for (int m = 0; m < 8; ++m)
#pragma unroll
            for (int n = 0; n < 4; ++n) acc[m][n] = (f32x4){0.f, 0.f, 0.f, 0.f};
    }
#define SAo(b, h) (((b) * 2 + (h)) * 16384)
#define SBo(b, h) ((4 + (b) * 2 + (h)) * 16384)
#define STAGE_A(b, h, kt) do { const char* g_ = (const char*)Ab + (h) * ahalf + (size_t)(kt) * 128; _Pragma("unroll") for (int i_ = 0; i_ < 2; ++i_) \
        __builtin_amdgcn_global_load_lds((const unsigned*)(g_ + voA[i_]), (LAS unsigned*)(lds + SAo(b, h) + ldsw + i_ * 8192), 16, 0, 0); } while (0)
#define STAGE_B(b, h, kt) do { const char* g_ = (const char*)Bb + (h) * bhalf + (size_t)(kt) * 128; _Pragma("unroll") for (int i_ = 0; i_ < 2; ++i_) \
        __builtin_amdgcn_global_load_lds((const unsigned*)(g_ + voB[i_]), (LAS unsigned*)(lds + SBo(b, h) + ldsw + i_ * 8192), 16, 0, 0); } while (0)
#define LDA(dst, b, h) _Pragma("unroll") for (int m_ = 0; m_ < 4; ++m_) _Pragma("unroll") for (int k_ = 0; k_ < 2; ++k_) \
        dst[m_][k_] = *(const LAS bf16x8*)(lds + SAo(b, h) + aoff + m_ * 2048 + k_ * 1024)
#define LDB(dst, b, h) _Pragma("unroll") for (int n_ = 0; n_ < 2; ++n_) _Pragma("unroll") for (int k_ = 0; k_ < 2; ++k_) \
        dst[n_][k_] = *(const LAS bf16x8*)(lds + SBo(b, h) + boff + n_ * 2048 + k_ * 1024)
#define MMA(ai, bj, A_, B_) do { __builtin_amdgcn_s_setprio(1); \
        _Pragma("unroll") for (int m_ = 0; m_ < 4; ++m_) _Pragma("unroll") for (int n_ = 0; n_ < 2; ++n_) _Pragma("unroll") for (int k_ = 0; k_ < 2; ++k_) \
            acc[(ai) * 4 + m_][(bj) * 2 + n_] = MFMA16(B_[n_][k_], A_[m_][k_], acc[(ai) * 4 + m_][(bj) * 2 + n_]); \
        __builtin_amdgcn_s_setprio(0); } while (0)
#define WAIT_V(n) asm volatile("s_waitcnt vmcnt(" #n ")" ::: "memory")
#define WAIT_L(n) asm volatile("s_waitcnt lgkmcnt(" #n ")" ::: "memory")
#define BAR __builtin_amdgcn_s_barrier()
#define SCHED __builtin_amdgcn_sched_barrier(0)
    bf16x8 At[4][2], B0[2][2], B1[2][2];
    const int nt = K >> 6;
    __syncthreads();
    STAGE_B(0, 0, 0); STAGE_A(0, 0, 0); STAGE_B(0, 1, 0); STAGE_A(0, 1, 0);
    if (wr == 1) BAR;
    WAIT_V(4); BAR;
    STAGE_B(1, 0, 1); STAGE_A(1, 0, 1); STAGE_B(1, 1, 1);
    WAIT_V(6); BAR;
    for (int t = 0; t < nt - 2; t += 2) {
        LDB(B0, 0, 0); SCHED; LDA(At, 0, 0); STAGE_A(1, 1, t + 1);
        WAIT_L(8); BAR; WAIT_L(0); MMA(0, 0, At, B0); BAR; SCHED;
        LDB(B1, 0, 1); STAGE_B(0, 0, t + 2);
        BAR; WAIT_L(0); MMA(0, 1, At, B1); BAR;
        LDA(At, 0, 1); STAGE_A(0, 0, t + 2);
        BAR; WAIT_L(0); MMA(1, 0, At, B0); BAR; SCHED;
        STAGE_B(0, 1, t + 2);
        WAIT_V(6); BAR; MMA(1, 1, At, B1); BAR;
        LDB(B0, 1, 0); SCHED; LDA(At, 1, 0); STAGE_A(0, 1, t + 2);
        WAIT_L(8); BAR; WAIT_L(0); MMA(0, 0, At, B0); BAR; SCHED;
        LDB(B1, 1, 1); STAGE_B(1, 0, t + 3);
        BAR; WAIT_L(0); MMA(0, 1, At, B1); BAR;
        LDA(At, 1, 1); STAGE_A(1, 0, t + 3);
        BAR; WAIT_L(0); MMA(1, 0, At, B0); BAR; SCHED;
        STAGE_B(1, 1, t + 3);
        WAIT_V(6); BAR; MMA(1, 1, At, B1); BAR;
    }
    { LDB(B0, 0, 0); LDA(At, 0, 0); STAGE_A(1, 1, nt - 1);
      BAR; WAIT_L(0); MMA(0, 0, At, B0); BAR;
      LDB(B1, 0, 1); BAR; WAIT_L(0); MMA(0, 1, At, B1); BAR;
      LDA(At, 0, 1); WAIT_V(4); BAR; WAIT_L(0); MMA(1, 0, At, B0); MMA(1, 1, At, B1); BAR; }
    { LDB(B0, 1, 0); LDA(At, 1, 0); WAIT_V(2); BAR; WAIT_L(0); MMA(0, 0, At, B0); BAR;
      LDB(B1, 1, 1); WAIT_V(0); BAR; WAIT_L(0); MMA(0, 1, At, B1); BAR;
      LDA(At, 1, 1); BAR; WAIT_L(0); MMA(1, 0, At, B0); MMA(1, 1, At, B1); BAR; }
    if (wr == 0) BAR;
#undef SAo
#undef SBo
#undef STAGE_A
#undef STAGE_B
#undef LDA
#undef LDB
#undef MMA
#undef WAIT_V
#undef WAIT_L
#undef BAR
#undef SCHED
}
#define OPAQUE_WS(name) char* name = get_kp()->ws
#define EPI_IDS int tid_ = threadIdx.x; asm volatile("" : "+v"(tid_)); const int wid_ = tid_ >> 6, lane_ = tid_ & 63, wr_ = wid_ >> 2, wc_ = wid_ & 3, fr_ = lane_ & 15, fq_ = lane_ >> 4

__device__ __forceinline__ void tile_map(int L, int nM, int nN, int& pm, int& pn) {
    const int nwg = nM * nN; int wgid = L;
    { const int q = nwg / 8, r = nwg % 8, xcd = wgid % 8, off = wgid / 8; wgid = (xcd < r ? xcd * (q + 1) : r * (q + 1) + (xcd - r) * q) + off; }
    const int nig = 8 * nN, gid = wgid / nig, fm = gid * 8, gsz = (nM - fm) < 8 ? (nM - fm) : 8;
    pm = fm + ((wgid % nig) % gsz); pn = (wgid % nig) / gsz;
}

__device__ __forceinline__ void store8bf(bf16_t* p, f32x4 v0, f32x4 v1) { u32x4 o; o.x = pk2(v0[0], v0[1]); o.y = pk2(v0[2], v0[3]); o.z = pk2(v1[0], v1[1]); o.w = pk2(v1[2], v1[3]); *(u32x4*)p = o; }
__device__ __forceinline__ void load8bf(const bf16_t* p, f32x4& v0, f32x4& v1) { const u32x4 w = *(const u32x4*)p; v0[0] = blo(w.x); v0[1] = bhi(w.x); v0[2] = blo(w.y); v0[3] = bhi(w.y); v1[0] = blo(w.z); v1[1] = bhi(w.z); v1[2] = blo(w.w); v1[3] = bhi(w.w); }
__device__ __forceinline__ f32x4 silu4(f32x4 v) { f32x4 o; for (int j = 0; j < 4; ++j) o[j] = v[j] * sigmoidf_(v[j]); return o; }
__device__ __forceinline__ f32x4 sigm4(f32x4 v) { f32x4 o; for (int j = 0; j < 4; ++j) o[j] = sigmoidf_(v[j]); return o; }
__device__ __forceinline__ float sq4(f32x4 v) { return v[0] * v[0] + v[1] * v[1] + v[2] * v[2] + v[3] * v[3]; }

struct EpiProj {
    bf16_t* proj; bf16_t* krope; float* rsq; const float *cosr, *sinr, *cosm, *sinm; int brow, bcol;
    __device__ __forceinline__ void operator()(f32x4 (&acc)[8][4], int wr, int wc, int fr, int fq) const {
        const int c0 = bcol + wc * 64;
        int type;
        if (bcol < 1024) type = 0; else if (bcol < 2048) type = 1; else if (bcol < 3072) type = 2; else if (bcol < 4096) type = 3;
        else if (bcol < 5120) type = 2; else if (bcol < 6144) type = 3; else if (bcol < 7168) type = 4; else if (bcol < 8192) type = 3;
        else if (bcol < 14336) type = 5; else type = 6;
#pragma unroll
        for (int m = 0; m < 8; ++m) {
            const int t = brow + ROWOFF(wr, m) + fr;
            bf16_t* rowp = proj + (size_t)t * LDP + c0 + 8 * fq;
            if (type == 0 || type == 1) {
                const int blk = (c0 >> 6) & 1; const float sc = type == 0 ? RQSCALE : 1.0f;
                f32x4 o1[2], o2[2];
#pragma unroll
                for (int n = 0; n < 2; ++n) {
                    const int f0 = 32 * blk + 8 * fq + 4 * n;
                    const f32x4 cs = *(const f32x4*)(cosr + (size_t)t * 64 + f0), sn = *(const f32x4*)(sinr + (size_t)t * 64 + f0);
                    const f32x4 x1 = acc[m][n], x2 = acc[m][n + 2];
                    o1[n] = (x1 * cs - x2 * sn) * sc; o2[n] = (x2 * cs + x1 * sn) * sc;
                }
                store8bf(rowp, o1[0], o1[1]); store8bf(rowp + 32, o2[0], o2[1]);
            } else if (type == 2) {
                store8bf(rowp, acc[m][0], acc[m][1]); store8bf(rowp + 32, acc[m][2], acc[m][3]);
            } else if (type == 3) {
                store8bf(rowp, silu4(acc[m][0]), silu4(acc[m][1])); store8bf(rowp + 32, silu4(acc[m][2]), silu4(acc[m][3]));
            } else if (type == 4) {
                float s = sq4(acc[m][0]) + sq4(acc[m][1]) + sq4(acc[m][2]) + sq4(acc[m][3]);
                store8bf(rowp, acc[m][0], acc[m][1]); store8bf(rowp + 32, acc[m][2], acc[m][3]);
                { const int ln_ = fq * 16 + fr; s += shx(s, ln_, 16); s += shx(s, ln_, 32); }
                if (fq == 0) rsq[(size_t)t * 16 + ((c0 - 6144) >> 6)] = s;
            } else if (type == 5) {
                store8bf(rowp, sigm4(acc[m][0]), sigm4(acc[m][1])); store8bf(rowp + 32, sigm4(acc[m][2]), sigm4(acc[m][3]));
            } else {
                if (wc == 0) {
                    f32x4 o1[2], o2[2];
#pragma unroll
                    for (int n = 0; n < 2; ++n) {
                        const int f0 = 8 * fq + 4 * n;
                        const f32x4 cs = *(const f32x4*)(cosm + (size_t)t * 32 + f0), sn = *(const f32x4*)(sinm + (size_t)t * 32 + f0);
                        const f32x4 x1 = acc[m][n], x2 = acc[m][n + 2];
                        o1[n] = x1 * cs - x2 * sn; o2[n] = x2 * cs + x1 * sn;
                    }
                    store8bf(krope + (size_t)t * 64 + 8 * fq, o1[0], o1[1]); store8bf(krope + (size_t)t * 64 + 32 + 8 * fq, o2[0], o2[1]);
                }
            }
        }
    }
};

struct EpiQ {
    bf16_t* qm; const float* rsq; const float *cosm, *sinm; int brow, bcol;
    __device__ __forceinline__ void operator()(f32x4 (&acc)[8][4], int wr, int wc, int fr, int fq) const {
        const int c0 = bcol + wc * 64, head = c0 / 192, within = c0 - head * 192;
        float rsv[8];
#pragma unroll
        for (int m = 0; m < 8; ++m) {
            const int t = brow + ROWOFF(wr, m) + fr;
            const f32x4 r0 = *(const f32x4*)(rsq + (size_t)t * 16), r1 = *(const f32x4*)(rsq + (size_t)t * 16 + 4);
            const float ss = r0[0] + r0[1] + r0[2] + r0[3] + r1[0] + r1[1] + r1[2] + r1[3];
            rsv[m] = rsqrtf(ss * (1.0f / 512.0f) + EPS) * QSCALE;
        }
#pragma unroll
        for (int m = 0; m < 8; ++m) {
            const int t = brow + ROWOFF(wr, m) + fr, b = t >> 11, s = t & 2047;
            const float rs = rsv[m];
            bf16_t* base = qm + ((size_t)((b * 8 + head) * 2048 + s)) * 192 + within + 8 * fq;
            if (within != 128) {
                store8bf(base, acc[m][0] * rs, acc[m][1] * rs); store8bf(base + 32, acc[m][2] * rs, acc[m][3] * rs);
            } else {
                f32x4 o1[2], o2[2];
#pragma unroll
                for (int n = 0; n < 2; ++n) {
                    const int f0 = 8 * fq + 4 * n;
                    const f32x4 cs = *(const f32x4*)(cosm + (size_t)t * 32 + f0), sn = *(const f32x4*)(sinm + (size_t)t * 32 + f0);
                    const f32x4 x1 = acc[m][n] * rs, x2 = acc[m][n + 2] * rs;
                    o1[n] = x1 * cs - x2 * sn; o2[n] = x2 * cs + x1 * sn;
                }
                store8bf(base, o1[0], o1[1]); store8bf(base + 32, o2[0], o2[1]);
            }
        }
    }
};

struct EpiKV {
    bf16_t* kn; bf16_t* vt; const float* rsq; int brow, head;
    __device__ __forceinline__ void operator()(f32x4 (&acc)[8][4], int wr, int wc, int fr, int fq) const {
        float rsv[8];
#pragma unroll
        for (int m = 0; m < 8; ++m) {
            const int t = brow + ROWOFF(wr, m) + fr;
            const f32x4 r0 = *(const f32x4*)(rsq + (size_t)t * 16 + 8), r1 = *(const f32x4*)(rsq + (size_t)t * 16 + 12);
            const float ss = r0[0] + r0[1] + r0[2] + r0[3] + r1[0] + r1[1] + r1[2] + r1[3];
            rsv[m] = rsqrtf(ss * (1.0f / 512.0f) + EPS);
        }
#pragma unroll
        for (int m = 0; m < 8; ++m) {
            const int t = brow + ROWOFF(wr, m) + fr, b = t >> 11, s = t & 2047;
            const float rs = rsv[m];
            if (wc < 2) {
                bf16_t* base = kn + ((size_t)((b * 8 + head) * 2048 + s)) * 128 + wc * 64 + 8 * fq;
                store8bf(base, acc[m][0] * rs, acc[m][1] * rs); store8bf(base + 32, acc[m][2] * rs, acc[m][3] * rs);
            } else {
#pragma unroll
                for (int n = 0; n < 4; ++n)
#pragma unroll
                    for (int j = 0; j < 4; j += 2) {
                        const int d = (wc - 2) * 64 + (n >> 1) * 32 + 8 * fq + 4 * (n & 1) + j;
                        const unsigned pv_ = pk2(acc[m][n][j] * rs, acc[m][n][j + 1] * rs);
                        vt[((size_t)((b * 8 + head) * 128 + d)) * 2048 + s] = (bf16_t)pv_;
                        vt[((size_t)((b * 8 + head) * 128 + d + 1)) * 2048 + s] = (bf16_t)(pv_ >> 16);
                    }
            }
        }
    }
};

struct EpiBranch {
    const bf16_t* gates; bf16_t* merged; int mode, brow, bcol;
    __device__ __forceinline__ void operator()(f32x4 (&acc)[8][4], int wr, int wc, int fr, int fq) const {
        const int col0 = bcol + wc * 64 + 8 * fq;
        const size_t t0 = (size_t)(brow + fr);
#pragma unroll
        for (int m = 0; m < 8; ++m) {
            const size_t t = t0 + ROWOFF(wr, m);
#pragma unroll
            for (int bj = 0; bj < 2; ++bj) {
                const bf16_t* gp = gates + t * LDP + col0 + bj * 32 + mode * 2048;
                f32x4 g0, g1; load8bf(gp, g0, g1);
                if (mode != 2) {
                    f32x4 h0, h1; load8bf(gp + 2048, h0, h1);
#pragma unroll
                    for (int j = 0; j < 4; ++j) {
                        acc[m][2 * bj][j] *= g0[j] * __builtin_amdgcn_rcpf(fmaxf(h0[j], 1e-30f));
                        acc[m][2 * bj + 1][j] *= g1[j] * __builtin_amdgcn_rcpf(fmaxf(h1[j], 1e-30f));
                    }
                } else {
                    store8bf(merged + t * D + col0 + bj * 32, acc[m][2 * bj] * g0, acc[m][2 * bj + 1] * g1);
                }
            }
        }
    }
};

struct EpiOut {
    bf16_t* y; int brow, bcol;
    __device__ __forceinline__ void operator()(f32x4 (&acc)[8][4], int wr, int wc, int fr, int fq) const {
#pragma unroll
        for (int m = 0; m < 8; ++m) {
            const int t = brow + ROWOFF(wr, m) + fr;
            bf16_t* yp = y + (size_t)t * D + bcol + wc * 64 + 8 * fq;
            store8bf(yp, acc[m][0], acc[m][1]); store8bf(yp + 32, acc[m][2], acc[m][3]);
        }
    }
};

__device__ __forceinline__ void epi_proj_staged(LAS char* lds, f32x4 (&acc)[8][4], bf16_t* proj, int brow, int bcol, int act  , int wid, int lane) {
    const int wr = wid >> 2, wc = wid & 3, fr = lane & 15, fq = lane >> 4;
    LAS char* wl = lds + wid * 16384;
#pragma unroll
    for (int m = 0; m < 8; ++m) {
        const int lr = m * 16 + fr;
#pragma unroll
        for (int bj = 0; bj < 2; ++bj) {
            f32x4 v0 = acc[m][2 * bj], v1 = acc[m][2 * bj + 1];
            if (act == 1) { v0 = silu4(v0); v1 = silu4(v1); } else if (act == 2) { v0 = sigm4(v0); v1 = sigm4(v1); }
            u32x4 o; o.x = pk2(v0[0], v0[1]); o.y = pk2(v0[2], v0[3]); o.z = pk2(v1[0], v1[1]); o.w = pk2(v1[2], v1[3]);
            *(LAS u32x4*)(wl + lr * 128 + (((bj * 4 + fq) ^ (lr & 7)) * 16)) = o;
        }
    }
    WAIT_L0(); __builtin_amdgcn_wave_barrier();
    const int rsub = lane >> 3, ch = lane & 7;
#pragma unroll
    for (int i = 0; i < 16; ++i) {
        const int lr = 8 * i + rsub;
        const u32x4 o = *(const LAS u32x4*)(wl + lr * 128 + ((ch ^ (lr & 7)) * 16));
        const int t = brow + ROWOFF(wr, lr >> 4) + (lr & 15);
        *(u32x4*)(proj + (size_t)t * LDP + bcol + wc * 64 + ch * 8) = o;
    }
}

__device__ __forceinline__ int win_map(int np) {
    if (np < 2048) { const int base = np & ~127, p = np & 127, blk = p >> 6, half = (p >> 5) & 1, r = p & 31; return base + 32 * blk + 64 * half + r; }
    if (np < 7168) return np;
    if (np < 14336) return np + 64;
    if (np < 14400) return 7168 + (np - 14336);
    return -1;
}

struct ConvArgs { const float* src; const float* gain; bf16_t* dst; int ld, Kt, k0, np0, wmap; };
__device__ __forceinline__ ConvArgs conv_decode(KP p, int ci) {
    char* ws = p->ws;
    constexpr int NCONV_L = 1824 + 48 + 64 + 384 + 256 + 8 + 8;
    ConvArgs a; const int l = ci / NCONV_L; ci -= l * NCONV_L; a.gain = nullptr; a.wmap = 0;
    if (ci < 1824) { const int nt = ci % 114, kt = ci / 114; a.src = p->in[7] + (size_t)l * 2048 * NIN; a.ld = NIN; a.Kt = 2048; a.k0 = kt * 128; a.np0 = nt * 128; a.wmap = 1; a.dst = (bf16_t*)(ws + WS_WI) + (size_t)l * NP1 * 2048; }
    else if ((ci -= 1824) < 48) { const int nt = ci % 12, kt = ci / 12; a.src = p->in[17] + (size_t)l * 512 * 1536; a.ld = 1536; a.Kt = 512; a.k0 = kt * 128; a.np0 = nt * 128; a.gain = p->in[16] + l * 512; a.dst = (bf16_t*)(ws + WS_WUQ) + (size_t)l * 1536 * 512; }
    else if ((ci -= 48) < 64) { const int nt = ci % 16, kt = ci / 16; a.src = p->in[19] + (size_t)l * 512 * 2048; a.ld = 2048; a.Kt = 512; a.k0 = kt * 128; a.np0 = nt * 128; a.gain = p->in[18] + l * 512; a.dst = (bf16_t*)(ws + WS_WUKV) + (size_t)l * 2048 * 512; }
    else if ((ci -= 64) < 384) { const int nt = ci % 16, kt = ci / 16; a.src = p->in[20] + (size_t)l * 3072 * 2048; a.ld = 2048; a.Kt = 3072; a.k0 = kt * 128; a.np0 = nt * 128; a.dst = (bf16_t*)(ws + WS_WB) + (size_t)l * 2048 * 3072; }
    else if ((ci -= 384) < 256) { const int nt = ci % 16, kt = ci / 16; a.src = p->in[21] + (size_t)l * 2048 * 2048; a.ld = 2048; a.Kt = 2048; a.k0 = kt * 128; a.np0 = nt * 128; a.dst = (bf16_t*)(ws + WS_WO) + (size_t)l * 2048 * 2048; }
    else if ((ci -= 256) < 8) { a.src = p->in[11] + (size_t)(l * 8 + ci) * 16384; a.ld = 128; a.Kt = 128; a.k0 = 0; a.np0 = 0; a.dst = (bf16_t*)(ws + WS_WA) + (size_t)(l * 8 + ci) * 16384; }
    else { ci -= 8; a.src = p->in[13] + (size_t)(l * 8 + ci) * 16384; a.ld = 128; a.Kt = 128; a.k0 = 0; a.np0 = 0; a.dst = (bf16_t*)(ws + WS_WX) + (size_t)(l * 8 + ci) * 16384; }
    return a;
}
__device__ __forceinline__ void conv_load(const ConvArgs& c, int tid, f32x4 (&a)[4], f32x4 (&b)[4]) {
    const int c8 = (tid & 15) * 8, np = c.np0 + c8;
    const int n = c.wmap ? win_map(np) : np;
#pragma unroll
    for (int r = 0; r < 4; ++r) {
        const int kl = (tid >> 4) + 32 * r;
        a[r] = (f32x4){0.f, 0.f, 0.f, 0.f}; b[r] = a[r];
        if (n >= 0) { const float* sp = c.src + (size_t)(c.k0 + kl) * c.ld + n; a[r] = *(const f32x4*)sp; b[r] = *(const f32x4*)(sp + 4); }
    }
}
__device__ __forceinline__ void conv_finish(LAS char* lds, const ConvArgs& c, int tid, const f32x4 (&a)[4], const f32x4 (&b)[4]) {
    LAS bf16_t* tl = (LAS bf16_t*)lds;
    const int c8 = (tid & 15) * 8;
    __syncthreads();
#pragma unroll
    for (int r = 0; r < 4; ++r) {
        const int kl = (tid >> 4) + 32 * r;
        const float g = c.gain ? c.gain[c.k0 + kl] : 1.0f;
#pragma unroll
        for (int e = 0; e < 4; e += 2) {
            const unsigned pa_ = pk2(a[r][e] * g, a[r][e + 1] * g), pb_ = pk2(b[r][e] * g, b[r][e + 1] * g);
            tl[(c8 + e) * 130 + kl] = (bf16_t)pa_; tl[(c8 + e + 1) * 130 + kl] = (bf16_t)(pa_ >> 16);
            tl[(c8 + 4 + e) * 130 + kl] = (bf16_t)pb_; tl[(c8 + 5 + e) * 130 + kl] = (bf16_t)(pb_ >> 16);
        }
    }
    __syncthreads();
#pragma unroll
    for (int r = 0; r < 4; ++r) {
        const int nl = (tid >> 4) + 32 * r, kc = (tid & 15) * 8;
        const LAS unsigned* rp = (const LAS unsigned*)(tl + nl * 130 + kc);
        u32x4 o; o.x = rp[0]; o.y = rp[1]; o.z = rp[2]; o.w = rp[3];
        *(u32x4*)(c.dst + (size_t)(c.np0 + nl) * c.Kt + c.k0 + kc) = o;
    }
}

__device__ __forceinline__ void conv4(LAS char* lds, KP p, int base) {
    int tid = threadIdx.x; asm volatile("" : "+v"(tid));
    f32x4 a0[4], b0[4], a1[4], b1[4];
    ConvArgs c0 = conv_decode(p, base), c1 = conv_decode(p, base + 1);
    conv_load(c0, tid, a0, b0); conv_load(c1, tid, a1, b1);
    conv_finish(lds, c0, tid, a0, b0);
    c0 = conv_decode(p, base + 2); conv_load(c0, tid, a0, b0);
    conv_finish(lds, c1, tid, a1, b1);
    c1 = conv_decode(p, base + 3); conv_load(c1, tid, a1, b1);
    conv_finish(lds, c0, tid, a0, b0);
    conv_finish(lds, c1, tid, a1, b1);
}

__device__ void phase0(LAS char* lds, KP p) {
    char* ws = p->ws;
    int tid = threadIdx.x; asm volatile("" : "+v"(tid)); const int wid = tid >> 6, lane = tid & 63;
    constexpr int NCONV_L = 1824 + 48 + 64 + 384 + 256 + 8 + 8;
    constexpr int N_ADA = 384, N_ROPE = 128, N_ITEMS = N_ADA + N_ROPE;
    for (int it = blockIdx.x; it < N_ITEMS; it += gridDim.x) {
        if (it < N_ADA) {
            const int l = it / 96, j0 = (it % 96) * 64;
            LAS float* cact = (LAS float*)lds;
            LAS float* red = (LAS float*)(lds + 32768);
            __syncthreads();
            for (int i = tid; i < 8192; i += 512) { const float v = p->in[1][i]; cact[i] = v * sigmoidf_(v); }
            __syncthreads();
            const int cg = lane & 15, kq = lane >> 4;
            const float* wp = p->in[3] + (size_t)l * 2048 * 6144 + j0 + 4 * cg;
            f32x4 a0 = (f32x4){0.f, 0.f, 0.f, 0.f}, a1 = a0, a2 = a0, a3 = a0;
#pragma unroll 16
            for (int j = 0; j < 64; ++j) {
                const int k = wid * 256 + 4 * j + kq;
                const f32x4 w = *(const f32x4*)(wp + (size_t)k * 6144);
                a0 += w * cact[k]; a1 += w * cact[2048 + k]; a2 += w * cact[4096 + k]; a3 += w * cact[6144 + k];
            }
#pragma unroll
            for (int e = 0; e < 4; ++e) {
                a0[e] += shx(a0[e], lane, 16); a0[e] += shx(a0[e], lane, 32); a1[e] += shx(a1[e], lane, 16); a1[e] += shx(a1[e], lane, 32);
                a2[e] += shx(a2[e], lane, 16); a2[e] += shx(a2[e], lane, 32); a3[e] += shx(a3[e], lane, 16); a3[e] += shx(a3[e], lane, 32);
            }
            if (kq == 0) {
                *(LAS f32x4*)(red + (wid * 4 + 0) * 64 + 4 * cg) = a0; *(LAS f32x4*)(red + (wid * 4 + 1) * 64 + 4 * cg) = a1;
                *(LAS f32x4*)(red + (wid * 4 + 2) * 64 + 4 * cg) = a2; *(LAS f32x4*)(red + (wid * 4 + 3) * 64 + 4 * cg) = a3;
            }
            __syncthreads();
            if (tid < 256) {
                const int b = tid >> 6, jl = tid & 63; float s = 0.f;
#pragma unroll
                for (int w = 0; w < 8; ++w) s += red[(w * 4 + b) * 64 + jl];
                ((float*)(ws + WS_MOD))[(size_t)(l * 4 + b) * 6144 + j0 + jl] = s + p->in[4][(size_t)l * 6144 + j0 + jl];
            }
        } else if (it < N_ADA + N_ROPE) {
            const int t0 = (it - N_ADA) * 64;
            for (int e = tid; e < 64 * 96; e += 512) {
                const int tl = e / 96, f = e % 96, t = t0 + tl;
                const float pos = (float)p->pos[t];
                float invf; if (f < 64) invf = exp2f(-(float)(2 * f) * (1.0f / 128.0f) * 13.287712379549449f); else invf = exp2f(-(float)(2 * (f - 64)) * (1.0f / 64.0f) * 13.287712379549449f);
                const float ang = pos * invf;
                double rev = (double)ang * 0.15915494309189535; rev -= rint(rev);
                const float rv = (float)rev;
                const float sn = __builtin_amdgcn_sinf(rv), cs = __builtin_amdgcn_cosf(rv);
                if (f < 64) { ((float*)(ws + WS_COSR))[(size_t)t * 64 + f] = cs; ((float*)(ws + WS_SINR))[(size_t)t * 64 + f] = sn; }
                else { ((float*)(ws + WS_COSM))[(size_t)t * 32 + f - 64] = cs; ((float*)(ws + WS_SINM))[(size_t)t * 32 + f - 64] = sn; }
            }
        }
    }
    {
        constexpr int NCONV = NCONV_L;
        int ci = blockIdx.x;
        f32x4 a0[4], b0[4], a1[4], b1[4];
        ConvArgs c0 = conv_decode(p, ci < NCONV ? ci : 0), c1 = c0;
        if (ci < NCONV) conv_load(c0, tid, a0, b0);
        while (ci < NCONV) {
            const int cn = ci + gridDim.x, cnn = cn + gridDim.x;
            if (cn < NCONV) { c1 = conv_decode(p, cn); conv_load(c1, tid, a1, b1); }
            conv_finish(lds, c0, tid, a0, b0);
            if (cn >= NCONV) break;
            if (cnn < NCONV) { c0 = conv_decode(p, cnn); conv_load(c0, tid, a0, b0); }
            conv_finish(lds, c1, tid, a1, b1);
            ci = cnn;
        }
    }
}

__device__ __forceinline__ float wave_sum(float v, int lane) {
    v = row16_sum(v); v += shx(v, lane, 16); v += shx(v, lane, 32); return v;
}
__device__ void rowpass(KP p, int l  ) {
    char* ws = p->ws;
    int tid = threadIdx.x; asm volatile("" : "+v"(tid));
    const int lane = tid & 63, gw = blockIdx.x * 8 + (tid >> 6), nw = gridDim.x * 8;
    const float* mod = (const float*)(ws + WS_MOD);
    float* xcur = (float*)(ws + WS_XCUR);
    const bf16_t* ybuf = (const bf16_t*)(ws + WS_YBUF);
    bf16_t* hbuf = (bf16_t*)(ws + WS_HBUF);
    for (int g4 = gw; g4 < T / 4; g4 += nw) {
        const int r0 = g4 * 4, b = r0 >> 11;
        f32x4 pa[8], pb[8], pc[8];
        if (l >= 0) {
#pragma unroll
            for (int i = 0; i < 8; ++i) {
                const int c = i * 256 + lane * 4;
                pa[i] = (*(const f32x4*)(mod + (size_t)(l * 4 + b) * 6144 + 4096 + c) + 1.0f) * *(const f32x4*)(p->in[6] + (size_t)l * D + c);
            }
        }
        if (l < DEPTH - 1) {
            const int ln = l + 1;
#pragma unroll
            for (int i = 0; i < 8; ++i) {
                const int c = i * 256 + lane * 4;
                pb[i] = (*(const f32x4*)(mod + (size_t)(ln * 4 + b) * 6144 + 2048 + c) + 1.0f) * *(const f32x4*)(p->in[5] + (size_t)ln * D + c);
                pc[i] = *(const f32x4*)(mod + (size_t)(ln * 4 + b) * 6144 + c);
            }
        }
        const float* xprev = (l <= 0) ? p->in[0] : xcur;
        float* dst = (l == DEPTH - 1) ? p->out : xcur;
#pragma unroll 1
        for (int rr = 0; rr < 4; ++rr) {
            const int row = r0 + rr;
            f32x4 xv[8], yv[8];
#pragma unroll
            for (int i = 0; i < 8; ++i) {
                xv[i] = *(const f32x4*)(xprev + (size_t)row * D + i * 256 + lane * 4);
                if (l >= 0) yv[i] = load4bf(ybuf + (size_t)row * D + i * 256 + lane * 4);
            }
            if (l >= 0) {
                float ss = 0.f;
#pragma unroll
                for (int i = 0; i < 8; ++i) ss += yv[i][0] * yv[i][0] + yv[i][1] * yv[i][1] + yv[i][2] * yv[i][2] + yv[i][3] * yv[i][3];
                ss = wave_sum(ss, lane);
                const float rs = rsqrtf(ss * (1.0f / D) + EPS);
#pragma unroll
                for (int i = 0; i < 8; ++i) {
                    xv[i] = xv[i] + pa[i] * (yv[i] * rs);
                    *(f32x4*)(dst + (size_t)row * D + i * 256 + lane * 4) = xv[i];
                }
            }
            if (l < DEPTH - 1) {
                float ss = 0.f;
#pragma unroll
                for (int i = 0; i < 8; ++i) ss += xv[i][0] * xv[i][0] + xv[i][1] * xv[i][1] + xv[i][2] * xv[i][2] + xv[i][3] * xv[i][3];
                ss = wave_sum(ss, lane);
                const float rs = rsqrtf(ss * (1.0f / D) + EPS);
#pragma unroll
                for (int i = 0; i < 8; ++i) store4bf(hbuf + (size_t)row * D + i * 256 + lane * 4, xv[i] * rs * pb[i] + pc[i]);
            }
        }
    }
}

__device__ __forceinline__ int tix(int row, int col) { return row * 72 + (col ^ (((row >> 3) & 3) << 4)); }
template <bool OUT>
__device__ void ret_item(LAS char* lds, KP p, int l, int item) {
    char* ws = p->ws;
    int tid = threadIdx.x; asm volatile("" : "+v"(tid)); const int wid = tid >> 6, lane = tid & 63, fr = lane & 15, fq = lane >> 4;
    const int g = item & 7, h = (item >> 3) & 7, b = item >> 6;
    LAS bf16_t* Qs = (LAS bf16_t*)(lds);
    LAS bf16_t* Ks = (LAS bf16_t*)(lds + 17408);
    LAS bf16_t* Kt = (LAS bf16_t*)(lds + 34816);
    LAS bf16_t* Vt = (LAS bf16_t*)(lds + 53248);
    LAS bf16_t* St = (LAS bf16_t*)(lds + 71680);
    LAS bf16_t* Ps = (LAS bf16_t*)(lds + 106496);
    LAS float* Os = (LAS float*)(lds);
    const bf16_t* proj = (const bf16_t*)(ws + WS_PROJ);
    float* tot = (float*)(ws + WS_TOT);
    const float gy = __builtin_amdgcn_exp2f(-5.0f - (float)h);
    const float lg2 = -gy * (1.0f + gy * (0.5f + gy * (0.33333334f + gy * (0.25f + gy * 0.2f)))) * 1.4426950408889634f;
    const float d64 = __builtin_amdgcn_exp2f(lg2 * 64.0f), d256 = __builtin_amdgcn_exp2f(lg2 * 256.0f);
    f32x4 sacc[8];
#pragma unroll
    for (int nf = 0; nf < 8; ++nf) sacc[nf] = (f32x4){0.f, 0.f, 0.f, 0.f};
    if (OUT) {
        float w = 1.0f;
        for (int gp = g - 1; gp >= 0; --gp) {
            const float* tp = tot + (size_t)((b * 8 + h) * 8 + gp) * 16384;
            float tv[8][4];
#pragma unroll
            for (int nf = 0; nf < 8; ++nf)
#pragma unroll
                for (int j = 0; j < 4; ++j) tv[nf][j] = tp[(16 * wid + 4 * fq + j) * 128 + 16 * nf + fr];
#pragma unroll
            for (int nf = 0; nf < 8; ++nf)
#pragma unroll
                for (int j = 0; j < 4; ++j) sacc[nf][j] += w * tv[nf][j];
            w *= d256;
        }
    }
    int li[2], lc[2];
#pragma unroll
    for (int r = 0; r < 2; ++r) { const int wt = wid + 8 * r; li[r] = 16 * (wt & 3) + (lane & 15); lc[r] = 8 * (4 * (wt >> 2) + (lane >> 4)); }
    u32x4 gq[2], gk[2], gv[2];
#define RET_LOAD(n_) do { const int t0_ = b * 2048 + (n_) * 64; _Pragma("unroll") for (int r = 0; r < 2; ++r) { \
        const bf16_t* rowp = proj + (size_t)(t0_ + li[r]) * LDP + h * 128 + lc[r]; \
        gk[r] = *(const u32x4*)(rowp + 1024); gv[r] = *(const u32x4*)(rowp + 2048); if (OUT) gq[r] = *(const u32x4*)(rowp); } } while (0)
    RET_LOAD(g * 4);
    const int ni = tid >> 3, npart = tid & 7, ncol = h * 128 + npart * 16;
    f32x4 gv4[4]; u32x4 sgp[2];
    if (OUT) {
#pragma unroll
        for (int e = 0; e < 4; ++e) gv4[e] = *(const f32x4*)(p->in[8] + (size_t)l * 1024 + ncol + e * 4);
    }
    for (int c = 0; c < 4; ++c) {
        const int n = g * 4 + c, t0 = b * 2048 + n * 64;
        if (OUT) { const bf16_t* gp_ = proj + (size_t)(t0 + ni) * LDP + 3072 + ncol; sgp[0] = *(const u32x4*)gp_; sgp[1] = *(const u32x4*)(gp_ + 8); }
        __syncthreads();
#pragma unroll
        for (int r = 0; r < 2; ++r) {
            const int i = li[r], c8 = lc[r];
            if (OUT) { *(LAS u32x4*)(Qs + i * 136 + c8) = gq[r]; *(LAS u32x4*)(Ks + i * 136 + c8) = gk[r]; }
            const float dec = __builtin_amdgcn_exp2f(lg2 * (float)(63 - i));
#pragma unroll
            for (int e = 0; e < 4; ++e) {
                Kt[tix(c8 + 2 * e, i)] = f2bf(blo(gk[r][e]) * dec); Kt[tix(c8 + 2 * e + 1, i)] = f2bf(bhi(gk[r][e]) * dec);
                Vt[tix(c8 + 2 * e, i)] = (bf16_t)(gv[r][e] & 0xffffu); Vt[tix(c8 + 2 * e + 1, i)] = (bf16_t)(gv[r][e] >> 16);
            }
        }
        if (OUT) {
#pragma unroll
            for (int nf = 0; nf < 8; ++nf)
#pragma unroll
                for (int j = 0; j < 4; ++j) St[(16 * wid + 4 * fq + j) * 136 + 16 * nf + fr] = f2bf(sacc[nf][j]);
        }
        if (c + 1 < 4) RET_LOAD(n + 1);
        __syncthreads();
        const int mf = wid & 3, nh = wid >> 2;
        f32x4 o1[4], o2[4];
#pragma unroll
        for (int nf = 0; nf < 4; ++nf) { o1[nf] = (f32x4){0.f, 0.f, 0.f, 0.f}; o2[nf] = (f32x4){0.f, 0.f, 0.f, 0.f}; }
        if (OUT) {
            f32x4 s2[2] = {(f32x4){0.f, 0.f, 0.f, 0.f}, (f32x4){0.f, 0.f, 0.f, 0.f}};
            {
                bf16x8 fa[4], fb0[4], fb1[4];
#pragma unroll
                for (int kk = 0; kk < 4; ++kk) {
                    fa[kk] = *(const LAS bf16x8*)(Qs + (16 * mf + fr) * 136 + kk * 32 + fq * 8);
                    fb0[kk] = *(const LAS bf16x8*)(Ks + (32 * nh + fr) * 136 + kk * 32 + fq * 8);
                    fb1[kk] = *(const LAS bf16x8*)(Ks + (32 * nh + 16 + fr) * 136 + kk * 32 + fq * 8);
                }
#pragma unroll
                for (int kk = 0; kk < 4; ++kk) { s2[0] = MFMA16(fa[kk], fb0[kk], s2[0]); s2[1] = MFMA16(fa[kk], fb1[kk], s2[1]); }
                __builtin_amdgcn_sched_group_barrier(0x100, 12, 0); __builtin_amdgcn_sched_group_barrier(0x008, 8, 0);
            }
            __builtin_amdgcn_sched_barrier(0);
#pragma unroll
            for (int nf = 0; nf < 2; ++nf)
#pragma unroll
                for (int j = 0; j < 4; ++j) {
                    const int i = 16 * mf + 4 * fq + j, jj = 32 * nh + 16 * nf + fr;
                    Ps[i * 72 + jj] = f2bf(s2[nf][j] * __builtin_amdgcn_exp2f(lg2 * fabsf((float)(i - jj))));
                }
            __builtin_amdgcn_sched_barrier(0);
            {
                bf16x8 qa[4], sb[4][4];
#pragma unroll
                for (int kk = 0; kk < 4; ++kk) {
                    qa[kk] = *(const LAS bf16x8*)(Qs + (16 * mf + fr) * 136 + kk * 32 + fq * 8);
#pragma unroll
                    for (int nf = 0; nf < 4; ++nf) sb[kk][nf] = *(const LAS bf16x8*)(St + (64 * nh + 16 * nf + fr) * 136 + kk * 32 + fq * 8);
                }
#pragma unroll
                for (int kk = 0; kk < 4; ++kk)
#pragma unroll
                    for (int nf = 0; nf < 4; ++nf) o2[nf] = MFMA16(qa[kk], sb[kk][nf], o2[nf]);
                __builtin_amdgcn_sched_group_barrier(0x100, 20, 0); __builtin_amdgcn_sched_group_barrier(0x008, 16, 0);
            }
            __builtin_amdgcn_sched_barrier(0);
        }
#pragma unroll
        for (int nf = 0; nf < 8; ++nf) sacc[nf] *= d64;
        __builtin_amdgcn_sched_barrier(0);
        {
            bf16x8 va[2], kb[2][8];
#pragma unroll
            for (int kk = 0; kk < 2; ++kk) {
                va[kk] = *(const LAS bf16x8*)(Vt + tix(16 * wid + fr, kk * 32 + fq * 8));
#pragma unroll
                for (int nf = 0; nf < 8; ++nf) kb[kk][nf] = *(const LAS bf16x8*)(Kt + tix(16 * nf + fr, kk * 32 + fq * 8));
            }
#pragma unroll
            for (int kk = 0; kk < 2; ++kk)
#pragma unroll
                for (int nf = 0; nf < 8; ++nf) sacc[nf] = MFMA16(va[kk], kb[kk][nf], sacc[nf]);
            __builtin_amdgcn_sched_group_barrier(0x100, 18, 0); __builtin_amdgcn_sched_group_barrier(0x008, 16, 0);
        }
        __builtin_amdgcn_sched_barrier(0);
        if (OUT) {
            __syncthreads();
            {
                bf16x8 pa[2], vb[2][4];
#pragma unroll
                for (int kk = 0; kk < 2; ++kk) {
                    pa[kk] = *(const LAS bf16x8*)(Ps + (16 * mf + fr) * 72 + kk * 32 + fq * 8);
#pragma unroll
                    for (int nf = 0; nf < 4; ++nf) vb[kk][nf] = *(const LAS bf16x8*)(Vt + tix(64 * nh + 16 * nf + fr, kk * 32 + fq * 8));
                }
#pragma unroll
                for (int kk = 0; kk < 2; ++kk)
#pragma unroll
                    for (int nf = 0; nf < 4; ++nf) o1[nf] = MFMA16(pa[kk], vb[kk][nf], o1[nf]);
                __builtin_amdgcn_sched_group_barrier(0x100, 10, 0); __builtin_amdgcn_sched_group_barrier(0x008, 8, 0);
            }
            __builtin_amdgcn_sched_barrier(0);
            __builtin_amdgcn_sched_barrier(0);
#pragma unroll
            for (int j = 0; j < 4; ++j) {
                const int i = 16 * mf + 4 * fq + j; const float dq = __builtin_amdgcn_exp2f(lg2 * (float)(i + 1));
#pragma unroll
                for (int nf = 0; nf < 4; ++nf) Os[i * 132 + 64 * nh + 16 * nf + fr] = o1[nf][j] + dq * o2[nf][j];
            }
        }
        if (OUT) {
            __syncthreads();
            const int i = tid >> 3, part = tid & 7, t = t0 + i;
            f32x4 v[4]; float sum = 0.f;
#pragma unroll
            for (int e = 0; e < 4; ++e) { v[e] = *(const LAS f32x4*)(Os + i * 132 + part * 16 + e * 4); sum += v[e][0] + v[e][1] + v[e][2] + v[e][3]; }
            sum += dppf(sum, 0); sum += dppf(sum, 1); sum += shx(sum, lane, 4);
            const float mean = sum * (1.0f / 128.0f);
            float sq = 0.f;
#pragma unroll
            for (int e = 0; e < 4; ++e) { v[e] = v[e] - mean; sq += v[e][0] * v[e][0] + v[e][1] * v[e][1] + v[e][2] * v[e][2] + v[e][3] * v[e][3]; }
            sq += dppf(sq, 0); sq += dppf(sq, 1); sq += shx(sq, lane, 4);
            const float rs = rsqrtf(sq * (1.0f / 128.0f) + EPS);
            bf16_t* yp = (bf16_t*)(ws + WS_YCAT) + (size_t)t * 3072 + ncol;
            f32x4 sg4[4];
            sg4[0][0] = blo(sgp[0].x); sg4[0][1] = bhi(sgp[0].x); sg4[0][2] = blo(sgp[0].y); sg4[0][3] = bhi(sgp[0].y);
            sg4[1][0] = blo(sgp[0].z); sg4[1][1] = bhi(sgp[0].z); sg4[1][2] = blo(sgp[0].w); sg4[1][3] = bhi(sgp[0].w);
            sg4[2][0] = blo(sgp[1].x); sg4[2][1] = bhi(sgp[1].x); sg4[2][2] = blo(sgp[1].y); sg4[2][3] = bhi(sgp[1].y);
            sg4[3][0] = blo(sgp[1].z); sg4[3][1] = bhi(sgp[1].z); sg4[3][2] = blo(sgp[1].w); sg4[3][3] = bhi(sgp[1].w);
            store8bf(yp, v[0] * rs * gv4[0] * sg4[0], v[1] * rs * gv4[1] * sg4[1]);
            store8bf(yp + 8, v[2] * rs * gv4[2] * sg4[2], v[3] * rs * gv4[3] * sg4[3]);
        }
    }
#undef RET_LOAD
    if (!OUT) {
        float* tp = tot + (size_t)item * 16384;
#pragma unroll
        for (int nf = 0; nf < 8; ++nf)
#pragma unroll
            for (int j = 0; j < 4; ++j) tp[(16 * wid + 4 * fq + j) * 128 + 16 * nf + fr] = sacc[nf][j];
    }
}

__device__ void lru_item(LAS char* lds, KP p, int l, int item) {
    char* ws = p->ws;
    int tid = threadIdx.x; asm volatile("" : "+v"(tid)); const int wid = tid >> 6, lane = tid & 63, fr = lane & 15, fq = lane >> 4;
    const int nb = item & 7, n = (item >> 3) & 31, b = item >> 8, t0 = b * 2048 + n * 64, s0 = n * 64;
    LAS bf16_t* Xs = (LAS bf16_t*)(lds);
    LAS float* Xf = (LAS float*)(lds + 17408);
    LAS bf16_t* Wa = (LAS bf16_t*)(lds + 50176);
    LAS bf16_t* Wx = (LAS bf16_t*)(lds + 84992);
    LAS float* As_ = (LAS float*)(lds + 50176);
    LAS float* Bs_ = (LAS float*)(lds + 82944);
    LAS float* Cq = (LAS float*)(lds + 119808);
    const bf16_t* proj = (const bf16_t*)(ws + WS_PROJ);
    const bf16_t* wat = (const bf16_t*)(ws + WS_WA) + (size_t)(l * 8 + nb) * 16384;
    const bf16_t* wxt = (const bf16_t*)(ws + WS_WX) + (size_t)(l * 8 + nb) * 16384;
    float pba[4], pbx[4], plam[4];
#pragma unroll
    for (int nf = 0; nf < 4; ++nf) { const int ch_ = l * 1024 + nb * 128 + 64 * (wid >> 2) + 16 * nf + fr; pba[nf] = p->in[12][ch_]; pbx[nf] = p->in[14][ch_]; plam[nf] = p->in[15][ch_]; }
    __syncthreads();
    {
        u32x4 wa4[4], wx4[4];
#pragma unroll
        for (int r = 0; r < 4; ++r) { const int q = tid + 512 * r, d = q >> 4, c8 = (q & 15) * 8; wa4[r] = *(const u32x4*)(wat + d * 128 + c8); wx4[r] = *(const u32x4*)(wxt + d * 128 + c8); }
#pragma unroll
        for (int r = 0; r < 4; ++r) { const int q = tid + 512 * r, d = q >> 4, c8 = (q & 15) * 8; *(LAS u32x4*)(Wa + d * 136 + c8) = wa4[r]; *(LAS u32x4*)(Wx + d * 136 + c8) = wx4[r]; }
    }
#pragma unroll
    for (int r = 0; r < 2; ++r) {
        const int q = tid + 512 * r, i = q >> 4, c8 = (q & 15) * 8, ch = nb * 128 + c8;
        f32x4 x0 = *(const f32x4*)(p->in[10] + (size_t)l * 1024 + ch), x1 = *(const f32x4*)(p->in[10] + (size_t)l * 1024 + ch + 4);
        u32x4 xv4[4]; f32x4 w04[4], w14[4];
#pragma unroll
        for (int k = 0; k < 4; ++k) {
            const int sk = s0 + i - 3 + k, tk = sk >= 0 ? (t0 + i - 3 + k) : t0;
            xv4[k] = *(const u32x4*)(proj + (size_t)tk * LDP + 4096 + ch);
            w04[k] = *(const f32x4*)(p->in[9] + (size_t)(l * 4 + k) * 1024 + ch); w14[k] = *(const f32x4*)(p->in[9] + (size_t)(l * 4 + k) * 1024 + ch + 4);
        }
#pragma unroll
        for (int k = 0; k < 4; ++k) {
            const float mk = (s0 + i - 3 + k >= 0) ? 1.0f : 0.0f;
            const f32x4 w0 = w04[k] * mk, w1 = w14[k] * mk; const u32x4 xv = xv4[k];
            x0[0] += w0[0] * blo(xv[0]); x0[1] += w0[1] * bhi(xv[0]); x0[2] += w0[2] * blo(xv[1]); x0[3] += w0[3] * bhi(xv[1]);
            x1[0] += w1[0] * blo(xv[2]); x1[1] += w1[1] * bhi(xv[2]); x1[2] += w1[2] * blo(xv[3]); x1[3] += w1[3] * bhi(xv[3]);
        }
        u32x4 o; o.x = pk2(x0[0], x0[1]); o.y = pk2(x0[2], x0[3]); o.z = pk2(x1[0], x1[1]); o.w = pk2(x1[2], x1[3]);
        *(LAS u32x4*)(Xs + i * 136 + c8) = o;
        *(LAS f32x4*)(Xf + i * 128 + c8) = x0; *(LAS f32x4*)(Xf + i * 128 + c8 + 4) = x1;
    }
    __syncthreads();
    const int mf = wid & 3, nh = wid >> 2;
    f32x4 accA[4], accX[4];
#pragma unroll
    for (int nf = 0; nf < 4; ++nf) { accA[nf] = (f32x4){0.f, 0.f, 0.f, 0.f}; accX[nf] = (f32x4){0.f, 0.f, 0.f, 0.f}; }
    __builtin_amdgcn_sched_barrier(0);
#pragma unroll
    for (int half = 0; half < 2; ++half) {
        bf16x8 xa[2], wa_[2][4], wx_[2][4];
#pragma unroll
        for (int kk = 0; kk < 2; ++kk) {
            const int k0 = (half * 2 + kk) * 32;
            xa[kk] = *(const LAS bf16x8*)(Xs + (16 * mf + fr) * 136 + k0 + fq * 8);
#pragma unroll
            for (int nf = 0; nf < 4; ++nf) {
                wa_[kk][nf] = *(const LAS bf16x8*)(Wa + (64 * nh + 16 * nf + fr) * 136 + k0 + fq * 8);
                wx_[kk][nf] = *(const LAS bf16x8*)(Wx + (64 * nh + 16 * nf + fr) * 136 + k0 + fq * 8);
            }
        }
#pragma unroll
        for (int kk = 0; kk < 2; ++kk)
#pragma unroll
            for (int nf = 0; nf < 4; ++nf) { accA[nf] = MFMA16(xa[kk], wa_[kk][nf], accA[nf]); accX[nf] = MFMA16(xa[kk], wx_[kk][nf], accX[nf]); }
        __builtin_amdgcn_sched_group_barrier(0x100, 18, 0); __builtin_amdgcn_sched_group_barrier(0x008, 16, 0);
        __builtin_amdgcn_sched_barrier(0);
    }
    __syncthreads();
#pragma unroll
    for (int nf = 0; nf < 4; ++nf) {
        const int d = 64 * nh + 16 * nf + fr;
        const float ba = pba[nf], bx = pbx[nf], lam = plam[nf];
        const float em = __expf(-fabsf(lam));
        const float l1p = em < 0.01f ? em * (1.0f - em * (0.5f - em * 0.33333334f)) : __logf(1.0f + em);
        const float sp = fmaxf(-lam, 0.0f) + l1p;
#pragma unroll
        for (int j = 0; j < 4; ++j) {
            const int i = 16 * mf + 4 * fq + j;
            const float r = sigmoidf_(accA[nf][j] + ba), ig = sigmoidf_(accX[nf][j] + bx);
            const float la = -8.0f * r * sp;
            As_[i * 128 + d] = __expf(la);
            const float x2 = 2.0f * la;
            const float om = x2 > -0.1f ? -x2 * (1.0f + x2 * (0.5f + x2 * (0.16666667f + x2 * 0.041666668f))) : 1.0f - __expf(x2);
            Bs_[i * 128 + d] = sqrtf(om) * (ig * Xf[i * 128 + d]);
        }
    }
    __syncthreads();
    {
        const int d = tid & 127, q = tid >> 7;
        float h = 0.f, A = 1.f;
#pragma unroll 4
        for (int ii = 0; ii < 16; ++ii) { const int i = 16 * q + ii; const float a = As_[i * 128 + d]; h = a * h + Bs_[i * 128 + d]; A *= a; }
        Cq[(q * 128 + d) * 2] = A; Cq[(q * 128 + d) * 2 + 1] = h;
        __syncthreads();
        float hin = 0.f, Ain = 1.f;
        for (int qq = 0; qq < q; ++qq) { const float Aq = Cq[(qq * 128 + d) * 2], hq = Cq[(qq * 128 + d) * 2 + 1]; hin = Aq * hin + hq; Ain *= Aq; }
        h = hin; A = Ain;
        bf16_t* hl = (bf16_t*)(ws + WS_HLOC) + (size_t)t0 * 1024 + nb * 128 + d;
        bf16_t* ac = (bf16_t*)(ws + WS_ACUM) + (size_t)t0 * 1024 + nb * 128 + d;
#pragma unroll 4
        for (int ii = 0; ii < 16; ++ii) {
            const int i = 16 * q + ii; const float a = As_[i * 128 + d]; h = a * h + Bs_[i * 128 + d]; A *= a;
            hl[(size_t)i * 1024] = f2bf(h); ac[(size_t)i * 1024] = f2bf(A);
        }
        if (q == 3) {
            float* lt = (float*)(ws + WS_LTOT) + (size_t)(b * 32 + n) * 1024 + nb * 128 + d;
            lt[0] = A; lt[(size_t)128 * 1024] = h;
        }
    }
}

__device__ void lru_out_item(KP p, int item) {
    char* ws = p->ws;
    int tid = threadIdx.x; asm volatile("" : "+v"(tid));
    const int n = item & 31, b = item >> 5, t0 = b * 2048 + n * 64, ch = tid * 2;
    const bf16_t* hl = (const bf16_t*)(ws + WS_HLOC); const bf16_t* ac = (const bf16_t*)(ws + WS_ACUM);
    const float* lt = (const float*)(ws + WS_LTOT);
    const bf16_t* proj = (const bf16_t*)(ws + WS_PROJ);
    bf16_t* ycat = (bf16_t*)(ws + WS_YCAT);
    f32x2 carry = (f32x2){0.f, 0.f};
    for (int m0 = 0; m0 < n; m0 += 8) {
        f32x2 A2[8], H2[8];
#pragma unroll
        for (int u = 0; u < 8; ++u) {
            const int m = (m0 + u < n) ? (m0 + u) : (n - 1);
            const size_t tl = (size_t)(b * 32 + m) * 1024 + ch;
            A2[u] = *(const f32x2*)(lt + tl); H2[u] = *(const f32x2*)(lt + (size_t)128 * 1024 + tl);
        }
#pragma unroll
        for (int u = 0; u < 8; ++u) if (m0 + u < n) carry = A2[u] * carry + H2[u];
    }
    for (int i0 = 0; i0 < 64; i0 += 8) {
        unsigned h2[8], a2[8], gw[8];
#pragma unroll
        for (int u = 0; u < 8; ++u) {
            const size_t t = t0 + i0 + u;
            h2[u] = *(const unsigned*)(hl + t * 1024 + ch); a2[u] = *(const unsigned*)(ac + t * 1024 + ch);
            gw[u] = *(const unsigned*)(proj + t * LDP + 5120 + ch);
        }
#pragma unroll
        for (int u = 0; u < 8; ++u) {
            const size_t t = t0 + i0 + u;
            const float y0 = blo(h2[u]) + blo(a2[u]) * carry.x, y1 = bhi(h2[u]) + bhi(a2[u]) * carry.y;
            *(unsigned*)(ycat + t * 3072 + 1024 + ch) = pk2(y0 * blo(gw[u]), y1 * bhi(gw[u]));
        }
    }
}

__device__ void attn_item(LAS char* lds, KP p, int b, int h, int Pp) {
    char* ws = p->ws;
    int tid = threadIdx.x; asm volatile("" : "+v"(tid)); const int wid = tid >> 6, lane = tid & 63, fr = lane & 15, fq = lane >> 4;
    LAS bf16_t* Pw = (LAS bf16_t*)(lds + 81920 + wid * 4608);
    const bf16_t* qm = (const bf16_t*)(ws + WS_QM);
    const bf16_t* kn = (const bf16_t*)(ws + WS_KN) + (size_t)(b * 8 + h) * 2048 * 128;
    const bf16_t* kr = (const bf16_t*)(ws + WS_KROPE) + (size_t)b * 2048 * 64;
    const bf16_t* vt = (const bf16_t*)(ws + WS_VT) + (size_t)(b * 8 + h) * 128 * 2048;
    const int s0 = Pp * 256 + wid * 32, nkt = 4 * Pp + 4, qc = 4 * Pp + (wid >> 1);
    bf16x8 qf[2][6];
#pragma unroll
    for (int mi = 0; mi < 2; ++mi)
#pragma unroll
        for (int ks = 0; ks < 6; ++ks) qf[mi][ks] = *(const bf16x8*)(qm + ((size_t)((b * 8 + h) * 2048 + s0 + 16 * mi + fr)) * 192 + ks * 32 + fq * 8);
    f32x4 o[2][8];
#pragma unroll
    for (int mi = 0; mi < 2; ++mi)
#pragma unroll
        for (int nd = 0; nd < 8; ++nd) o[mi][nd] = (f32x4){0.f, 0.f, 0.f, 0.f};
    float mrow[2][4], lsum[2][4];
#pragma unroll
    for (int mi = 0; mi < 2; ++mi)
#pragma unroll
        for (int j = 0; j < 4; ++j) { mrow[mi][j] = -1e30f; lsum[mi][j] = 0.f; }
    const bf16_t* ksrc[3]; int kstep[3];
#pragma unroll
    for (int r = 0; r < 3; ++r) {
        const int q = tid + 512 * r, row = q / 24, pc = q - row * 24, lc = pc ^ (row & 7);
        if (lc < 16) { ksrc[r] = kn + (size_t)row * 128 + lc * 8; kstep[r] = 64 * 128; } else { ksrc[r] = kr + (size_t)row * 64 + (lc - 16) * 8; kstep[r] = 64 * 64; }
    }
    const bf16_t* vsrc[2];
#pragma unroll
    for (int r = 0; r < 2; ++r) { const int q = tid + 512 * r, d = q >> 3, pc = q & 7; vsrc[r] = vt + (size_t)d * 2048 + ((pc ^ (d & 7)) * 8); }
    const int ldsw = wid * 1024;
#define ATT_STAGE(kt, buf) do { _Pragma("unroll") for (int r_ = 0; r_ < 3; ++r_) \
        __builtin_amdgcn_global_load_lds((const unsigned*)(ksrc[r_] + (size_t)(kt) * kstep[r_]), (LAS unsigned*)(lds + (buf) * 24576 + ldsw + r_ * 8192), 16, 0, 0); \
      _Pragma("unroll") for (int r_ = 0; r_ < 2; ++r_) \
        __builtin_amdgcn_global_load_lds((const unsigned*)(vsrc[r_] + (kt) * 64), (LAS unsigned*)(lds + 49152 + (buf) * 16384 + ldsw + r_ * 8192), 16, 0, 0); } while (0)
    const int f7 = fr & 7, xq = fq ^ (f7 & 3), yq = f7 >> 2;
    const int ka0 = fr * 384 + xq * 16 + yq * 64, ka1 = fr * 384 + xq * 16 + (1 - yq) * 64;
    const int va0 = fr * 128 + xq * 16 + yq * 64, va1 = fr * 128 + xq * 16 + (1 - yq) * 64;
    __syncthreads();
    ATT_STAGE(0, 0); WAIT_V0(); __syncthreads();
    for (int kt = 0; kt < nkt; ++kt) {
        const int cur = kt & 1;
        if (kt + 1 < nkt) ATT_STAGE(kt + 1, cur ^ 1);
        if (kt <= qc) {
            const LAS char* Kb = (const LAS char*)(lds + cur * 24576);
            const LAS char* Vb = (const LAS char*)(lds + 49152 + cur * 16384);
            f32x4 s[2][4];
#pragma unroll
            for (int mi = 0; mi < 2; ++mi)
#pragma unroll
                for (int n = 0; n < 4; ++n) s[mi][n] = (f32x4){0.f, 0.f, 0.f, 0.f};
            __builtin_amdgcn_sched_barrier(0);
            __builtin_amdgcn_s_setprio(1);
            {
                bf16x8 kf[6][4];
#pragma unroll
                for (int ks = 0; ks < 6; ++ks)
#pragma unroll
                    for (int n = 0; n < 4; ++n) kf[ks][n] = *(const LAS bf16x8*)(Kb + ((ks & 1) ? ka1 : ka0) + n * 6144 + (ks >> 1) * 128);
#pragma unroll
                for (int ks = 0; ks < 6; ++ks)
#pragma unroll
                    for (int n = 0; n < 4; ++n) { s[0][n] = MFMA16(qf[0][ks], kf[ks][n], s[0][n]); s[1][n] = MFMA16(qf[1][ks], kf[ks][n], s[1][n]); }
                __builtin_amdgcn_sched_group_barrier(0x100, 8, 0);
                __builtin_amdgcn_sched_group_barrier(0x008, 8, 0); __builtin_amdgcn_sched_group_barrier(0x100, 4, 0);
                __builtin_amdgcn_sched_group_barrier(0x008, 8, 0); __builtin_amdgcn_sched_group_barrier(0x100, 4, 0);
                __builtin_amdgcn_sched_group_barrier(0x008, 8, 0); __builtin_amdgcn_sched_group_barrier(0x100, 4, 0);
                __builtin_amdgcn_sched_group_barrier(0x008, 8, 0); __builtin_amdgcn_sched_group_barrier(0x100, 4, 0);
                __builtin_amdgcn_sched_group_barrier(0x008, 16, 0);
            }
            __builtin_amdgcn_s_setprio(0);
            __builtin_amdgcn_sched_barrier(0);
#pragma unroll
            for (int mi = 0; mi < 2; ++mi)
#pragma unroll
                for (int j = 0; j < 4; ++j) {
                    float mx = fmaxf(fmaxf(s[mi][0][j], s[mi][1][j]), fmaxf(s[mi][2][j], s[mi][3][j]));
                    mx = row16_max(mx);
                    const float mnew = fmaxf(mrow[mi][j], mx);
                    if (__builtin_amdgcn_ballot_w64(mnew != mrow[mi][j]) != 0ull) {
                        const float alpha = __builtin_amdgcn_exp2f(mrow[mi][j] - mnew);
                        mrow[mi][j] = mnew; lsum[mi][j] *= alpha;
#pragma unroll
                        for (int nd = 0; nd < 8; ++nd) o[mi][nd][j] *= alpha;
                    }
#pragma unroll
                    for (int n = 0; n < 4; ++n) { const float pe = __builtin_amdgcn_exp2f(s[mi][n][j] - mnew); lsum[mi][j] += pe; Pw[(16 * mi + 4 * fq + j) * 72 + n * 16 + fr] = (bf16_t)pk2(pe, 0.f); }
                }
            WAIT_L0(); __builtin_amdgcn_wave_barrier();
            __builtin_amdgcn_sched_barrier(0);
            __builtin_amdgcn_s_setprio(1);
            {
                bf16x8 pa[2][2], vb[2][8];
#pragma unroll
                for (int ks2 = 0; ks2 < 2; ++ks2)
#pragma unroll
                    for (int mi = 0; mi < 2; ++mi) pa[mi][ks2] = *(const LAS bf16x8*)(Pw + (16 * mi + fr) * 72 + ks2 * 32 + fq * 8);
#pragma unroll
                for (int ks2 = 0; ks2 < 2; ++ks2)
#pragma unroll
                    for (int nd = 0; nd < 8; ++nd) vb[ks2][nd] = *(const LAS bf16x8*)(Vb + (ks2 ? va1 : va0) + nd * 2048);
#pragma unroll
                for (int ks2 = 0; ks2 < 2; ++ks2)
#pragma unroll
                    for (int nd = 0; nd < 8; ++nd) { o[0][nd] = MFMA16(pa[0][ks2], vb[ks2][nd], o[0][nd]); o[1][nd] = MFMA16(pa[1][ks2], vb[ks2][nd], o[1][nd]); }
                __builtin_amdgcn_sched_group_barrier(0x100, 12, 0);
                __builtin_amdgcn_sched_group_barrier(0x008, 4, 0); __builtin_amdgcn_sched_group_barrier(0x100, 2, 0);
                __builtin_amdgcn_sched_group_barrier(0x008, 4, 0); __builtin_amdgcn_sched_group_barrier(0x100, 2, 0);
                __builtin_amdgcn_sched_group_barrier(0x008, 4, 0); __builtin_amdgcn_sched_group_barrier(0x100, 2, 0);
                __builtin_amdgcn_sched_group_barrier(0x008, 4, 0); __builtin_amdgcn_sched_group_barrier(0x100, 2, 0);
                __builtin_amdgcn_sched_group_barrier(0x008, 16, 0);
            }
            __builtin_amdgcn_s_setprio(0);
            __builtin_amdgcn_sched_barrier(0);
        }
        WAIT_V0(); __syncthreads();
    }
#undef ATT_STAGE
    const bf16_t* proj = (const bf16_t*)(ws + WS_PROJ);
    bf16_t* ycat = (bf16_t*)(ws + WS_YCAT);
    LAS bf16_t* Ow = (LAS bf16_t*)(lds + wid * 8704);
#pragma unroll
    for (int mi = 0; mi < 2; ++mi)
#pragma unroll
        for (int j = 0; j < 4; ++j) {
            const float ls = row16_sum(lsum[mi][j]);
            const float inv = 1.0f / ls;
#pragma unroll
            for (int nd = 0; nd < 8; ++nd) Ow[(16 * mi + 4 * fq + j) * 136 + nd * 16 + fr] = f2bf(o[mi][nd][j] * inv);
        }
    WAIT_L0(); __builtin_amdgcn_wave_barrier();
#pragma unroll
    for (int r = 0; r < 8; ++r) {
        const int q = lane + 64 * r, row = q >> 4, c8 = (q & 15) * 8;
        const size_t t = (size_t)b * 2048 + s0 + row;
        const u32x4 ov = *(const LAS u32x4*)(Ow + row * 136 + c8);
        const u32x4 gv = *(const u32x4*)(proj + t * LDP + 7168 + h * 128 + c8);
        u32x4 y;
#pragma unroll
        for (int e = 0; e < 4; ++e) y[e] = pk2(blo(ov[e]) * blo(gv[e]), bhi(ov[e]) * bhi(gv[e]));
        *(u32x4*)(ycat + t * 3072 + 2048 + h * 128 + c8) = y;
    }
}

#define XB_TMO      128
#define XB_XCNT(j)  (256  + 64 * (j))
#define XB_XSUB(j)  (1280 + 64 * (j))
#define XB_XGEN(j)  (2304 + 64 * (j))
#define XB_TOP      3328
#define XB_TOPGEN   3392
#define XCD_BAR_WORDS 3456
#define XB_SPIN_CAP (1u << 18)
__device__ __forceinline__ unsigned xb_ld(unsigned* p)              { return __hip_atomic_load(p, __ATOMIC_RELAXED, __HIP_MEMORY_SCOPE_AGENT); }
__device__ __forceinline__ unsigned xb_add(unsigned* p, unsigned v) { return __hip_atomic_fetch_add(p, v, __ATOMIC_RELAXED, __HIP_MEMORY_SCOPE_AGENT); }
__device__ __forceinline__ unsigned xb_xcc_id() { return (unsigned)__builtin_amdgcn_s_getreg((3 << 11) | 20) & 0xFu; }
#define XB_SPIN(cond, bar) do { unsigned _sp = 0; while (cond) { __builtin_amdgcn_s_sleep(1); \
    if ((++_sp & 255u) == 0u) { if (xb_ld(&(bar)[XB_TMO])) break; if (_sp > XB_SPIN_CAP) { atomicAdd(&(bar)[XB_TMO], 1u); break; } } } } while (0)
struct XcdBarrier { unsigned* bar; unsigned x; volatile LAS unsigned* st; };
__device__ __forceinline__ XcdBarrier xcd_barrier_post(unsigned* bar, volatile LAS unsigned* st) {
    XcdBarrier b; b.bar = bar; b.x = xb_xcc_id(); b.st = st;
    if (threadIdx.x == 0) (void)xb_add(&bar[XB_XCNT(b.x)], 1u);
    return b;
}
__device__ __forceinline__ void xcd_barrier_complete(unsigned* bar, unsigned x, unsigned& nloc, unsigned& nx) {
    const unsigned G = gridDim.x * gridDim.y * gridDim.z;
    unsigned sum, cnt, mine, sp = 0u;
    for (;;) {
        sum = 0u; cnt = 0u; mine = 0u;
#pragma unroll
        for (unsigned j = 0; j < 16; ++j) { const unsigned c = xb_ld(&bar[XB_XCNT(j)]); sum += c; cnt += (c > 0u) ? 1u : 0u; mine = (j == x) ? c : mine; }
        if (sum == G) break;
        __builtin_amdgcn_s_sleep(1);
        if ((++sp & 255u) == 0u) { if (xb_ld(&bar[XB_TMO])) break; if (sp > XB_SPIN_CAP) { atomicAdd(&bar[XB_TMO], 1u); break; } }
    }
    nloc = mine > 0u ? mine : 1u; nx = cnt > 0u ? cnt : 1u;
}
__device__ __forceinline__ void xcd_barrier(const XcdBarrier& b) {
    asm volatile("s_waitcnt vmcnt(0)" ::: "memory");
    __syncthreads();
    if (threadIdx.x == 0) {
        unsigned* bar = b.bar; asm volatile("" : "+s"(bar));
        __builtin_amdgcn_s_waitcnt(0);
        unsigned nloc = b.st[0], nx = b.st[1];
        if (nloc == 0u) { xcd_barrier_complete(bar, b.x, nloc, nx); b.st[0] = nloc; b.st[1] = nx; }
        const unsigned old = xb_add(&bar[XB_XSUB(b.x)], 1u);
        const unsigned gen = old / nloc;
        if (old + 1u == (gen + 1u) * nloc) {
            __builtin_amdgcn_fence(__ATOMIC_RELEASE, "agent");
            asm volatile("s_waitcnt vmcnt(0)" ::: "memory");
            const unsigned og = xb_add(&bar[XB_TOP], 1u);
            const unsigned tg = og / nx;
            if (og + 1u == (tg + 1u) * nx) xb_add(&bar[XB_TOPGEN], 1u);
            else XB_SPIN(xb_ld(&bar[XB_TOPGEN]) == tg, bar);
            __builtin_amdgcn_fence(__ATOMIC_ACQUIRE, "agent");
            xb_add(&bar[XB_XGEN(b.x)], 1u);
            asm volatile("s_waitcnt vmcnt(0)" ::: "memory");
        } else {
            XB_SPIN(xb_ld(&bar[XB_XGEN(b.x)]) == gen, bar);
            __builtin_amdgcn_fence(__ATOMIC_ACQUIRE, "agent");
            asm volatile("s_waitcnt vmcnt(0)" ::: "memory");
        }
    }
    __syncthreads();
}

#define Q_BEGIN(ctrp) unsigned* qctr_ = (ctrp); volatile LAS int* qslot_ = (volatile LAS int*)(lds + 131072 + 8); int qnxt_ = 0
#define Q_ISSUE() do { int r_ = 0; if (threadIdx.x == 0) r_ = (int)__hip_atomic_fetch_add(qctr_, 1u, __ATOMIC_RELAXED, __HIP_MEMORY_SCOPE_AGENT); qnxt_ = r_; } while (0)
#define Q_TAKE(it) do { __syncthreads(); if (threadIdx.x == 0) *qslot_ = G + qnxt_; __syncthreads(); (it) = *qslot_; } while (0)

__global__ void __launch_bounds__(512) fwd_megakernel(Params parg) {
    __shared__ __attribute__((aligned(1024))) char shm[131072 + 16];
    LAS char* lds = (LAS char*)shm;
    const int G = gridDim.x, c = blockIdx.x;
    volatile LAS unsigned* xst = (volatile LAS unsigned*)(lds + 131072);
    unsigned* xbar = (unsigned*)(parg.ws + WS_BAR);
    if (threadIdx.x == 0) { xst[0] = 0u; xst[1] = 0u; }
    __syncthreads();
    XcdBarrier xb = xcd_barrier_post(xbar, xst);
    if (parg.ph_lo > 1000) cg::this_grid().sync();
#define GRID_SYNC() xcd_barrier(xb)
    for (int ph = parg.ph_lo; ph < parg.ph_hi; ++ph) {
      const int ptype = ph < 2 ? ph : 2 + (ph - 2) % 6;
      const int nrep = 1 + ((REPMASK >> ptype) & 1);
      for (int rep = 0; rep < nrep; ++rep) {
        if (rep) GRID_SYNC();
        const bool skip_epi = VAR_NOEPI && (rep + 1 < nrep);
        KP p = get_kp();
        char* ws = p->ws;
        if (ph == 0) {
            if (PMASK & 1) phase0(lds, p);
        } else if (ph == 1) {
            if (PMASK & 2) rowpass(p, -1);
        } else {
            const int l = (ph - 2) / 6, sub = (ph - 2) % 6;
            if (sub == 0 && (PMASK & 4)) {
                const bf16_t* A = (const bf16_t*)(ws + WS_HBUF);
                const bf16_t* Bt = (const bf16_t*)(ws + WS_WI) + (size_t)l * NP1 * 2048;
                for (int L = c; L < 32 * 56; L += G) {
                    int pm, pn; tile_map(L, 32, 56, pm, pn);
                    f32x4 acc[8][4];
                    gemm256(lds, A + (size_t)pm * 256 * 2048, 2048, Bt + (size_t)pn * 256 * 2048, 2048, 2048, acc);
                    OPAQUE_WS(wx); EPI_IDS;
                    EpiProj e{(bf16_t*)(wx + WS_PROJ), (bf16_t*)(wx + WS_KROPE), (float*)(wx + WS_RSQ), (const float*)(wx + WS_COSR), (const float*)(wx + WS_SINR),
                              (const float*)(wx + WS_COSM), (const float*)(wx + WS_SINM), pm * 256, pn * 256};
                    const int bc_ = pn * 256;
                    const int act_ = (bc_ >= 8192) ? 2 : ((bc_ >= 3072 && bc_ < 4096) || (bc_ >= 5120 && bc_ < 6144) || (bc_ >= 7168 && bc_ < 8192)) ? 1
                                   : ((bc_ >= 2048 && bc_ < 3072) || (bc_ >= 4096 && bc_ < 5120)) ? 0 : -1;
                    if (act_ >= 0) epi_proj_staged(lds, acc, (bf16_t*)(wx + WS_PROJ), pm * 256, bc_, act_, wid_, lane_);
                    else if (!skip_epi) e(acc, wr_, wc_, fr_, fq_);
                }
            } else if (sub == 1 && (PMASK & 8)) {
                Q_BEGIN(xbar + 3520 + (ph * 2 + rep) * 8);
                const int nP2 = 32 + 192 + 256 + 256 + 1024 + (l + 1 < DEPTH ? 324 : 0);
                for (int it = c; it < nP2;) {
                    KP p = get_kp(); char* ws = p->ws;
                    if (it >= 480) Q_ISSUE();
                    if (it < 32) {
                        const int pm = it;
                        f32x4 acc[8][4];
                        gemm256(lds, (const bf16_t*)(ws + WS_HBUF) + (size_t)pm * 256 * 2048, 2048, (const bf16_t*)(ws + WS_WI) + (size_t)l * NP1 * 2048 + (size_t)14336 * 2048, 2048, 2048, acc);
                        Q_ISSUE();
                        OPAQUE_WS(wx); EPI_IDS;
                        EpiProj e{(bf16_t*)(wx + WS_PROJ), (bf16_t*)(wx + WS_KROPE), (float*)(wx + WS_RSQ), (const float*)(wx + WS_COSR), (const float*)(wx + WS_SINR),
                                  (const float*)(wx + WS_COSM), (const float*)(wx + WS_SINM), pm * 256, 14336};
                        if (!skip_epi) e(acc, wr_, wc_, fr_, fq_);
                    } else if (it < 224) {
                        const int i2 = it - 32, pm = i2 & 31, pn = i2 >> 5;
                        f32x4 acc[8][4];
                        gemm256(lds, (const bf16_t*)(ws + WS_PROJ) + (size_t)pm * 256 * LDP + 6144, LDP, (const bf16_t*)(ws + WS_WUQ) + (size_t)l * 1536 * 512 + (size_t)pn * 256 * 512, 512, 512, acc);
                        Q_ISSUE();
                        OPAQUE_WS(wx); EPI_IDS;
                        EpiQ e{(bf16_t*)(wx + WS_QM), (const float*)(wx + WS_RSQ), (const float*)(wx + WS_COSM), (const float*)(wx + WS_SINM), pm * 256, pn * 256};
                        if (!skip_epi) e(acc, wr_, wc_, fr_, fq_);
                    } else if (it < 480) {
                        const int i2 = it - 224, pm = i2 & 31, pn = i2 >> 5;
                        f32x4 acc[8][4];
                        gemm256(lds, (const bf16_t*)(ws + WS_PROJ) + (size_t)pm * 256 * LDP + 6656, LDP, (const bf16_t*)(ws + WS_WUKV) + (size_t)l * 2048 * 512 + (size_t)pn * 256 * 512, 512, 512, acc);
                        Q_ISSUE();
                        OPAQUE_WS(wx); EPI_IDS;
                        EpiKV e{(bf16_t*)(wx + WS_KN), (bf16_t*)(wx + WS_VT), (const float*)(wx + WS_RSQ), pm * 256, pn};
                        if (!skip_epi) e(acc, wr_, wc_, fr_, fq_);
                    } else if (it < 736) {
                        ret_item<false>(lds, p, l, it - 480);
                    } else if (it < 1760) {
                        lru_item(lds, p, l, it - 736);
                    } else {
                        conv4(lds, p, (l + 1) * 2592 + (it - 1760) * 4);
                    }
                    Q_TAKE(it);
                }
            } else if (sub == 2 && (PMASK & 16)) {
                Q_BEGIN(xbar + 3520 + (ph * 2 + rep) * 8);
                const int nP3 = 256 + 256 + 128 + (l + 1 < DEPTH ? 324 : 0);
                for (int it = c; it < nP3;) {
                    KP p = get_kp();
                    Q_ISSUE();
                    if (it < 256) {
                        const int bh = it & 31, Pp = 7 - (it >> 5);
                        attn_item(lds, p, bh >> 3, bh & 7, Pp);
                    } else if (it < 512) {
                        ret_item<true>(lds, p, l, it - 256);
                    } else if (it < 640) {
                        lru_out_item(p, it - 512);
                    } else {
                        conv4(lds, p, (l + 1) * 2592 + 1296 + (it - 640) * 4);
                    }
                    Q_TAKE(it);
                }
            } else if (sub == 3 && (PMASK & 32)) {
                for (int L = c; L < 256; L += G) {
                    int pm, pn; tile_map(L, 32, 8, pm, pn);
                    f32x4 acc[8][4];
#pragma unroll
                    for (int m_ = 0; m_ < 8; ++m_)
#pragma unroll
                        for (int n_ = 0; n_ < 4; ++n_) acc[m_][n_] = (f32x4){0.f, 0.f, 0.f, 0.f};
#pragma unroll 1
                    for (int i = 0; i < 3; ++i) {
                        gemm256(lds, (const bf16_t*)(ws + WS_YCAT) + (size_t)pm * 256 * 3072 + i * 1024, 3072,
                                (const bf16_t*)(ws + WS_WB) + (size_t)l * 2048 * 3072 + (size_t)pn * 256 * 3072 + i * 1024, 3072, 1024, acc, false);
                        OPAQUE_WS(wx); EPI_IDS;
                        EpiBranch e{(const bf16_t*)(wx + WS_PROJ) + 8192, (bf16_t*)(wx + WS_MERGED), i, pm * 256, pn * 256};
                        if (!skip_epi || i < 2) e(acc, wr_, wc_, fr_, fq_);
                    }
                }
            } else if (sub == 4 && (PMASK & 64)) {
                for (int L = c; L < 256; L += G) {
                    int pm, pn; tile_map(L, 32, 8, pm, pn);
                    f32x4 acc[8][4];
                    gemm256(lds, (const bf16_t*)(ws + WS_MERGED) + (size_t)pm * 256 * 2048, 2048, (const bf16_t*)(ws + WS_WO) + (size_t)l * 2048 * 2048 + (size_t)pn * 256 * 2048, 2048, 2048, acc);
                    OPAQUE_WS(wx); EPI_IDS;
                    EpiOut e{(bf16_t*)(wx + WS_YBUF), pm * 256, pn * 256};
                    if (!skip_epi) e(acc, wr_, wc_, fr_, fq_);
                }
            } else if (sub == 5 && (PMASK & 128)) {
                rowpass(p, l);
            }
        }
      }
        if (ph + 1 < parg.ph_hi) GRID_SYNC();
    }
}

extern "C" void kernel_launch(void* const* d_in, const int* in_sizes, int n_in, void* d_out, int out_size, void* d_ws, size_t ws_size, hipStream_t stream) {
    static int grid_blocks = 0;
    if (!grid_blocks) {
        int dev = 0, cus = 0, per_cu = 0;
        hipGetDevice(&dev);
        hipDeviceGetAttribute(&cus, hipDeviceAttributeMultiprocessorCount, dev);
        hipOccupancyMaxActiveBlocksPerMultiprocessor(&per_cu, fwd_megakernel, 512, 0);
        if (per_cu < 1) { fprintf(stderr, "kernel_launch: occupancy query returned %d\n", per_cu); per_cu = 1; }
        if (per_cu > 1) per_cu = 1;
        grid_blocks = cus * per_cu;
        if (ws_size < WS_END) fprintf(stderr, "kernel_launch: workspace too small: %zu < %zu\n", ws_size, (size_t)WS_END);
    }
    if (n_in != 22 || ws_size < WS_END) return;
    Params p{};
    for (int i = 0; i < 22; ++i) p.in[i] = (const float*)d_in[i];
    p.pos = (const int*)d_in[2];
    p.out = (float*)d_out;
    p.ws = (char*)d_ws;
    constexpr int NPH = 2 + 6 * DEPTH;
#if MULTI_LAUNCH
    for (int ph = 0; ph < NPH; ++ph) {
        p.ph_lo = ph; p.ph_hi = ph + 1;
        hipLaunchKernelGGL(fwd_megakernel, dim3(grid_blocks), dim3(512), 0, stream, p);
    }
#else
    p.ph_lo = 0; p.ph_hi = NPH;
    if (hipMemsetAsync((char*)d_ws + WS_BAR, 0, 4096 * 4, stream) != hipSuccess) { fprintf(stderr, "kernel_launch: hipMemsetAsync failed\n"); return; }
    void* args[] = {&p};
    hipError_t e = hipLaunchCooperativeKernel((void*)fwd_megakernel, dim3(grid_blocks), dim3(512), args, 0, stream);
    if (e != hipSuccess) fprintf(stderr, "cooperative launch failed: %s (grid %d)\n", hipGetErrorString(e), grid_blocks);
#endif
}
```

```cpp
#include <hip/hip_runtime.h>
#include <hip/hip_cooperative_groups.h>
#include <cstdio>
namespace cg = cooperative_groups;

#ifndef MULTI_LAUNCH
#define MULTI_LAUNCH 0
#endif

#ifndef PMASK
#define PMASK 0xff
#endif
#ifndef VAR_NOEPI
#define VAR_NOEPI 0
#endif
#ifndef REPMASK
#define REPMASK 0
#endif
#define LAS __attribute__((address_space(3)))
typedef unsigned short bf16_t;
typedef short bf16x8 __attribute__((ext_vector_type(8)));
typedef float f32x4 __attribute__((ext_vector_type(4)));
typedef float f32x2 __attribute__((ext_vector_type(2)));
typedef unsigned u32x4 __attribute__((ext_vector_type(4)));
typedef unsigned u32x2 __attribute__((ext_vector_type(2)));

constexpr int T = 8192, D = 2048, SEQ = 2048, DEPTH = 4;
constexpr int LDP = 14336;
constexpr int NP1 = 14592;
constexpr int NIN = 14400;
constexpr float EPS = 1e-6f;
constexpr float QSCALE = 0.07216878364870322f * 1.4426950408889634f;
constexpr float RQSCALE = 0.08838834764831845f;

constexpr size_t al256(size_t x) { return (x + 255) & ~(size_t)255; }
constexpr size_t WS_WI = 0;
constexpr size_t WS_WUQ = WS_WI + al256((size_t)DEPTH * NP1 * 2048 * 2);
constexpr size_t WS_WUKV = WS_WUQ + al256((size_t)DEPTH * 1536 * 512 * 2);
constexpr size_t WS_WB = WS_WUKV + al256((size_t)DEPTH * 2048 * 512 * 2);
constexpr size_t WS_WO = WS_WB + al256((size_t)DEPTH * 2048 * 3072 * 2);
constexpr size_t WS_WA = WS_WO + al256((size_t)DEPTH * 2048 * 2048 * 2);
constexpr size_t WS_WX = WS_WA + al256((size_t)DEPTH * 8 * 128 * 128 * 2);
constexpr size_t WS_MOD = WS_WX + al256((size_t)DEPTH * 8 * 128 * 128 * 2);
constexpr size_t WS_COSR = WS_MOD + al256((size_t)DEPTH * 4 * 6144 * 4);
constexpr size_t WS_SINR = WS_COSR + al256((size_t)T * 64 * 4);
constexpr size_t WS_COSM = WS_SINR + al256((size_t)T * 64 * 4);
constexpr size_t WS_SINM = WS_COSM + al256((size_t)T * 32 * 4);
constexpr size_t WS_XCUR = WS_SINM + al256((size_t)T * 32 * 4);
constexpr size_t WS_HBUF = WS_XCUR + al256((size_t)T * D * 4);
constexpr size_t WS_PROJ = WS_HBUF + al256((size_t)T * D * 2);
constexpr size_t WS_KROPE = WS_PROJ + al256((size_t)T * LDP * 2);
constexpr size_t WS_RSQ = WS_KROPE + al256((size_t)T * 64 * 2);
constexpr size_t WS_QM = WS_RSQ + al256((size_t)T * 16 * 4);
constexpr size_t WS_KN = WS_QM + al256((size_t)T * 8 * 192 * 2);
constexpr size_t WS_VT = WS_KN + al256((size_t)T * 8 * 128 * 2);
constexpr size_t WS_TOT = WS_VT + al256((size_t)T * 8 * 128 * 2);
constexpr size_t WS_HLOC = WS_TOT + al256((size_t)4 * 8 * 8 * 16384 * 4);
constexpr size_t WS_ACUM = WS_HLOC + al256((size_t)T * 1024 * 4);
constexpr size_t WS_YCAT = WS_ACUM + al256((size_t)T * 1024 * 4);
constexpr size_t WS_MACC = WS_YCAT + al256((size_t)T * 3072 * 2);
constexpr size_t WS_MERGED = WS_MACC + al256((size_t)T * D * 4);
constexpr size_t WS_YBUF = WS_MERGED + al256((size_t)T * D * 2);
constexpr size_t WS_BAR = WS_YBUF + al256((size_t)T * D * 4);
constexpr size_t WS_LTOT = WS_BAR + al256((size_t)4096 * 4);
constexpr size_t WS_END = WS_LTOT + al256((size_t)2 * 128 * 1024 * 4);

struct Params {
    const float* in[22];
    const int* pos;
    float* out;
    char* ws;
    int ph_lo, ph_hi;
};

typedef const Params __attribute__((address_space(4)))* KP;
__device__ __forceinline__ KP get_kp() { KP k = (KP)__builtin_amdgcn_kernarg_segment_ptr(); asm volatile("" : "+s"(k)); return k; }

__device__ __forceinline__ float bf2f(unsigned h) { return __uint_as_float(h << 16); }
__device__ __forceinline__ bf16_t f2bf(float f) { unsigned u = __float_as_uint(f); return (bf16_t)((u + 0x7fffu + ((u >> 16) & 1u)) >> 16); }
__device__ __forceinline__ unsigned pk2(float lo, float hi) { unsigned r; asm("s_nop 1\n\tv_cvt_pk_bf16_f32 %0, %1, %2" : "=v"(r) : "v"(lo), "v"(hi)); return r; }
__device__ __forceinline__ float blo(unsigned w) { return __uint_as_float(w << 16); }
__device__ __forceinline__ float bhi(unsigned w) { return __uint_as_float(w & 0xffff0000u); }
__device__ __forceinline__ float sigmoidf_(float x) { return __builtin_amdgcn_rcpf(1.0f + __builtin_amdgcn_exp2f(-1.4426950408889634f * x)); }
__device__ __forceinline__ float shx(float v, int lane, int k) { return __int_as_float(__builtin_amdgcn_ds_bpermute((lane ^ k) << 2, __float_as_int(v))); }
__device__ __forceinline__ float dppf(float v, const int ctrl_sel) {
    int r;
    if (ctrl_sel == 0) r = __builtin_amdgcn_update_dpp(0, __float_as_int(v), 0xB1, 0xf, 0xf, true);
    else if (ctrl_sel == 1) r = __builtin_amdgcn_update_dpp(0, __float_as_int(v), 0x4E, 0xf, 0xf, true);
    else if (ctrl_sel == 2) r = __builtin_amdgcn_update_dpp(0, __float_as_int(v), 0x124, 0xf, 0xf, true);
    else r = __builtin_amdgcn_update_dpp(0, __float_as_int(v), 0x128, 0xf, 0xf, true);
    return __int_as_float(r);
}
__device__ __forceinline__ float row16_max(float v) { v = fmaxf(v, dppf(v, 0)); v = fmaxf(v, dppf(v, 1)); v = fmaxf(v, dppf(v, 2)); v = fmaxf(v, dppf(v, 3)); return v; }
__device__ __forceinline__ float row16_sum(float v) { v += dppf(v, 0); v += dppf(v, 1); v += dppf(v, 2); v += dppf(v, 3); return v; }

__device__ __forceinline__ void store4bf(bf16_t* p, f32x4 v) { u32x2 o; o.x = pk2(v[0], v[1]); o.y = pk2(v[2], v[3]); *(u32x2*)p = o; }
__device__ __forceinline__ f32x4 load4bf(const bf16_t* p) { u32x2 w = *(const u32x2*)p; f32x4 r; r[0] = blo(w.x); r[1] = bhi(w.x); r[2] = blo(w.y); r[3] = bhi(w.y); return r; }
#define MFMA16(a, b, c) __builtin_amdgcn_mfma_f32_16x16x32_bf16((a), (b), (c), 0, 0, 0)
#define WAIT_V0() asm volatile("s_waitcnt vmcnt(0)" ::: "memory")
#define WAIT_L0() asm volatile("s_waitcnt lgkmcnt(0)" ::: "memory")

__device__ __forceinline__ int lds_byte2(int r, int c) { int st = (r >> 4) * 2 + (c >> 5), ob = (r & 15) * 64 + (c & 31) * 2; return st * 1024 + (ob ^ (((ob >> 9) & 1) << 5)); }
__device__ __forceinline__ void stage_rc2(int b, int& R, int& C) { int st = b >> 10, sb = b & 1023, swz = sb ^ (((sb >> 9) & 1) << 5); R = (st >> 1) * 16 + swz / 64; C = (st & 1) * 32 + (swz % 64) / 2; }

#define ROWOFF(wr, mi) ((((mi) >> 2) * 128) + (wr) * 64 + (((mi) & 3) * 16))
__device__ __forceinline__ void gemm256(LAS char* lds, const bf16_t* __restrict__ Ab, int lda, const bf16_t* __restrict__ Bb, int ldb, int K, f32x4 (&acc)[8][4], bool zero_acc = true) {
    int tid = threadIdx.x; asm volatile("" : "+v"(tid));
    const int wid = tid >> 6, lane = tid & 63, wr = wid >> 2, wc = wid & 3, fr = lane & 15, fq = lane >> 4;
    unsigned voA[2], voB[2];
#pragma unroll
    for (int i = 0; i < 2; ++i) {
        int R, C; stage_rc2(tid * 16 + i * 8192, R, C);
        voA[i] = (unsigned)(R * lda + C) * 2u;
        { const int rho = R & 31; voB[i] = (unsigned)(((R >> 5) * 64 + 8 * ((rho & 15) >> 2) + 4 * (rho >> 4) + (rho & 3)) * ldb + C) * 2u; }
    }
    const int swz = fr * 64 + ((fq * 16) ^ ((fr >> 3) << 5));
    const int aoff = wr * 8192 + swz, boff = wc * 4096 + swz, ldsw = wid * 1024;
    const size_t ahalf = (size_t)128 * lda * 2, bhalf = (size_t)32 * ldb * 2;
    if (zero_acc) {
#pragma unroll
        for (int m = 0; m < 8; ++m)
#pragma unroll
            for (int n = 0; n < 4; ++n) acc[m][n] = (f32x4){0.f, 0.f, 0.f, 0.f};
    }
#define SAo(b, h) (((b) * 2 + (h)) * 16384)
#define SBo(b, h) ((4 + (b) * 2 + (h)) * 16384)
#define STAGE_A(b, h, kt) do { const char* g_ = (const char*)Ab + (h) * ahalf + (size_t)(kt) * 128; _Pragma("unroll") for (int i_ = 0; i_ < 2; ++i_) \
        __builtin_amdgcn_global_load_lds((const unsigned*)(g_ + voA[i_]), (LAS unsigned*)(lds + SAo(b, h) + ldsw + i_ * 8192), 16, 0, 0); } while (0)
#define STAGE_B(b, h, kt) do { const char* g_ = (const char*)Bb + (h) * bhalf + (size_t)(kt) * 128; _Pragma("unroll") for (int i_ = 0; i_ < 2; ++i_) \
        __builtin_amdgcn_global_load_lds((const unsigned*)(g_ + voB[i_]), (LAS unsigned*)(lds + SBo(b, h) + ldsw + i_ * 8192), 16, 0, 0); } while (0)
#define LDA(dst, b, h) _Pragma("unroll") for (int m_ = 0; m_ < 4; ++m_) _Pragma("unroll") for (int k_ = 0; k_ < 2; ++k_) \
        dst[m_][k_] = *(const LAS bf16x8*)(lds + SAo(b, h) + aoff + m_ * 2048 + k_ * 1024)
#define LDB(dst, b, h) _Pragma("unroll") for (int n_ = 0; n_ < 2; ++n_) _Pragma("unroll") for (int k_ = 0; k_ < 2; ++k_) \
        dst[n_][k_] = *(const LAS bf16x8*)(lds + SBo(b, h) + boff + n_ * 2048 + k_ * 1024)
#define MMA(ai, bj, A_, B_) do { __builtin_amdgcn_s_setprio(1); \
        _Pragma("unroll") for (int m_ = 0; m_ < 4; ++m_) _Pragma("unroll") for (int n_ = 0; n_ < 2; ++n_) _Pragma("unroll") for (int k_ = 0; k_ < 2; ++k_) \
            acc[(ai) * 4 + m_][(bj) * 2 + n_] = MFMA16(B_[n_][k_], A_[m_][k_], acc[(ai) * 4 + m_][(bj) * 2 + n_]); \
        __builtin_amdgcn_s_setprio(0); } while (0)
#define WAIT_V(n) asm volatile("s_waitcnt vmcnt(" #n ")" ::: "memory")
#define WAIT_L(n) asm volatile("s_waitcnt lgkmcnt(" #n ")" ::: "memory")
#define BAR __builtin_amdgcn_s_barrier()
#define SCHED __builtin_amdgcn_sched_barrier(0)
    bf16x8 At[4][2], B0[2][2], B1[2][2];
    const int nt = K >> 6;
    __syncthreads();
    STAGE_B(0, 0, 0); STAGE_A(0, 0, 0); STAGE_B(0, 1, 0); STAGE_A(0, 1, 0);
    if (wr == 1) BAR;
    WAIT_V(4); BAR;
    STAGE_B(1, 0, 1); STAGE_A(1, 0, 1); STAGE_B(1, 1, 1);
    WAIT_V(6); BAR;
    for (int t = 0; t < nt - 2; t += 2) {
        LDB(B0, 0, 0); SCHED; LDA(At, 0, 0); STAGE_A(1, 1, t + 1);
        WAIT_L(8); BAR; WAIT_L(0); MMA(0, 0, At, B0); BAR; SCHED;
        LDB(B1, 0, 1); STAGE_B(0, 0, t + 2);
        BAR; WAIT_L(0); MMA(0, 1, At, B1); BAR;
        LDA(At, 0, 1); STAGE_A(0, 0, t + 2);
        BAR; WAIT_L(0); MMA(1, 0, At, B0); BAR; SCHED;
        STAGE_B(0, 1, t + 2);
        WAIT_V(6); BAR; MMA(1, 1, At, B1); BAR;
        LDB(B0, 1, 0); SCHED; LDA(At, 1, 0); STAGE_A(0, 1, t + 2);
        WAIT_L(8); BAR; WAIT_L(0); MMA(0, 0, At, B0); BAR; SCHED;
        LDB(B1, 1, 1); STAGE_B(1, 0, t + 3);
        BAR; WAIT_L(0); MMA(0, 1, At, B1); BAR;
        LDA(At, 1, 1); STAGE_A(1, 0, t + 3);
        BAR; WAIT_L(0); MMA(1, 0, At, B0); BAR; SCHED;
        STAGE_B(1, 1, t + 3);
        WAIT_V(6); BAR; MMA(1, 1, At, B1); BAR;
    }
    { LDB(B0, 0, 0); LDA(At, 0, 0); STAGE_A(1, 1, nt - 1);
      BAR; WAIT_L(0); MMA(0, 0, At, B0); BAR;
      LDB(B1, 0, 1); BAR; WAIT_L(0); MMA(0, 1, At, B1); BAR;
      LDA(At, 0, 1); WAIT_V(4); BAR; WAIT_L(0); MMA(1, 0, At, B0); MMA(1, 1, At, B1); BAR; }
    { LDB(B0, 1, 0); LDA(At, 1, 0); WAIT_V(2); BAR; WAIT_L(0); MMA(0, 0, At, B0); BAR;
      LDB(B1, 1, 1); WAIT_V(0); BAR; WAIT_L(0); MMA(0, 1, At, B1); BAR;
      LDA(At, 1, 1); BAR; WAIT_L(0); MMA(1, 0, At, B0); MMA(1, 1, At, B1); BAR; }
    if (wr == 0) BAR;
#undef SAo
#undef SBo
#undef STAGE_A
#undef STAGE_B
#undef LDA
#undef LDB
#undef MMA
#undef WAIT_V
#undef WAIT_L
#undef BAR
#undef SCHED
}
#define OPAQUE_WS(name) char* name = get_kp()->ws
#define EPI_IDS int tid_ = threadIdx.x; asm volatile("" : "+v"(tid_)); const int wid_ = tid_ >> 6, lane_ = tid_ & 63, wr_ = wid_ >> 2, wc_ = wid_ & 3, fr_ = lane_ & 15, fq_ = lane_ >> 4

__device__ __forceinline__ void tile_map(int L, int nM, int nN, int& pm, int& pn) {
    const int nwg = nM * nN; int wgid = L;
    { const int q = nwg / 8, r = nwg % 8, xcd = wgid % 8, off = wgid / 8; wgid = (xcd < r ? xcd * (q + 1) : r * (q + 1) + (xcd - r) * q) + off; }
    const int nig = 8 * nN, gid = wgid / nig, fm = gid * 8, gsz = (nM - fm) < 8 ? (nM - fm) : 8;
    pm = fm + ((wgid % nig) % gsz); pn = (wgid % nig) / gsz;
}

__device__ __forceinline__ void store8bf(bf16_t* p, f32x4 v0, f32x4 v1) { u32x4 o; o.x = pk2(v0[0], v0[1]); o.y = pk2(v0[2], v0[3]); o.z = pk2(v1[0], v1[1]); o.w = pk2(v1[2], v1[3]); *(u32x4*)p = o; }
__device__ __forceinline__ void load8bf(const bf16_t* p, f32x4& v0, f32x4& v1) { const u32x4 w = *(const u32x4*)p; v0[0] = blo(w.x); v0[1] = bhi(w.x); v0[2] = blo(w.y); v0[3] = bhi(w.y); v1[0] = blo(w.z); v1[1] = bhi(w.z); v1[2] = blo(w.w); v1[3] = bhi(w.w); }
__device__ __forceinline__ f32x4 silu4(f32x4 v) { f32x4 o; for (int j = 0; j < 4; ++j) o[j] = v[j] * sigmoidf_(v[j]); return o; }
__device__ __forceinline__ f32x4 sigm4(f32x4 v) { f32x4 o; for (int j = 0; j < 4; ++j) o[j] = sigmoidf_(v[j]); return o; }
__device__ __forceinline__ float sq4(f32x4 v) { return v[0] * v[0] + v[1] * v[1] + v[2] * v[2] + v[3] * v[3]; }

struct EpiProj {
    bf16_t* proj; bf16_t* krope; float* rsq; const float *cosr, *sinr, *cosm, *sinm; int brow, bcol;
    __device__ __forceinline__ void operator()(f32x4 (&acc)[8][4], int wr, int wc, int fr, int fq) const {
        const int c0 = bcol + wc * 64;
        int type;
        if (bcol < 1024) type = 0; else if (bcol < 2048) type = 1; else if (bcol < 3072) type = 2; else if (bcol < 4096) type = 3;
        else if (bcol < 5120) type = 2; else if (bcol < 6144) type = 3; else if (bcol < 7168) type = 4; else if (bcol < 8192) type = 3;
        else if (bcol < 14336) type = 5; else type = 6;
#pragma unroll
        for (int m = 0; m < 8; ++m) {
            const int t = brow + ROWOFF(wr, m) + fr;
            bf16_t* rowp = proj + (size_t)t * LDP + c0 + 8 * fq;
            if (type == 0 || type == 1) {
                const int blk = (c0 >> 6) & 1; const float sc = type == 0 ? RQSCALE : 1.0f;
                f32x4 o1[2], o2[2];
#pragma unroll
                for (int n = 0; n < 2; ++n) {
                    const int f0 = 32 * blk + 8 * fq + 4 * n;
                    const f32x4 cs = *(const f32x4*)(cosr + (size_t)t * 64 + f0), sn = *(const f32x4*)(sinr + (size_t)t * 64 + f0);
                    const f32x4 x1 = acc[m][n], x2 = acc[m][n + 2];
                    o1[n] = (x1 * cs - x2 * sn) * sc; o2[n] = (x2 * cs + x1 * sn) * sc;
                }
                store8bf(rowp, o1[0], o1[1]); store8bf(rowp + 32, o2[0], o2[1]);
            } else if (type == 2) {
                store8bf(rowp, acc[m][0], acc[m][1]); store8bf(rowp + 32, acc[m][2], acc[m][3]);
            } else if (type == 3) {
                store8bf(rowp, silu4(acc[m][0]), silu4(acc[m][1])); store8bf(rowp + 32, silu4(acc[m][2]), silu4(acc[m][3]));
            } else if (type == 4) {
                float s = sq4(acc[m][0]) + sq4(acc[m][1]) + sq4(acc[m][2]) + sq4(acc[m][3]);
                store8bf(rowp, acc[m][0], acc[m][1]); store8bf(rowp + 32, acc[m][2], acc[m][3]);
                { const int ln_ = fq * 16 + fr; s += shx(s, ln_, 16); s += shx(s, ln_, 32); }
                if (fq == 0) rsq[(size_t)t * 16 + ((c0 - 6144) >> 6)] = s;
            } else if (type == 5) {
                store8bf(rowp, sigm4(acc[m][0]), sigm4(acc[m][1])); store8bf(rowp + 32, sigm4(acc[m][2]), sigm4(acc[m][3]));
            } else {
                if (wc == 0) {
                    f32x4 o1[2], o2[2];
#pragma unroll
                    for (int n = 0; n < 2; ++n) {
                        const int f0 = 8 * fq + 4 * n;
                        const f32x4 cs = *(const f32x4*)(cosm + (size_t)t * 32 + f0), sn = *(const f32x4*)(sinm + (size_t)t * 32 + f0);
                        const f32x4 x1 = acc[m][n], x2 = acc[m][n + 2];
                        o1[n] = x1 * cs - x2 * sn; o2[n] = x2 * cs + x1 * sn;
                    }
                    store8bf(krope + (size_t)t * 64 + 8 * fq, o1[0], o1[1]); store8bf(krope + (size_t)t * 64 + 32 + 8 * fq, o2[0], o2[1]);
                }
            }
        }
    }
};

struct EpiQ {
    bf16_t* qm; const float* rsq; const float *cosm, *sinm; int brow, bcol;
    __device__ __forceinline__ void operator()(f32x4 (&acc)[8][4], int wr, int wc, int fr, int fq) const {
        const int c0 = bcol + wc * 64, head = c0 / 192, within = c0 - head * 192;
        float rsv[8];
#pragma unroll
        for (int m = 0; m < 8; ++m) {
            const int t = brow + ROWOFF(wr, m) + fr;
            const f32x4 r0 = *(const f32x4*)(rsq + (size_t)t * 16), r1 = *(const f32x4*)(rsq + (size_t)t * 16 + 4);
            const float ss = r0[0] + r0[1] + r0[2] + r0[3] + r1[0] + r1[1] + r1[2] + r1[3];
            rsv[m] = rsqrtf(ss * (1.0f / 512.0f) + EPS) * QSCALE;
        }
#pragma unroll
        for (int m = 0; m < 8; ++m) {
            const int t = brow + ROWOFF(wr, m) + fr, b = t >> 11, s = t & 2047;
            const float rs = rsv[m];
            bf16_t* base = qm + ((size_t)((b * 8 + head) * 2048 + s)) * 192 + within + 8 * fq;
            if (within != 128) {
                store8bf(base, acc[m][0] * rs, acc[m][1] * rs); store8bf(base + 32, acc[m][2] * rs, acc[m][3] * rs);
            } else {
                f32x4 o1[2], o2[2];
#pragma unroll
                for (int n = 0; n < 2; ++n) {
                    const int f0 = 8 * fq + 4 * n;
                    const f32x4 cs = *(const f32x4*)(cosm + (size_t)t * 32 + f0), sn = *(const f32x4*)(sinm + (size_t)t * 32 + f0);
                    const f32x4 x1 = acc[m][n] * rs, x2 = acc[m][n + 2] * rs;
                    o1[n] = x1 * cs - x2 * sn; o2[n] = x2 * cs + x1 * sn;
                }
                store8bf(base, o1[0], o1[1]); store8bf(base + 32, o2[0], o2[1]);
            }
        }
    }
};

struct EpiKV {
    bf16_t* kn; bf16_t* vt; const float* rsq; int brow, head;
    __device__ __forceinline__ void operator()(f32x4 (&acc)[8][4], int wr, int wc, int fr, int fq) const {
        float rsv[8];
#pragma unroll
        for (int m = 0; m < 8; ++m) {
            const int t = brow + ROWOFF(wr, m) + fr;
            const f32x4 r0 = *(const f32x4*)(rsq + (size_t)t * 16 + 8), r1 = *(const f32x4*)(rsq + (size_t)t * 16 + 12);
            const float ss = r0[0] + r0[1] + r0[2] + r0[3] + r1[0] + r1[1] + r1[2] + r1[3];
            rsv[m] = rsqrtf(ss * (1.0f / 512.0f) + EPS);
        }
#pragma unroll
        for (int m = 0; m < 8; ++m) {
            const int t = brow + ROWOFF(wr, m) + fr, b = t >> 11, s = t & 2047;
            const float rs = rsv[m];
            if (wc < 2) {
                bf16_t* base = kn + ((size_t)((b * 8 + head) * 2048 + s)) * 128 + wc * 64 + 8 * fq;
                store8bf(base, acc[m][0] * rs, acc[m][1] * rs); store8bf(base + 32, acc[m][2] * rs, acc[m][3] * rs);
            } else {
#pragma unroll
                for (int n = 0; n < 4; ++n)
#pragma unroll
                    for (int j = 0; j < 4; j += 2) {
                        const int d = (wc - 2) * 64 + (n >> 1) * 32 + 8 * fq + 4 * (n & 1) + j;
                        const unsigned pv_ = pk2(acc[m][n][j] * rs, acc[m][n][j + 1] * rs);
                        vt[((size_t)((b * 8 + head) * 128 + d)) * 2048 + s] = (bf16_t)pv_;
                        vt[((size_t)((b * 8 + head) * 128 + d + 1)) * 2048 + s] = (bf16_t)(pv_ >> 16);
                    }
            }
        }
    }
};

struct EpiBranch {
    const bf16_t* gates; bf16_t* merged; int mode, brow, bcol;
    __device__ __forceinline__ void operator()(f32x4 (&acc)[8][4], int wr, int wc, int fr, int fq) const {
        const int col0 = bcol + wc * 64 + 8 * fq;
        const size_t t0 = (size_t)(brow + fr);
#pragma unroll
        for (int m = 0; m < 8; ++m) {
            const size_t t = t0 + ROWOFF(wr, m);
#pragma unroll
            for (int bj = 0; bj < 2; ++bj) {
                const bf16_t* gp = gates + t * LDP + col0 + bj * 32 + mode * 2048;
                f32x4 g0, g1; load8bf(gp, g0, g1);
                if (mode != 2) {
                    f32x4 h0, h1; load8bf(gp + 2048, h0, h1);
#pragma unroll
                    for (int j = 0; j < 4; ++j) {
                        acc[m][2 * bj][j] *= g0[j] * __builtin_amdgcn_rcpf(fmaxf(h0[j], 1e-30f));
                        acc[m][2 * bj + 1][j] *= g1[j] * __builtin_amdgcn_rcpf(fmaxf(h1[j], 1e-30f));
                    }
                } else {
                    store8bf(merged + t * D + col0 + bj * 32, acc[m][2 * bj] * g0, acc[m][2 * bj + 1] * g1);
                }
            }
        }
    }
};

struct EpiOut {
    bf16_t* y; int brow, bcol;
    __device__ __forceinline__ void operator()(f32x4 (&acc)[8][4], int wr, int wc, int fr, int fq) const {
#pragma unroll
        for (int m = 0; m < 8; ++m) {
            const int t = brow + ROWOFF(wr, m) + fr;
            bf16_t* yp = y + (size_t)t * D + bcol + wc * 64 + 8 * fq;
            store8bf(yp, acc[m][0], acc[m][1]); store8bf(yp + 32, acc[m][2], acc[m][3]);
        }
    }
};

__device__ __forceinline__ int win_map(int np) {
    if (np < 2048) { const int base = np & ~127, p = np & 127, blk = p >> 6, half = (p >> 5) & 1, r = p & 31; return base + 32 * blk + 64 * half + r; }
    if (np < 7168) return np;
    if (np < 14336) return np + 64;
    if (np < 14400) return 7168 + (np - 14336);
    return -1;
}

struct ConvArgs { const float* src; const float* gain; bf16_t* dst; int ld, Kt, k0, np0, wmap; };
__device__ __forceinline__ ConvArgs conv_decode(KP p, int ci) {
    char* ws = p->ws;
    constexpr int NCONV_L = 1824 + 48 + 64 + 384 + 256 + 8 + 8;
    ConvArgs a; const int l = ci / NCONV_L; ci -= l * NCONV_L; a.gain = nullptr; a.wmap = 0;
    if (ci < 1824) { const int nt = ci % 114, kt = ci / 114; a.src = p->in[7] + (size_t)l * 2048 * NIN; a.ld = NIN; a.Kt = 2048; a.k0 = kt * 128; a.np0 = nt * 128; a.wmap = 1; a.dst = (bf16_t*)(ws + WS_WI) + (size_t)l * NP1 * 2048; }
    else if ((ci -= 1824) < 48) { const int nt = ci % 12, kt = ci / 12; a.src = p->in[17] + (size_t)l * 512 * 1536; a.ld = 1536; a.Kt = 512; a.k0 = kt * 128; a.np0 = nt * 128; a.gain = p->in[16] + l * 512; a.dst = (bf16_t*)(ws + WS_WUQ) + (size_t)l * 1536 * 512; }
    else if ((ci -= 48) < 64) { const int nt = ci % 16, kt = ci / 16; a.src = p->in[19] + (size_t)l * 512 * 2048; a.ld = 2048; a.Kt = 512; a.k0 = kt * 128; a.np0 = nt * 128; a.gain = p->in[18] + l * 512; a.dst = (bf16_t*)(ws + WS_WUKV) + (size_t)l * 2048 * 512; }
    else if ((ci -= 64) < 384) { const int nt = ci % 16, kt = ci / 16; a.src = p->in[20] + (size_t)l * 3072 * 2048; a.ld = 2048; a.Kt = 3072; a.k0 = kt * 128; a.np0 = nt * 128; a.dst = (bf16_t*)(ws + WS_WB) + (size_t)l * 2048 * 3072; }
    else if ((ci -= 384) < 256) { const int nt = ci % 16, kt = ci / 16; a.src = p->in[21] + (size_t)l * 2048 * 2048; a.ld = 2048; a.Kt = 2048; a.k0 = kt * 128; a.np0 = nt * 128; a.dst = (bf16_t*)(ws + WS_WO) + (size_t)l * 2048 * 2048; }
    else if ((ci -= 256) < 8) { a.src = p->in[11] + (size_t)(l * 8 + ci) * 16384; a.ld = 128; a.Kt = 128; a.k0 = 0; a.np0 = 0; a.dst = (bf16_t*)(ws + WS_WA) + (size_t)(l * 8 + ci) * 16384; }
    else { ci -= 8; a.src = p->in[13] + (size_t)(l * 8 + ci) * 16384; a.ld = 128; a.Kt = 128; a.k0 = 0; a.np0 = 0; a.dst = (bf16_t*)(ws + WS_WX) + (size_t)(l * 8 + ci) * 16384; }
    return a;
}
__device__ __forceinline__ void conv_load(const ConvArgs& c, int tid, f32x4 (&a)[4], f32x4 (&b)[4]) {
    const int c8 = (tid & 15) * 8, np = c.np0 + c8;
    const int n = c.wmap ? win_map(np) : np;
#pragma unroll
    for (int r = 0; r < 4; ++r) {
        const int kl = (tid >> 4) + 32 * r;
        a[r] = (f32x4){0.f, 0.f, 0.f, 0.f}; b[r] = a[r];
        if (n >= 0) { const float* sp = c.src + (size_t)(c.k0 + kl) * c.ld + n; a[r] = __builtin_nontemporal_load((const f32x4*)sp); b[r] = __builtin_nontemporal_load((const f32x4*)(sp + 4)); }
    }
}
__device__ __forceinline__ void conv_finish(LAS char* lds, const ConvArgs& c, int tid, const f32x4 (&a)[4], const f32x4 (&b)[4]) {
    LAS bf16_t* tl = (LAS bf16_t*)lds;
    const int c8 = (tid & 15) * 8;
    __syncthreads();
#pragma unroll
    for (int r = 0; r < 4; ++r) {
        const int kl = (tid >> 4) + 32 * r;
        const float g = c.gain ? c.gain[c.k0 + kl] : 1.0f;
#pragma unroll
        for (int e = 0; e < 4; e += 2) {
            const unsigned pa_ = pk2(a[r][e] * g, a[r][e + 1] * g), pb_ = pk2(b[r][e] * g, b[r][e + 1] * g);
            tl[(c8 + e) * 130 + kl] = (bf16_t)pa_; tl[(c8 + e + 1) * 130 + kl] = (bf16_t)(pa_ >> 16);
            tl[(c8 + 4 + e) * 130 + kl] = (bf16_t)pb_; tl[(c8 + 5 + e) * 130 + kl] = (bf16_t)(pb_ >> 16);
        }
    }
    __syncthreads();
#pragma unroll
    for (int r = 0; r < 4; ++r) {
        const int nl = (tid >> 4) + 32 * r, kc = (tid & 15) * 8;
        const LAS unsigned* rp = (const LAS unsigned*)(tl + nl * 130 + kc);
        u32x4 o; o.x = rp[0]; o.y = rp[1]; o.z = rp[2]; o.w = rp[3];
        *(u32x4*)(c.dst + (size_t)(c.np0 + nl) * c.Kt + c.k0 + kc) = o;
    }
}

__device__ __forceinline__ void conv4(LAS char* lds, KP p, int base) {
    int tid = threadIdx.x; asm volatile("" : "+v"(tid));
    f32x4 a0[4], b0[4], a1[4], b1[4];
    ConvArgs c0 = conv_decode(p, base), c1 = conv_decode(p, base + 1);
    conv_load(c0, tid, a0, b0); conv_load(c1, tid, a1, b1);
    conv_finish(lds, c0, tid, a0, b0);
    c0 = conv_decode(p, base + 2); conv_load(c0, tid, a0, b0);
    conv_finish(lds, c1, tid, a1, b1);
    c1 = conv_decode(p, base + 3); conv_load(c1, tid, a1, b1);
    conv_finish(lds, c0, tid, a0, b0);
    conv_finish(lds, c1, tid, a1, b1);
}

__device__ void phase0(LAS char* lds, KP p) {
    char* ws = p->ws;
    int tid = threadIdx.x; asm volatile("" : "+v"(tid)); const int wid = tid >> 6, lane = tid & 63;
    constexpr int NCONV_L = 1824 + 48 + 64 + 384 + 256 + 8 + 8;
    constexpr int N_ADA = 384, N_ROPE = 128, N_ITEMS = N_ADA + N_ROPE;
    for (int it = blockIdx.x; it < N_ITEMS; it += gridDim.x) {
        if (it < N_ADA) {
            const int l = it / 96, j0 = (it % 96) * 64;
            LAS float* cact = (LAS float*)lds;
            LAS float* red = (LAS float*)(lds + 32768);
            __syncthreads();
            for (int i = tid; i < 8192; i += 512) { const float v = p->in[1][i]; cact[i] = v * sigmoidf_(v); }
            __syncthreads();
            const int cg = lane & 15, kq = lane >> 4;
            const float* wp = p->in[3] + (size_t)l * 2048 * 6144 + j0 + 4 * cg;
            f32x4 a0 = (f32x4){0.f, 0.f, 0.f, 0.f}, a1 = a0, a2 = a0, a3 = a0;
#pragma unroll 16
            for (int j = 0; j < 64; ++j) {
                const int k = wid * 256 + 4 * j + kq;
                const f32x4 w = *(const f32x4*)(wp + (size_t)k * 6144);
                a0 += w * cact[k]; a1 += w * cact[2048 + k]; a2 += w * cact[4096 + k]; a3 += w * cact[6144 + k];
            }
#pragma unroll
            for (int e = 0; e < 4; ++e) {
                a0[e] += shx(a0[e], lane, 16); a0[e] += shx(a0[e], lane, 32); a1[e] += shx(a1[e], lane, 16); a1[e] += shx(a1[e], lane, 32);
                a2[e] += shx(a2[e], lane, 16); a2[e] += shx(a2[e], lane, 32); a3[e] += shx(a3[e], lane, 16); a3[e] += shx(a3[e], lane, 32);
            }
            if (kq == 0) {
                *(LAS f32x4*)(red + (wid * 4 + 0) * 64 + 4 * cg) = a0; *(LAS f32x4*)(red + (wid * 4 + 1) * 64 + 4 * cg) = a1;
                *(LAS f32x4*)(red + (wid * 4 + 2) * 64 + 4 * cg) = a2; *(LAS f32x4*)(red + (wid * 4 + 3) * 64 + 4 * cg) = a3;
            }
            __syncthreads();
            if (tid < 256) {
                const int b = tid >> 6, jl = tid & 63; float s = 0.f;
#pragma unroll
                for (int w = 0; w < 8; ++w) s += red[(w * 4 + b) * 64 + jl];
                ((float*)(ws + WS_MOD))[(size_t)(l * 4 + b) * 6144 + j0 + jl] = s + p->in[4][(size_t)l * 6144 + j0 + jl];
            }
        } else if (it < N_ADA + N_ROPE) {
            const int t0 = (it - N_ADA) * 64;
            for (int e = tid; e < 64 * 96; e += 512) {
                const int tl = e / 96, f = e % 96, t = t0 + tl;
                const float pos = (float)p->pos[t];
                float invf; if (f < 64) invf = exp2f(-(float)(2 * f) * (1.0f / 128.0f) * 13.287712379549449f); else invf = exp2f(-(float)(2 * (f - 64)) * (1.0f / 64.0f) * 13.287712379549449f);
                const float ang = pos * invf;
                double rev = (double)ang * 0.15915494309189535; rev -= rint(rev);
                const float rv = (float)rev;
                const float sn = __builtin_amdgcn_sinf(rv), cs = __builtin_amdgcn_cosf(rv);
                if (f < 64) { ((float*)(ws + WS_COSR))[(size_t)t * 64 + f] = cs; ((float*)(ws + WS_SINR))[(size_t)t * 64 + f] = sn; }
                else { ((float*)(ws + WS_COSM))[(size_t)t * 32 + f - 64] = cs; ((float*)(ws + WS_SINM))[(size_t)t * 32 + f - 64] = sn; }
            }
        }
    }
    {
        constexpr int NCONV = NCONV_L;
        int ci = blockIdx.x;
        f32x4 a0[4], b0[4], a1[4], b1[4];
        ConvArgs c0 = conv_decode(p, ci < NCONV ? ci : 0), c1 = c0;
        if (ci < NCONV) conv_load(c0, tid, a0, b0);
        while (ci < NCONV) {
            const int cn = ci + gridDim.x, cnn = cn + gridDim.x;
            if (cn < NCONV) { c1 = conv_decode(p, cn); conv_load(c1, tid, a1, b1); }
            conv_finish(lds, c0, tid, a0, b0);
            if (cn >= NCONV) break;
            if (cnn < NCONV) { c0 = conv_decode(p, cnn); conv_load(c0, tid, a0, b0); }
            conv_finish(lds, c1, tid, a1, b1);
            ci = cnn;
        }
    }
}

__device__ __forceinline__ float wave_sum(float v, int lane) {
    v = row16_sum(v); v += shx(v, lane, 16); v += shx(v, lane, 32); return v;
}
__device__ void rowpass(KP p, int l  ) {
    char* ws = p->ws;
    int tid = threadIdx.x; asm volatile("" : "+v"(tid));
    const int lane = tid & 63, gw = blockIdx.x * 8 + (tid >> 6), nw = gridDim.x * 8;
    const float* mod = (const float*)(ws + WS_MOD);
    float* xcur = (float*)(ws + WS_XCUR);
    const bf16_t* ybuf = (const bf16_t*)(ws + WS_YBUF);
    bf16_t* hbuf = (bf16_t*)(ws + WS_HBUF);
    for (int g4 = gw; g4 < T / 4; g4 += nw) {
        const int r0 = g4 * 4, b = r0 >> 11;
        f32x4 pa[8], pb[8], pc[8];
        if (l >= 0) {
#pragma unroll
            for (int i = 0; i < 8; ++i) {
                const int c = i * 256 + lane * 4;
                pa[i] = (*(const f32x4*)(mod + (size_t)(l * 4 + b) * 6144 + 4096 + c) + 1.0f) * *(const f32x4*)(p->in[6] + (size_t)l * D + c);
            }
        }
        if (l < DEPTH - 1) {
            const int ln = l + 1;
#pragma unroll
            for (int i = 0; i < 8; ++i) {
                const int c = i * 256 + lane * 4;
                pb[i] = (*(const f32x4*)(mod + (size_t)(ln * 4 + b) * 6144 + 2048 + c) + 1.0f) * *(const f32x4*)(p->in[5] + (size_t)ln * D + c);
                pc[i] = *(const f32x4*)(mod + (size_t)(ln * 4 + b) * 6144 + c);
            }
        }
        const float* xprev = (l <= 0) ? p->in[0] : xcur;
        float* dst = (l == DEPTH - 1) ? p->out : xcur;
#pragma unroll 1
        for (int rr = 0; rr < 4; ++rr) {
            const int row = r0 + rr;
            f32x4 xv[8], yv[8];
#pragma unroll
            for (int i = 0; i < 8; ++i) {
                xv[i] = *(const f32x4*)(xprev + (size_t)row * D + i * 256 + lane * 4);
                if (l >= 0) yv[i] = load4bf(ybuf + (size_t)row * D + i * 256 + lane * 4);
            }
            if (l >= 0) {
                float ss = 0.f;
#pragma unroll
                for (int i = 0; i < 8; ++i) ss += yv[i][0] * yv[i][0] + yv[i][1] * yv[i][1] + yv[i][2] * yv[i][2] + yv[i][3] * yv[i][3];
                ss = wave_sum(ss, lane);
                const float rs = rsqrtf(ss * (1.0f / D) + EPS);
#pragma unroll
                for (int i = 0; i < 8; ++i) {
                    xv[i] = xv[i] + pa[i] * (yv[i] * rs);
                    *(f32x4*)(dst + (size_t)row * D + i * 256 + lane * 4) = xv[i];
                }
            }
            if (l < DEPTH - 1) {
                float ss = 0.f;
#pragma unroll
                for (int i = 0; i < 8; ++i) ss += xv[i][0] * xv[i][0] + xv[i][1] * xv[i][1] + xv[i][2] * xv[i][2] + xv[i][3] * xv[i][3];
                ss = wave_sum(ss, lane);
                const float rs = rsqrtf(ss * (1.0f / D) + EPS);
#pragma unroll
                for (int i = 0; i < 8; ++i) store4bf(hbuf + (size_t)row * D + i * 256 + lane * 4, xv[i] * rs * pb[i] + pc[i]);
            }
        }
    }
}

__device__ __forceinline__ int tix(int row, int col) { return row * 72 + (col ^ (((row >> 3) & 3) << 4)); }
template <bool OUT>
__device__ void ret_item(LAS char* lds, KP p, int l, int item) {
    char* ws = p->ws;
    int tid = threadIdx.x; asm volatile("" : "+v"(tid)); const int wid = tid >> 6, lane = tid & 63, fr = lane & 15, fq = lane >> 4;
    const int g = item & 7, h = (item >> 3) & 7, b = item >> 6;
    LAS bf16_t* Qs = (LAS bf16_t*)(lds);
    LAS bf16_t* Ks = (LAS bf16_t*)(lds + 17408);
    LAS bf16_t* Kt = (LAS bf16_t*)(lds + 34816);
    LAS bf16_t* Vt = (LAS bf16_t*)(lds + 53248);
    LAS bf16_t* St = (LAS bf16_t*)(lds + 71680);
    LAS bf16_t* Ps = (LAS bf16_t*)(lds + 106496);
    LAS float* Os = (LAS float*)(lds);
    const bf16_t* proj = (const bf16_t*)(ws + WS_PROJ);
    float* tot = (float*)(ws + WS_TOT);
    const float gy = __builtin_amdgcn_exp2f(-5.0f - (float)h);
    const float lg2 = -gy * (1.0f + gy * (0.5f + gy * (0.33333334f + gy * (0.25f + gy * 0.2f)))) * 1.4426950408889634f;
    const float d64 = __builtin_amdgcn_exp2f(lg2 * 64.0f), d256 = __builtin_amdgcn_exp2f(lg2 * 256.0f);
    f32x4 sacc[8];
#pragma unroll
    for (int nf = 0; nf < 8; ++nf) sacc[nf] = (f32x4){0.f, 0.f, 0.f, 0.f};
    if (OUT) {
        float w = 1.0f;
        for (int gp = g - 1; gp >= 0; --gp) {
            const float* tp = tot + (size_t)((b * 8 + h) * 8 + gp) * 16384;
            float tv[8][4];
#pragma unroll
            for (int nf = 0; nf < 8; ++nf)
#pragma unroll
                for (int j = 0; j < 4; ++j) tv[nf][j] = tp[(16 * wid + 4 * fq + j) * 128 + 16 * nf + fr];
#pragma unroll
            for (int nf = 0; nf < 8; ++nf)
#pragma unroll
                for (int j = 0; j < 4; ++j) sacc[nf][j] += w * tv[nf][j];
            w *= d256;
        }
    }
    int li[2], lc[2];
#pragma unroll
    for (int r = 0; r < 2; ++r) { const int wt = wid + 8 * r; li[r] = 16 * (wt & 3) + (lane & 15); lc[r] = 8 * (4 * (wt >> 2) + (lane >> 4)); }
    u32x4 gq[2], gk[2], gv[2];
#define RET_LOAD(n_) do { const int t0_ = b * 2048 + (n_) * 64; _Pragma("unroll") for (int r = 0; r < 2; ++r) { \
        const bf16_t* rowp = proj + (size_t)(t0_ + li[r]) * LDP + h * 128 + lc[r]; \
        gk[r] = *(const u32x4*)(rowp + 1024); gv[r] = *(const u32x4*)(rowp + 2048); if (OUT) gq[r] = *(const u32x4*)(rowp); } } while (0)
    RET_LOAD(g * 4);
    const int ni = tid >> 3, npart = tid & 7, ncol = h * 128 + npart * 16;
    f32x4 gv4[4]; u32x4 sgp[2];
    if (OUT) {
#pragma unroll
        for (int e = 0; e < 4; ++e) gv4[e] = *(const f32x4*)(p->in[8] + (size_t)l * 1024 + ncol + e * 4);
    }
    for (int c = 0; c < 4; ++c) {
        const int n = g * 4 + c, t0 = b * 2048 + n * 64;
        if (OUT) { const bf16_t* gp_ = proj + (size_t)(t0 + ni) * LDP + 3072 + ncol; sgp[0] = *(const u32x4*)gp_; sgp[1] = *(const u32x4*)(gp_ + 8); }
        __syncthreads();
#pragma unroll
        for (int r = 0; r < 2; ++r) {
            const int i = li[r], c8 = lc[r];
            if (OUT) { *(LAS u32x4*)(Qs + i * 136 + c8) = gq[r]; *(LAS u32x4*)(Ks + i * 136 + c8) = gk[r]; }
            const float dec = __builtin_amdgcn_exp2f(lg2 * (float)(63 - i));
#pragma unroll
            for (int e = 0; e < 4; ++e) {
                Kt[tix(c8 + 2 * e, i)] = f2bf(blo(gk[r][e]) * dec); Kt[tix(c8 + 2 * e + 1, i)] = f2bf(bhi(gk[r][e]) * dec);
                Vt[tix(c8 + 2 * e, i)] = (bf16_t)(gv[r][e] & 0xffffu); Vt[tix(c8 + 2 * e + 1, i)] = (bf16_t)(gv[r][e] >> 16);
            }
        }
        if (OUT) {
#pragma unroll
            for (int nf = 0; nf < 8; ++nf)
#pragma unroll
                for (int j = 0; j < 4; ++j) St[(16 * wid + 4 * fq + j) * 136 + 16 * nf + fr] = f2bf(sacc[nf][j]);
        }
        if (c + 1 < 4) RET_LOAD(n + 1);
        __syncthreads();
        const int mf = wid & 3, nh = wid >> 2;
        f32x4 o1[4], o2[4];
#pragma unroll
        for (int nf = 0; nf < 4; ++nf) { o1[nf] = (f32x4){0.f, 0.f, 0.f, 0.f}; o2[nf] = (f32x4){0.f, 0.f, 0.f, 0.f}; }
        if (OUT) {
            f32x4 s2[2] = {(f32x4){0.f, 0.f, 0.f, 0.f}, (f32x4){0.f, 0.f, 0.f, 0.f}};
            {
                bf16x8 fa[4], fb0[4], fb1[4];
#pragma unroll
                for (int kk = 0; kk < 4; ++kk) {
                    fa[kk] = *(const LAS bf16x8*)(Qs + (16 * mf + fr) * 136 + kk * 32 + fq * 8);
                    fb0[kk] = *(const LAS bf16x8*)(Ks + (32 * nh + fr) * 136 + kk * 32 + fq * 8);
                    fb1[kk] = *(const LAS bf16x8*)(Ks + (32 * nh + 16 + fr) * 136 + kk * 32 + fq * 8);
                }
#pragma unroll
                for (int kk = 0; kk < 4; ++kk) { s2[0] = MFMA16(fa[kk], fb0[kk], s2[0]); s2[1] = MFMA16(fa[kk], fb1[kk], s2[1]); }
                __builtin_amdgcn_sched_group_barrier(0x100, 12, 0); __builtin_amdgcn_sched_group_barrier(0x008, 8, 0);
            }
            __builtin_amdgcn_sched_barrier(0);
#pragma unroll
            for (int nf = 0; nf < 2; ++nf)
#pragma unroll
                for (int j = 0; j < 4; ++j) {
                    const int i = 16 * mf + 4 * fq + j, jj = 32 * nh + 16 * nf + fr;
                    Ps[i * 72 + jj] = f2bf(s2[nf][j] * __builtin_amdgcn_exp2f(lg2 * fabsf((float)(i - jj))));
                }
            __builtin_amdgcn_sched_barrier(0);
            {
                bf16x8 qa[4], sb[4][4];
#pragma unroll
                for (int kk = 0; kk < 4; ++kk) {
                    qa[kk] = *(const LAS bf16x8*)(Qs + (16 * mf + fr) * 136 + kk * 32 + fq * 8);
#pragma unroll
                    for (int nf = 0; nf < 4; ++nf) sb[kk][nf] = *(const LAS bf16x8*)(St + (64 * nh + 16 * nf + fr) * 136 + kk * 32 + fq * 8);
                }
#pragma unroll
                for (int kk = 0; kk < 4; ++kk)
#pragma unroll
                    for (int nf = 0; nf < 4; ++nf) o2[nf] = MFMA16(qa[kk], sb[kk][nf], o2[nf]);
                __builtin_amdgcn_sched_group_barrier(0x100, 20, 0); __builtin_amdgcn_sched_group_barrier(0x008, 16, 0);
            }
            __builtin_amdgcn_sched_barrier(0);
        }
#pragma unroll
        for (int nf = 0; nf < 8; ++nf) sacc[nf] *= d64;
        __builtin_amdgcn_sched_barrier(0);
        {
            bf16x8 va[2], kb[2][8];
#pragma unroll
            for (int kk = 0; kk < 2; ++kk) {
                va[kk] = *(const LAS bf16x8*)(Vt + tix(16 * wid + fr, kk * 32 + fq * 8));
#pragma unroll
                for (int nf = 0; nf < 8; ++nf) kb[kk][nf] = *(const LAS bf16x8*)(Kt + tix(16 * nf + fr, kk * 32 + fq * 8));
            }
#pragma unroll
            for (int kk = 0; kk < 2; ++kk)
#pragma unroll
                for (int nf = 0; nf < 8; ++nf) sacc[nf] = MFMA16(va[kk], kb[kk][nf], sacc[nf]);
            __builtin_amdgcn_sched_group_barrier(0x100, 18, 0); __builtin_amdgcn_sched_group_barrier(0x008, 16, 0);
        }
        __builtin_amdgcn_sched_barrier(0);
        if (OUT) {
            __syncthreads();
            {
                bf16x8 pa[2], vb[2][4];
#pragma unroll
                for (int kk = 0; kk < 2; ++kk) {
                    pa[kk] = *(const LAS bf16x8*)(Ps + (16 * mf + fr) * 72 + kk * 32 + fq * 8);
#pragma unroll
                    for (int nf = 0; nf < 4; ++nf) vb[kk][nf] = *(const LAS bf16x8*)(Vt + tix(64 * nh + 16 * nf + fr, kk * 32 + fq * 8));
                }
#pragma unroll
                for (int kk = 0; kk < 2; ++kk)
#pragma unroll
                    for (int nf = 0; nf < 4; ++nf) o1[nf] = MFMA16(pa[kk], vb[kk][nf], o1[nf]);
                __builtin_amdgcn_sched_group_barrier(0x100, 10, 0); __builtin_amdgcn_sched_group_barrier(0x008, 8, 0);
            }
            __builtin_amdgcn_sched_barrier(0);
            __builtin_amdgcn_sched_barrier(0);
#pragma unroll
            for (int j = 0; j < 4; ++j) {
                const int i = 16 * mf + 4 * fq + j; const float dq = __builtin_amdgcn_exp2f(lg2 * (float)(i + 1));
#pragma unroll
                for (int nf = 0; nf < 4; ++nf) Os[i * 132 + 64 * nh + 16 * nf + fr] = o1[nf][j] + dq * o2[nf][j];
            }
        }
        if (OUT) {
            __syncthreads();
            const int i = tid >> 3, part = tid & 7, t = t0 + i;
            f32x4 v[4]; float sum = 0.f;
#pragma unroll
            for (int e = 0; e < 4; ++e) { v[e] = *(const LAS f32x4*)(Os + i * 132 + part * 16 + e * 4); sum += v[e][0] + v[e][1] + v[e][2] + v[e][3]; }
            sum += dppf(sum, 0); sum += dppf(sum, 1); sum += shx(sum, lane, 4);
            const float mean = sum * (1.0f / 128.0f);
            float sq = 0.f;
#pragma unroll
            for (int e = 0; e < 4; ++e) { v[e] = v[e] - mean; sq += v[e][0] * v[e][0] + v[e][1] * v[e][1] + v[e][2] * v[e][2] + v[e][3] * v[e][3]; }
            sq += dppf(sq, 0); sq += dppf(sq, 1); sq += shx(sq, lane, 4);
            const float rs = rsqrtf(sq * (1.0f / 128.0f) + EPS);
            bf16_t* yp = (bf16_t*)(ws + WS_YCAT) + (size_t)t * 3072 + ncol;
            f32x4 sg4[4];
            sg4[0][0] = blo(sgp[0].x); sg4[0][1] = bhi(sgp[0].x); sg4[0][2] = blo(sgp[0].y); sg4[0][3] = bhi(sgp[0].y);
            sg4[1][0] = blo(sgp[0].z); sg4[1][1] = bhi(sgp[0].z); sg4[1][2] = blo(sgp[0].w); sg4[1][3] = bhi(sgp[0].w);
            sg4[2][0] = blo(sgp[1].x); sg4[2][1] = bhi(sgp[1].x); sg4[2][2] = blo(sgp[1].y); sg4[2][3] = bhi(sgp[1].y);
            sg4[3][0] = blo(sgp[1].z); sg4[3][1] = bhi(sgp[1].z); sg4[3][2] = blo(sgp[1].w); sg4[3][3] = bhi(sgp[1].w);
            store8bf(yp, v[0] * rs * gv4[0] * sg4[0], v[1] * rs * gv4[1] * sg4[1]);
            store8bf(yp + 8, v[2] * rs * gv4[2] * sg4[2], v[3] * rs * gv4[3] * sg4[3]);
        }
    }
#undef RET_LOAD
    if (!OUT) {
        float* tp = tot + (size_t)item * 16384;
#pragma unroll
        for (int nf = 0; nf < 8; ++nf)
#pragma unroll
            for (int j = 0; j < 4; ++j) tp[(16 * wid + 4 * fq + j) * 128 + 16 * nf + fr] = sacc[nf][j];
    }
}

__device__ void lru_item(LAS char* lds, KP p, int l, int item) {
    char* ws = p->ws;
    int tid = threadIdx.x; asm volatile("" : "+v"(tid)); const int wid = tid >> 6, lane = tid & 63, fr = lane & 15, fq = lane >> 4;
    const int nb = item & 7, n = (item >> 3) & 31, b = item >> 8, t0 = b * 2048 + n * 64, s0 = n * 64;
    LAS bf16_t* Xs = (LAS bf16_t*)(lds);
    LAS float* Xf = (LAS float*)(lds + 17408);
    LAS bf16_t* Wa = (LAS bf16_t*)(lds + 50176);
    LAS bf16_t* Wx = (LAS bf16_t*)(lds + 84992);
    LAS float* As_ = (LAS float*)(lds + 50176);
    LAS float* Bs_ = (LAS float*)(lds + 82944);
    LAS float* Cq = (LAS float*)(lds + 119808);
    const bf16_t* proj = (const bf16_t*)(ws + WS_PROJ);
    const bf16_t* wat = (const bf16_t*)(ws + WS_WA) + (size_t)(l * 8 + nb) * 16384;
    const bf16_t* wxt = (const bf16_t*)(ws + WS_WX) + (size_t)(l * 8 + nb) * 16384;
    float pba[4], pbx[4], plam[4];
#pragma unroll
    for (int nf = 0; nf < 4; ++nf) { const int ch_ = l * 1024 + nb * 128 + 64 * (wid >> 2) + 16 * nf + fr; pba[nf] = p->in[12][ch_]; pbx[nf] = p->in[14][ch_]; plam[nf] = p->in[15][ch_]; }
    __syncthreads();
    {
        u32x4 wa4[4], wx4[4];
#pragma unroll
        for (int r = 0; r < 4; ++r) { const int q = tid + 512 * r, d = q >> 4, c8 = (q & 15) * 8; wa4[r] = *(const u32x4*)(wat + d * 128 + c8); wx4[r] = *(const u32x4*)(wxt + d * 128 + c8); }
#pragma unroll
        for (int r = 0; r < 4; ++r) { const int q = tid + 512 * r, d = q >> 4, c8 = (q & 15) * 8; *(LAS u32x4*)(Wa + d * 136 + c8) = wa4[r]; *(LAS u32x4*)(Wx + d * 136 + c8) = wx4[r]; }
    }
#pragma unroll
    for (int r = 0; r < 2; ++r) {
        const int q = tid + 512 * r, i = q >> 4, c8 = (q & 15) * 8, ch = nb * 128 + c8;
        f32x4 x0 = *(const f32x4*)(p->in[10] + (size_t)l * 1024 + ch), x1 = *(const f32x4*)(p->in[10] + (size_t)l * 1024 + ch + 4);
        u32x4 xv4[4]; f32x4 w04[4], w14[4];
#pragma unroll
        for (int k = 0; k < 4; ++k) {
            const int sk = s0 + i - 3 + k, tk = sk >= 0 ? (t0 + i - 3 + k) : t0;
            xv4[k] = *(const u32x4*)(proj + (size_t)tk * LDP + 4096 + ch);
            w04[k] = *(const f32x4*)(p->in[9] + (size_t)(l * 4 + k) * 1024 + ch); w14[k] = *(const f32x4*)(p->in[9] + (size_t)(l * 4 + k) * 1024 + ch + 4);
        }
#pragma unroll
        for (int k = 0; k < 4; ++k) {
            const float mk = (s0 + i - 3 + k >= 0) ? 1.0f : 0.0f;
            const f32x4 w0 = w04[k] * mk, w1 = w14[k] * mk; const u32x4 xv = xv4[k];
            x0[0] += w0[0] * blo(xv[0]); x0[1] += w0[1] * bhi(xv[0]); x0[2] += w0[2] * blo(xv[1]); x0[3] += w0[3] * bhi(xv[1]);
            x1[0] += w1[0] * blo(xv[2]); x1[1] += w1[1] * bhi(xv[2]); x1[2] += w1[2] * blo(xv[3]); x1[3] += w1[3] * bhi(xv[3]);
        }
        u32x4 o; o.x = pk2(x0[0], x0[1]); o.y = pk2(x0[2], x0[3]); o.z = pk2(x1[0], x1[1]); o.w = pk2(x1[2], x1[3]);
        *(LAS u32x4*)(Xs + i * 136 + c8) = o;
        *(LAS f32x4*)(Xf + i * 128 + c8) = x0; *(LAS f32x4*)(Xf + i * 128 + c8 + 4) = x1;
    }
    __syncthreads();
    const int mf = wid & 3, nh = wid >> 2;
    f32x4 accA[4], accX[4];
#pragma unroll
    for (int nf = 0; nf < 4; ++nf) { accA[nf] = (f32x4){0.f, 0.f, 0.f, 0.f}; accX[nf] = (f32x4){0.f, 0.f, 0.f, 0.f}; }
    __builtin_amdgcn_sched_barrier(0);
#pragma unroll
    for (int half = 0; half < 2; ++half) {
        bf16x8 xa[2], wa_[2][4], wx_[2][4];
#pragma unroll
        for (int kk = 0; kk < 2; ++kk) {
            const int k0 = (half * 2 + kk) * 32;
            xa[kk] = *(const LAS bf16x8*)(Xs + (16 * mf + fr) * 136 + k0 + fq * 8);
#pragma unroll
            for (int nf = 0; nf < 4; ++nf) {
                wa_[kk][nf] = *(const LAS bf16x8*)(Wa + (64 * nh + 16 * nf + fr) * 136 + k0 + fq * 8);
                wx_[kk][nf] = *(const LAS bf16x8*)(Wx + (64 * nh + 16 * nf + fr) * 136 + k0 + fq * 8);
            }
        }
#pragma unroll
        for (int kk = 0; kk < 2; ++kk)
#pragma unroll
            for (int nf = 0; nf < 4; ++nf) { accA[nf] = MFMA16(xa[kk], wa_[kk][nf], accA[nf]); accX[nf] = MFMA16(xa[kk], wx_[kk][nf], accX[nf]); }
        __builtin_amdgcn_sched_group_barrier(0x100, 18, 0); __builtin_amdgcn_sched_group_barrier(0x008, 16, 0);
        __builtin_amdgcn_sched_barrier(0);
    }
    __syncthreads();
#pragma unroll
    for (int nf = 0; nf < 4; ++nf) {
        const int d = 64 * nh + 16 * nf + fr;
        const float ba = pba[nf], bx = pbx[nf], lam = plam[nf];
        const float em = __expf(-fabsf(lam));
        const float l1p = em < 0.01f ? em * (1.0f - em * (0.5f - em * 0.33333334f)) : __logf(1.0f + em);
        const float sp = fmaxf(-lam, 0.0f) + l1p;
#pragma unroll
        for (int j = 0; j < 4; ++j) {
            const int i = 16 * mf + 4 * fq + j;
            const float r = sigmoidf_(accA[nf][j] + ba), ig = sigmoidf_(accX[nf][j] + bx);
            const float la = -8.0f * r * sp;
            As_[i * 128 + d] = __expf(la);
            const float x2 = 2.0f * la;
            const float om = x2 > -0.1f ? -x2 * (1.0f + x2 * (0.5f + x2 * (0.16666667f + x2 * 0.041666668f))) : 1.0f - __expf(x2);
            Bs_[i * 128 + d] = sqrtf(om) * (ig * Xf[i * 128 + d]);
        }
    }
    __syncthreads();
    {
        const int d = tid & 127, q = tid >> 7;
        float h = 0.f, A = 1.f;
#pragma unroll 4
        for (int ii = 0; ii < 16; ++ii) { const int i = 16 * q + ii; const float a = As_[i * 128 + d]; h = a * h + Bs_[i * 128 + d]; A *= a; }
        Cq[(q * 128 + d) * 2] = A; Cq[(q * 128 + d) * 2 + 1] = h;
        __syncthreads();
        float hin = 0.f, Ain = 1.f;
        for (int qq = 0; qq < q; ++qq) { const float Aq = Cq[(qq * 128 + d) * 2], hq = Cq[(qq * 128 + d) * 2 + 1]; hin = Aq * hin + hq; Ain *= Aq; }
        h = hin; A = Ain;
        bf16_t* hl = (bf16_t*)(ws + WS_HLOC) + (size_t)t0 * 1024 + nb * 128 + d;
        bf16_t* ac = (bf16_t*)(ws + WS_ACUM) + (size_t)t0 * 1024 + nb * 128 + d;
#pragma unroll 4
        for (int ii = 0; ii < 16; ++ii) {
            const int i = 16 * q + ii; const float a = As_[i * 128 + d]; h = a * h + Bs_[i * 128 + d]; A *= a;
            hl[(size_t)i * 1024] = f2bf(h); ac[(size_t)i * 1024] = f2bf(A);
        }
        if (q == 3) {
            float* lt = (float*)(ws + WS_LTOT) + (size_t)(b * 32 + n) * 1024 + nb * 128 + d;
            lt[0] = A; lt[(size_t)128 * 1024] = h;
        }
    }
}

__device__ void lru_out_item(KP p, int item) {
    char* ws = p->ws;
    int tid = threadIdx.x; asm volatile("" : "+v"(tid));
    const int n = item & 31, b = item >> 5, t0 = b * 2048 + n * 64, ch = tid * 2;
    const bf16_t* hl = (const bf16_t*)(ws + WS_HLOC); const bf16_t* ac = (const bf16_t*)(ws + WS_ACUM);
    const float* lt = (const float*)(ws + WS_LTOT);
    const bf16_t* proj = (const bf16_t*)(ws + WS_PROJ);
    bf16_t* ycat = (bf16_t*)(ws + WS_YCAT);
    f32x2 carry = (f32x2){0.f, 0.f};
    for (int m0 = 0; m0 < n; m0 += 8) {
        f32x2 A2[8], H2[8];
#pragma unroll
        for (int u = 0; u < 8; ++u) {
            const int m = (m0 + u < n) ? (m0 + u) : (n - 1);
            const size_t tl = (size_t)(b * 32 + m) * 1024 + ch;
            A2[u] = *(const f32x2*)(lt + tl); H2[u] = *(const f32x2*)(lt + (size_t)128 * 1024 + tl);
        }
#pragma unroll
        for (int u = 0; u < 8; ++u) if (m0 + u < n) carry = A2[u] * carry + H2[u];
    }
    for (int i0 = 0; i0 < 64; i0 += 8) {
        unsigned h2[8], a2[8], gw[8];
#pragma unroll
        for (int u = 0; u < 8; ++u) {
            const size_t t = t0 + i0 + u;
            h2[u] = *(const unsigned*)(hl + t * 1024 + ch); a2[u] = *(const unsigned*)(ac + t * 1024 + ch);
            gw[u] = *(const unsigned*)(proj + t * LDP + 5120 + ch);
        }
#pragma unroll
        for (int u = 0; u < 8; ++u) {
            const size_t t = t0 + i0 + u;
            const float y0 = blo(h2[u]) + blo(a2[u]) * carry.x, y1 = bhi(h2[u]) + bhi(a2[u]) * carry.y;
            *(unsigned*)(ycat + t * 3072 + 1024 + ch) = pk2(y0 * blo(gw[u]), y1 * bhi(gw[u]));
        }
    }
}

__device__ void attn_item(LAS char* lds, KP p, int b, int h, int Pp) {
    char* ws = p->ws;
    int tid = threadIdx.x; asm volatile("" : "+v"(tid)); const int wid = tid >> 6, lane = tid & 63, fr = lane & 15, fq = lane >> 4;
    LAS bf16_t* Pw = (LAS bf16_t*)(lds + 81920 + wid * 4608);
    const bf16_t* qm = (const bf16_t*)(ws + WS_QM);
    const bf16_t* kn = (const bf16_t*)(ws + WS_KN) + (size_t)(b * 8 + h) * 2048 * 128;
    const bf16_t* kr = (const bf16_t*)(ws + WS_KROPE) + (size_t)b * 2048 * 64;
    const bf16_t* vt = (const bf16_t*)(ws + WS_VT) + (size_t)(b * 8 + h) * 128 * 2048;
    const int s0 = Pp * 256 + wid * 32, nkt = 4 * Pp + 4, qc = 4 * Pp + (wid >> 1);
    bf16x8 qf[2][6];
#pragma unroll
    for (int mi = 0; mi < 2; ++mi)
#pragma unroll
        for (int ks = 0; ks < 6; ++ks) qf[mi][ks] = *(const bf16x8*)(qm + ((size_t)((b * 8 + h) * 2048 + s0 + 16 * mi + fr)) * 192 + ks * 32 + fq * 8);
    f32x4 o[2][8];
#pragma unroll
    for (int mi = 0; mi < 2; ++mi)
#pragma unroll
        for (int nd = 0; nd < 8; ++nd) o[mi][nd] = (f32x4){0.f, 0.f, 0.f, 0.f};
    float mrow[2][4], lsum[2][4];
#pragma unroll
    for (int mi = 0; mi < 2; ++mi)
#pragma unroll
        for (int j = 0; j < 4; ++j) { mrow[mi][j] = -1e30f; lsum[mi][j] = 0.f; }
    const bf16_t* ksrc[3]; int kstep[3];
#pragma unroll
    for (int r = 0; r < 3; ++r) {
        const int q = tid + 512 * r, row = q / 24, pc = q - row * 24, lc = pc ^ (row & 7);
        if (lc < 16) { ksrc[r] = kn + (size_t)row * 128 + lc * 8; kstep[r] = 64 * 128; } else { ksrc[r] = kr + (size_t)row * 64 + (lc - 16) * 8; kstep[r] = 64 * 64; }
    }
    const bf16_t* vsrc[2];
#pragma unroll
    for (int r = 0; r < 2; ++r) { const int q = tid + 512 * r, d = q >> 3, pc = q & 7; vsrc[r] = vt + (size_t)d * 2048 + ((pc ^ (d & 7)) * 8); }
    const int ldsw = wid * 1024;
#define ATT_STAGE(kt, buf) do { _Pragma("unroll") for (int r_ = 0; r_ < 3; ++r_) \
        __builtin_amdgcn_global_load_lds((const unsigned*)(ksrc[r_] + (size_t)(kt) * kstep[r_]), (LAS unsigned*)(lds + (buf) * 24576 + ldsw + r_ * 8192), 16, 0, 0); \
      _Pragma("unroll") for (int r_ = 0; r_ < 2; ++r_) \
        __builtin_amdgcn_global_load_lds((const unsigned*)(vsrc[r_] + (kt) * 64), (LAS unsigned*)(lds + 49152 + (buf) * 16384 + ldsw + r_ * 8192), 16, 0, 0); } while (0)
    const int f7 = fr & 7, xq = fq ^ (f7 & 3), yq = f7 >> 2;
    const int ka0 = fr * 384 + xq * 16 + yq * 64, ka1 = fr * 384 + xq * 16 + (1 - yq) * 64;
    const int va0 = fr * 128 + xq * 16 + yq * 64, va1 = fr * 128 + xq * 16 + (1 - yq) * 64;
    __syncthreads();
    ATT_STAGE(0, 0); WAIT_V0(); __syncthreads();
    for (int kt = 0; kt < nkt; ++kt) {
        const int cur = kt & 1;
        if (kt + 1 < nkt) ATT_STAGE(kt + 1, cur ^ 1);
        if (kt <= qc) {
            const LAS char* Kb = (const LAS char*)(lds + cur * 24576);
            const LAS char* Vb = (const LAS char*)(lds + 49152 + cur * 16384);
            f32x4 s[2][4];
#pragma unroll
            for (int mi = 0; mi < 2; ++mi)
#pragma unroll
                for (int n = 0; n < 4; ++n) s[mi][n] = (f32x4){0.f, 0.f, 0.f, 0.f};
            __builtin_amdgcn_sched_barrier(0);
            __builtin_amdgcn_s_setprio(1);
            {
                bf16x8 kf[6][4];
#pragma unroll
                for (int ks = 0; ks < 6; ++ks)
#pragma unroll
                    for (int n = 0; n < 4; ++n) kf[ks][n] = *(const LAS bf16x8*)(Kb + ((ks & 1) ? ka1 : ka0) + n * 6144 + (ks >> 1) * 128);
#pragma unroll
                for (int ks = 0; ks < 6; ++ks)
#pragma unroll
                    for (int n = 0; n < 4; ++n) { s[0][n] = MFMA16(qf[0][ks], kf[ks][n], s[0][n]); s[1][n] = MFMA16(qf[1][ks], kf[ks][n], s[1][n]); }
                __builtin_amdgcn_sched_group_barrier(0x100, 8, 0);
                __builtin_amdgcn_sched_group_barrier(0x008, 8, 0); __builtin_amdgcn_sched_group_barrier(0x100, 4, 0);
                __builtin_amdgcn_sched_group_barrier(0x008, 8, 0); __builtin_amdgcn_sched_group_barrier(0x100, 4, 0);
                __builtin_amdgcn_sched_group_barrier(0x008, 8, 0); __builtin_amdgcn_sched_group_barrier(0x100, 4, 0);
                __builtin_amdgcn_sched_group_barrier(0x008, 8, 0); __builtin_amdgcn_sched_group_barrier(0x100, 4, 0);
                __builtin_amdgcn_sched_group_barrier(0x008, 16, 0);
            }
            __builtin_amdgcn_s_setprio(0);
            __builtin_amdgcn_sched_barrier(0);
#pragma unroll
            for (int mi = 0; mi < 2; ++mi)
#pragma unroll
                for (int j = 0; j < 4; ++j) {
                    float mx = fmaxf(fmaxf(s[mi][0][j], s[mi][1][j]), fmaxf(s[mi][2][j], s[mi][3][j]));
                    mx = row16_max(mx);
                    const float mnew = fmaxf(mrow[mi][j], mx);
                    if (__builtin_amdgcn_ballot_w64(mnew != mrow[mi][j]) != 0ull) {
                        const float alpha = __builtin_amdgcn_exp2f(mrow[mi][j] - mnew);
                        mrow[mi][j] = mnew; lsum[mi][j] *= alpha;
#pragma unroll
                        for (int nd = 0; nd < 8; ++nd) o[mi][nd][j] *= alpha;
                    }
#pragma unroll
                    for (int n = 0; n < 4; ++n) { const float pe = __builtin_amdgcn_exp2f(s[mi][n][j] - mnew); lsum[mi][j] += pe; Pw[(16 * mi + 4 * fq + j) * 72 + n * 16 + fr] = (bf16_t)pk2(pe, 0.f); }
                }
            WAIT_L0(); __builtin_amdgcn_wave_barrier();
            __builtin_amdgcn_sched_barrier(0);
            __builtin_amdgcn_s_setprio(1);
            {
                bf16x8 pa[2][2], vb[2][8];
#pragma unroll
                for (int ks2 = 0; ks2 < 2; ++ks2)
#pragma unroll
                    for (int mi = 0; mi < 2; ++mi) pa[mi][ks2] = *(const LAS bf16x8*)(Pw + (16 * mi + fr) * 72 + ks2 * 32 + fq * 8);
#pragma unroll
                for (int ks2 = 0; ks2 < 2; ++ks2)
#pragma unroll
                    for (int nd = 0; nd < 8; ++nd) vb[ks2][nd] = *(const LAS bf16x8*)(Vb + (ks2 ? va1 : va0) + nd * 2048);
#pragma unroll
                for (int ks2 = 0; ks2 < 2; ++ks2)
#pragma unroll
                    for (int nd = 0; nd < 8; ++nd) { o[0][nd] = MFMA16(pa[0][ks2], vb[ks2][nd], o[0][nd]); o[1][nd] = MFMA16(pa[1][ks2], vb[ks2][nd], o[1][nd]); }
                __builtin_amdgcn_sched_group_barrier(0x100, 12, 0);
                __builtin_amdgcn_sched_group_barrier(0x008, 4, 0); __builtin_amdgcn_sched_group_barrier(0x100, 2, 0);
                __builtin_amdgcn_sched_group_barrier(0x008, 4, 0); __builtin_amdgcn_sched_group_barrier(0x100, 2, 0);
                __builtin_amdgcn_sched_group_barrier(0x008, 4, 0); __builtin_amdgcn_sched_group_barrier(0x100, 2, 0);
                __builtin_amdgcn_sched_group_barrier(0x008, 4, 0); __builtin_amdgcn_sched_group_barrier(0x100, 2, 0);
                __builtin_amdgcn_sched_group_barrier(0x008, 16, 0);
            }
            __builtin_amdgcn_s_setprio(0);
            __builtin_amdgcn_sched_barrier(0);
        }
        WAIT_V0(); __syncthreads();
    }
#undef ATT_STAGE
    const bf16_t* proj = (const bf16_t*)(ws + WS_PROJ);
    bf16_t* ycat = (bf16_t*)(ws + WS_YCAT);
    LAS bf16_t* Ow = (LAS bf16_t*)(lds + wid * 8704);
#pragma unroll
    for (int mi = 0; mi < 2; ++mi)
#pragma unroll
        for (int j = 0; j < 4; ++j) {
            const float ls = row16_sum(lsum[mi][j]);
            const float inv = 1.0f / ls;
#pragma unroll
            for (int nd = 0; nd < 8; ++nd) Ow[(16 * mi + 4 * fq + j) * 136 + nd * 16 + fr] = f2bf(o[mi][nd][j] * inv);
        }
    WAIT_L0(); __builtin_amdgcn_wave_barrier();
#pragma unroll
    for (int r = 0; r < 8; ++r) {
        const int q = lane + 64 * r, row = q >> 4, c8 = (q & 15) * 8;
        const size_t t = (size_t)b * 2048 + s0 + row;
        const u32x4 ov = *(const LAS u32x4*)(Ow + row * 136 + c8);
        const u32x4 gv = *(const u32x4*)(proj + t * LDP + 7168 + h * 128 + c8);
        u32x4 y;
#pragma unroll
        for (int e = 0; e < 4; ++e) y[e] = pk2(blo(ov[e]) * blo(gv[e]), bhi(ov[e]) * bhi(gv[e]));
        *(u32x4*)(ycat + t * 3072 + 2048 + h * 128 + c8) = y;
    }
}

#define XB_TMO      128
#define XB_XCNT(j)  (256  + 64 * (j))
#define XB_XSUB(j)  (1280 + 64 * (j))
#define XB_XGEN(j)  (2304 + 64 * (j))
#define XB_TOP      3328
#define XB_TOPGEN   3392
#define XCD_BAR_WORDS 3456
#define XB_SPIN_CAP (1u << 18)
__device__ __forceinline__ unsigned xb_ld(unsigned* p)              { return __hip_atomic_load(p, __ATOMIC_RELAXED, __HIP_MEMORY_SCOPE_AGENT); }
__device__ __forceinline__ unsigned xb_add(unsigned* p, unsigned v) { return __hip_atomic_fetch_add(p, v, __ATOMIC_RELAXED, __HIP_MEMORY_SCOPE_AGENT); }
__device__ __forceinline__ unsigned xb_xcc_id() { return (unsigned)__builtin_amdgcn_s_getreg((3 << 11) | 20) & 0xFu; }
#define XB_SPIN(cond, bar) do { unsigned _sp = 0; while (cond) { __builtin_amdgcn_s_sleep(1); \
    if ((++_sp & 255u) == 0u) { if (xb_ld(&(bar)[XB_TMO])) break; if (_sp > XB_SPIN_CAP) { atomicAdd(&(bar)[XB_TMO], 1u); break; } } } } while (0)
struct XcdBarrier { unsigned* bar; unsigned x; volatile LAS unsigned* st; };
__device__ __forceinline__ XcdBarrier xcd_barrier_post(unsigned* bar, volatile LAS unsigned* st) {
    XcdBarrier b; b.bar = bar; b.x = xb_xcc_id(); b.st = st;
    if (threadIdx.x == 0) (void)xb_add(&bar[XB_XCNT(b.x)], 1u);
    return b;
}
__device__ __forceinline__ void xcd_barrier_complete(unsigned* bar, unsigned x, unsigned& nloc, unsigned& nx) {
    const unsigned G = gridDim.x * gridDim.y * gridDim.z;
    unsigned sum, cnt, mine, sp = 0u;
    for (;;) {
        sum = 0u; cnt = 0u; mine = 0u;
#pragma unroll
        for (unsigned j = 0; j < 16; ++j) { const unsigned c = xb_ld(&bar[XB_XCNT(j)]); sum += c; cnt += (c > 0u) ? 1u : 0u; mine = (j == x) ? c : mine; }
        if (sum == G) break;
        __builtin_amdgcn_s_sleep(1);
        if ((++sp & 255u) == 0u) { if (xb_ld(&bar[XB_TMO])) break; if (sp > XB_SPIN_CAP) { atomicAdd(&bar[XB_TMO], 1u); break; } }
    }
    nloc = mine > 0u ? mine : 1u; nx = cnt > 0u ? cnt : 1u;
}
__device__ __forceinline__ void xcd_barrier(const XcdBarrier& b) {
    asm volatile("s_waitcnt vmcnt(0)" ::: "memory");
    __syncthreads();
    if (threadIdx.x == 0) {
        unsigned* bar = b.bar; asm volatile("" : "+s"(bar));
        __builtin_amdgcn_s_waitcnt(0);
        unsigned nloc = b.st[0], nx = b.st[1];
        if (nloc == 0u) { xcd_barrier_complete(bar, b.x, nloc, nx); b.st[0] = nloc; b.st[1] = nx; }
        const unsigned old = xb_add(&bar[XB_XSUB(b.x)], 1u);
        const unsigned gen = old / nloc;
        if (old + 1u == (gen + 1u) * nloc) {
            __builtin_amdgcn_fence(__ATOMIC_RELEASE, "agent");
            asm volatile("s_waitcnt vmcnt(0)" ::: "memory");
            const unsigned og = xb_add(&bar[XB_TOP], 1u);
            const unsigned tg = og / nx;
            if (og + 1u == (tg + 1u) * nx) xb_add(&bar[XB_TOPGEN], 1u);
            else XB_SPIN(xb_ld(&bar[XB_TOPGEN]) == tg, bar);
            __builtin_amdgcn_fence(__ATOMIC_ACQUIRE, "agent");
            xb_add(&bar[XB_XGEN(b.x)], 1u);
            asm volatile("s_waitcnt vmcnt(0)" ::: "memory");
        } else {
            XB_SPIN(xb_ld(&bar[XB_XGEN(b.x)]) == gen, bar);
            __builtin_amdgcn_fence(__ATOMIC_ACQUIRE, "agent");
            asm volatile("s_waitcnt vmcnt(0)" ::: "memory");
        }
    }
    __syncthreads();
}

#define Q_BEGIN(ctrp) unsigned* qctr_ = (ctrp); volatile LAS int* qslot_ = (volatile LAS int*)(lds + 131072 + 8); int qnxt_ = 0
#define Q_ISSUE() do { int r_ = 0; if (threadIdx.x == 0) r_ = (int)__hip_atomic_fetch_add(qctr_, 1u, __ATOMIC_RELAXED, __HIP_MEMORY_SCOPE_AGENT); qnxt_ = r_; } while (0)
#define Q_TAKE(it) do { __syncthreads(); if (threadIdx.x == 0) *qslot_ = G + qnxt_; __syncthreads(); (it) = *qslot_; } while (0)

__global__ void __launch_bounds__(512) fwd_megakernel(Params parg) {
    __shared__ __attribute__((aligned(1024))) char shm[131072 + 16];
    LAS char* lds = (LAS char*)shm;
    const int G = gridDim.x, c = blockIdx.x;
    volatile LAS unsigned* xst = (volatile LAS unsigned*)(lds + 131072);
    unsigned* xbar = (unsigned*)(parg.ws + WS_BAR);
    if (threadIdx.x == 0) { xst[0] = 0u; xst[1] = 0u; }
    __syncthreads();
    XcdBarrier xb = xcd_barrier_post(xbar, xst);
    if (parg.ph_lo > 1000) cg::this_grid().sync();
#define GRID_SYNC() xcd_barrier(xb)
    for (int ph = parg.ph_lo; ph < parg.ph_hi; ++ph) {
      const int ptype = ph < 2 ? ph : 2 + (ph - 2) % 6;
      const int nrep = 1 + ((REPMASK >> ptype) & 1);
      for (int rep = 0; rep < nrep; ++rep) {
        if (rep) GRID_SYNC();
        const bool skip_epi = VAR_NOEPI && (rep + 1 < nrep);
        KP p = get_kp();
        char* ws = p->ws;
        if (ph == 0) {
            if (PMASK & 1) phase0(lds, p);
        } else if (ph == 1) {
            if (PMASK & 2) rowpass(p, -1);
        } else {
            const int l = (ph - 2) / 6, sub = (ph - 2) % 6;
            if (sub == 0 && (PMASK & 4)) {
                const bf16_t* A = (const bf16_t*)(ws + WS_HBUF);
                const bf16_t* Bt = (const bf16_t*)(ws + WS_WI) + (size_t)l * NP1 * 2048;
                for (int L = c; L < 32 * 56; L += G) {
                    int pm, pn; tile_map(L, 32, 56, pm, pn);
                    f32x4 acc[8][4];
                    gemm256(lds, A + (size_t)pm * 256 * 2048, 2048, Bt + (size_t)pn * 256 * 2048, 2048, 2048, acc);
                    OPAQUE_WS(wx); EPI_IDS;
                    EpiProj e{(bf16_t*)(wx + WS_PROJ), (bf16_t*)(wx + WS_KROPE), (float*)(wx + WS_RSQ), (const float*)(wx + WS_COSR), (const float*)(wx + WS_SINR),
                              (const float*)(wx + WS_COSM), (const float*)(wx + WS_SINM), pm * 256, pn * 256};
                    if (!skip_epi) e(acc, wr_, wc_, fr_, fq_);
                }
            } else if (sub == 1 && (PMASK & 8)) {
                Q_BEGIN(xbar + 3520 + (ph * 2 + rep) * 8);
                const int nP2 = 32 + 192 + 256 + 256 + 1024 + (l + 1 < DEPTH ? 324 : 0);
                for (int it = c; it < nP2;) {
                    KP p = get_kp(); char* ws = p->ws;
                    if (it >= 480) Q_ISSUE();
                    if (it < 32) {
                        const int pm = it;
                        f32x4 acc[8][4];
                        gemm256(lds, (const bf16_t*)(ws + WS_HBUF) + (size_t)pm * 256 * 2048, 2048, (const bf16_t*)(ws + WS_WI) + (size_t)l * NP1 * 2048 + (size_t)14336 * 2048, 2048, 2048, acc);
                        Q_ISSUE();
                        OPAQUE_WS(wx); EPI_IDS;
                        EpiProj e{(bf16_t*)(wx + WS_PROJ), (bf16_t*)(wx + WS_KROPE), (float*)(wx + WS_RSQ), (const float*)(wx + WS_COSR), (const float*)(wx + WS_SINR),
                                  (const float*)(wx + WS_COSM), (const float*)(wx + WS_SINM), pm * 256, 14336};
                        if (!skip_epi) e(acc, wr_, wc_, fr_, fq_);
                    } else if (it < 224) {
                        const int i2 = it - 32, pm = i2 & 31, pn = i2 >> 5;
                        f32x4 acc[8][4];
                        gemm256(lds, (const bf16_t*)(ws + WS_PROJ) + (size_t)pm * 256 * LDP + 6144, LDP, (const bf16_t*)(ws + WS_WUQ) + (size_t)l * 1536 * 512 + (size_t)pn * 256 * 512, 512, 512, acc);
                        Q_ISSUE();
                        OPAQUE_WS(wx); EPI_IDS;
                        EpiQ e{(bf16_t*)(wx + WS_QM), (const float*)(wx + WS_RSQ), (const float*)(wx + WS_COSM), (const float*)(wx + WS_SINM), pm * 256, pn * 256};
                        if (!skip_epi) e(acc, wr_, wc_, fr_, fq_);
                    } else if (it < 480) {
                        const int i2 = it - 224, pm = i2 & 31, pn = i2 >> 5;
                        f32x4 acc[8][4];
                        gemm256(lds, (const bf16_t*)(ws + WS_PROJ) + (size_t)pm * 256 * LDP + 6656, LDP, (const bf16_t*)(ws + WS_WUKV) + (size_t)l * 2048 * 512 + (size_t)pn * 256 * 512, 512, 512, acc);
                        Q_ISSUE();
                        OPAQUE_WS(wx); EPI_IDS;
                        EpiKV e{(bf16_t*)(wx + WS_KN), (bf16_t*)(wx + WS_VT), (const float*)(wx + WS_RSQ), pm * 256, pn};
                        if (!skip_epi) e(acc, wr_, wc_, fr_, fq_);
                    } else if (it < 736) {
                        ret_item<false>(lds, p, l, it - 480);
                    } else if (it < 1760) {
                        lru_item(lds, p, l, it - 736);
                    } else {
                        conv4(lds, p, (l + 1) * 2592 + (it - 1760) * 4);
                    }
                    Q_TAKE(it);
                }
            } else if (sub == 2 && (PMASK & 16)) {
                Q_BEGIN(xbar + 3520 + (ph * 2 + rep) * 8);
                const int nP3 = 256 + 256 + 128 + (l + 1 < DEPTH ? 324 : 0);
                for (int it = c; it < nP3;) {
                    KP p = get_kp();
                    Q_ISSUE();
                    if (it < 256) {
                        const int bh = it & 31, Pp = 7 - (it >> 5);
                        attn_item(lds, p, bh >> 3, bh & 7, Pp);
                    } else if (it < 512) {
                        ret_item<true>(lds, p, l, it - 256);
                    } else if (it < 640) {
                        lru_out_item(p, it - 512);
                    } else {
                        conv4(lds, p, (l + 1) * 2592 + 1296 + (it - 640) * 4);
                    }
                    Q_TAKE(it);
                }
            } else if (sub == 3 && (PMASK & 32)) {
                for (int L = c; L < 256; L += G) {
                    int pm, pn; tile_map(L, 32, 8, pm, pn);
                    f32x4 acc[8][4];
#pragma unroll
                    for (int m_ = 0; m_ < 8; ++m_)
#pragma unroll
                        for (int n_ = 0; n_ < 4; ++n_) acc[m_][n_] = (f32x4){0.f, 0.f, 0.f, 0.f};
#pragma unroll 1
                    for (int i = 0; i < 3; ++i) {
                        gemm256(lds, (const bf16_t*)(ws + WS_YCAT) + (size_t)pm * 256 * 3072 + i * 1024, 3072,
                                (const bf16_t*)(ws + WS_WB) + (size_t)l * 2048 * 3072 + (size_t)pn * 256 * 3072 + i * 1024, 3072, 1024, acc, false);
                        OPAQUE_WS(wx); EPI_IDS;
                        EpiBranch e{(const bf16_t*)(wx + WS_PROJ) + 8192, (bf16_t*)(wx + WS_MERGED), i, pm * 256, pn * 256};
                        if (!skip_epi || i < 2) e(acc, wr_, wc_, fr_, fq_);
                    }
                }
            } else if (sub == 4 && (PMASK & 64)) {
                for (int L = c; L < 256; L += G) {
                    int pm, pn; tile_map(L, 32, 8, pm, pn);
                    f32x4 acc[8][4];
                    gemm256(lds, (const bf16_t*)(ws + WS_MERGED) + (size_t)pm * 256 * 2048, 2048, (const bf16_t*)(ws + WS_WO) + (size_t)l * 2048 * 2048 + (size_t)pn * 256 * 2048, 2048, 2048, acc);
                    OPAQUE_WS(wx); EPI_IDS;
                    EpiOut e{(bf16_t*)(wx + WS_YBUF), pm * 256, pn * 256};
                    if (!skip_epi) e(acc, wr_, wc_, fr_, fq_);
                }
            } else if (sub == 5 && (PMASK & 128)) {
                rowpass(p, l);
            }
        }
      }
        if (ph + 1 < parg.ph_hi) GRID_SYNC();
    }
}

extern "C" void kernel_launch(void* const* d_in, const int* in_sizes, int n_in, void* d_out, int out_size, void* d_ws, size_t ws_size, hipStream_t stream) {
    static int grid_blocks = 0;
    if (!grid_blocks) {
        int dev = 0, cus = 0, per_cu = 0;
        hipGetDevice(&dev);
        hipDeviceGetAttribute(&cus, hipDeviceAttributeMultiprocessorCount, dev);
        hipOccupancyMaxActiveBlocksPerMultiprocessor(&per_cu, fwd_megakernel, 512, 0);
        if (per_cu < 1) { fprintf(stderr, "kernel_launch: occupancy query returned %d\n", per_cu); per_cu = 1; }
        if (per_cu > 1) per_cu = 1;
        grid_blocks = cus * per_cu;
        if (ws_size < WS_END) fprintf(stderr, "kernel_launch: workspace too small: %zu < %zu\n", ws_size, (size_t)WS_END);
    }
    if (n_in != 22 || ws_size < WS_END) return;
    Params p{};
    for (int i = 0; i < 22; ++i) p.in[i] = (const float*)d_in[i];
    p.pos = (const int*)d_in[2];
    p.out = (float*)d_out;
    p.ws = (char*)d_ws;
    constexpr int NPH = 2 + 6 * DEPTH;
#if MULTI_LAUNCH
    for (int ph = 0; ph < NPH; ++ph) {
        p.ph_lo = ph; p.ph_hi = ph + 1;
        hipLaunchKernelGGL(fwd_megakernel, dim3(grid_blocks), dim3(512), 0, stream, p);
    }
#else
    p.ph_lo = 0; p.ph_hi = NPH;
    if (hipMemsetAsync((char*)d_ws + WS_BAR, 0, 4096 * 4, stream) != hipSuccess) { fprintf(stderr, "kernel_launch: hipMemsetAsync failed\n"); return; }
    void* args[] = {&p};
    hipError_t e = hipLaunchCooperativeKernel((void*)fwd_megakernel, dim3(grid_blocks), dim3(512), args, 0, stream);
    if (e != hipSuccess) fprintf(stderr, "cooperative launch failed: %s (grid %d)\n", hipGetErrorString(e), grid_blocks);
#endif
}
```

```cpp
#include <hip/hip_runtime.h>
#include <hip/hip_cooperative_groups.h>
#include <cstdio>
namespace cg = cooperative_groups;

#ifndef MULTI_LAUNCH
#define MULTI_LAUNCH 0
#endif

#ifndef PMASK
#define PMASK 0xff
#endif
#ifndef VAR_NOEPI
#define VAR_NOEPI 0
#endif
#ifndef REPMASK
#define REPMASK 0
#endif
#define LAS __attribute__((address_space(3)))
typedef unsigned short bf16_t;
typedef short bf16x8 __attribute__((ext_vector_type(8)));
typedef float f32x4 __attribute__((ext_vector_type(4)));
typedef float f32x2 __attribute__((ext_vector_type(2)));
typedef unsigned u32x4 __attribute__((ext_vector_type(4)));
typedef unsigned u32x2 __attribute__((ext_vector_type(2)));

constexpr int T = 8192, D = 2048, SEQ = 2048, DEPTH = 4;
constexpr int LDP = 14336;
constexpr int NP1 = 14592;
constexpr int NIN = 14400;
constexpr float EPS = 1e-6f;
constexpr float QSCALE = 0.07216878364870322f * 1.4426950408889634f;
constexpr float RQSCALE = 0.08838834764831845f;

constexpr size_t al256(size_t x) { return (x + 255) & ~(size_t)255; }
constexpr size_t WS_WI = 0;
constexpr size_t WS_WUQ = WS_WI + al256((size_t)DEPTH * NP1 * 2048 * 2);
constexpr size_t WS_WUKV = WS_WUQ + al256((size_t)DEPTH * 1536 * 512 * 2);
constexpr size_t WS_WB = WS_WUKV + al256((size_t)DEPTH * 2048 * 512 * 2);
constexpr size_t WS_WO = WS_WB + al256((size_t)DEPTH * 2048 * 3072 * 2);
constexpr size_t WS_WA = WS_WO + al256((size_t)DEPTH * 2048 * 2048 * 2);
constexpr size_t WS_WX = WS_WA + al256((size_t)DEPTH * 8 * 128 * 128 * 2);
constexpr size_t WS_MOD = WS_WX + al256((size_t)DEPTH * 8 * 128 * 128 * 2);
constexpr size_t WS_COSR = WS_MOD + al256((size_t)DEPTH * 4 * 6144 * 4);
constexpr size_t WS_SINR = WS_COSR + al256((size_t)T * 64 * 4);
constexpr size_t WS_COSM = WS_SINR + al256((size_t)T * 64 * 4);
constexpr size_t WS_SINM = WS_COSM + al256((size_t)T * 32 * 4);
constexpr size_t WS_XCUR = WS_SINM + al256((size_t)T * 32 * 4);
constexpr size_t WS_HBUF = WS_XCUR + al256((size_t)T * D * 4);
constexpr size_t WS_PROJ = WS_HBUF + al256((size_t)T * D * 2);
constexpr size_t WS_KROPE = WS_PROJ + al256((size_t)T * LDP * 2);
constexpr size_t WS_RSQ = WS_KROPE + al256((size_t)T * 64 * 2);
constexpr size_t WS_QM = WS_RSQ + al256((size_t)T * 16 * 4);
constexpr size_t WS_KN = WS_QM + al256((size_t)T * 8 * 192 * 2);
constexpr size_t WS_VT = WS_KN + al256((size_t)T * 8 * 128 * 2);
constexpr size_t WS_TOT = WS_VT + al256((size_t)T * 8 * 128 * 2);
constexpr size_t WS_HLOC = WS_TOT + al256((size_t)4 * 8 * 8 * 16384 * 4);
constexpr size_t WS_ACUM = WS_HLOC + al256((size_t)T * 1024 * 4);
constexpr size_t WS_YCAT = WS_ACUM + al256((size_t)T * 1024 * 4);
constexpr size_t WS_MACC = WS_YCAT + al256((size_t)T * 3072 * 2);
constexpr size_t WS_MERGED = WS_MACC + al256((size_t)T * D * 4);
constexpr size_t WS_YBUF = WS_MERGED + al256((size_t)T * D * 2);
constexpr size_t WS_BAR = WS_YBUF + al256((size_t)T * D * 4);
constexpr size_t WS_LTOT = WS_BAR + al256((size_t)4096 * 4);
constexpr size_t WS_END = WS_LTOT + al256((size_t)2 * 128 * 1024 * 4);

struct Params {
    const float* in[22];
    const int* pos;
    float* out;
    char* ws;
    int ph_lo, ph_hi;
};

typedef const Params __attribute__((address_space(4)))* KP;
__device__ __forceinline__ KP get_kp() { KP k = (KP)__builtin_amdgcn_kernarg_segment_ptr(); asm volatile("" : "+s"(k)); return k; }

__device__ __forceinline__ float bf2f(unsigned h) { return __uint_as_float(h << 16); }
__device__ __forceinline__ bf16_t f2bf(float f) { unsigned u = __float_as_uint(f); return (bf16_t)((u + 0x7fffu + ((u >> 16) & 1u)) >> 16); }
__device__ __forceinline__ unsigned pk2(float lo, float hi) { unsigned r; asm("s_nop 1\n\tv_cvt_pk_bf16_f32 %0, %1, %2" : "=v"(r) : "v"(lo), "v"(hi)); return r; }
__device__ __forceinline__ float blo(unsigned w) { return __uint_as_float(w << 16); }
__device__ __forceinline__ float bhi(unsigned w) { return __uint_as_float(w & 0xffff0000u); }
__device__ __forceinline__ float sigmoidf_(float x) { return __builtin_amdgcn_rcpf(1.0f + __builtin_amdgcn_exp2f(-1.4426950408889634f * x)); }
__device__ __forceinline__ float shx(float v, int lane, int k) { return __int_as_float(__builtin_amdgcn_ds_bpermute((lane ^ k) << 2, __float_as_int(v))); }
__device__ __forceinline__ float dppf(float v, const int ctrl_sel) {
    int r;
    if (ctrl_sel == 0) r = __builtin_amdgcn_update_dpp(0, __float_as_int(v), 0xB1, 0xf, 0xf, true);
    else if (ctrl_sel == 1) r = __builtin_amdgcn_update_dpp(0, __float_as_int(v), 0x4E, 0xf, 0xf, true);
    else if (ctrl_sel == 2) r = __builtin_amdgcn_update_dpp(0, __float_as_int(v), 0x124, 0xf, 0xf, true);
    else r = __builtin_amdgcn_update_dpp(0, __float_as_int(v), 0x128, 0xf, 0xf, true);
    return __int_as_float(r);
}
__device__ __forceinline__ float row16_max(float v) { v = fmaxf(v, dppf(v, 0)); v = fmaxf(v, dppf(v, 1)); v = fmaxf(v, dppf(v, 2)); v = fmaxf(v, dppf(v, 3)); return v; }
__device__ __forceinline__ float row16_sum(float v) { v += dppf(v, 0); v += dppf(v, 1); v += dppf(v, 2); v += dppf(v, 3); return v; }

__device__ __forceinline__ void store4bf(bf16_t* p, f32x4 v) { u32x2 o; o.x = pk2(v[0], v[1]); o.y = pk2(v[2], v[3]); *(u32x2*)p = o; }
__device__ __forceinline__ f32x4 load4bf(const bf16_t* p) { u32x2 w = *(const u32x2*)p; f32x4 r; r[0] = blo(w.x); r[1] = bhi(w.x); r[2] = blo(w.y); r[3] = bhi(w.y); return r; }
#define MFMA16(a, b, c) __builtin_amdgcn_mfma_f32_16x16x32_bf16((a), (b), (c), 0, 0, 0)
#define WAIT_V0() asm volatile("s_waitcnt vmcnt(0)" ::: "memory")
#define WAIT_L0() asm volatile("s_waitcnt lgkmcnt(0)" ::: "memory")

__device__ __forceinline__ int lds_byte2(int r, int c) { int st = (r >> 4) * 2 + (c >> 5), ob = (r & 15) * 64 + (c & 31) * 2; return st * 1024 + (ob ^ (((ob >> 9) & 1) << 5)); }
__device__ __forceinline__ void stage_rc2(int b, int& R, int& C) { int st = b >> 10, sb = b & 1023, swz = sb ^ (((sb >> 9) & 1) << 5); R = (st >> 1) * 16 + swz / 64; C = (st & 1) * 32 + (swz % 64) / 2; }

#define ROWOFF(wr, mi) ((((mi) >> 2) * 128) + (wr) * 64 + (((mi) & 3) * 16))
__device__ __forceinline__ void gemm256(LAS char* lds, const bf16_t* __restrict__ Ab, int lda, const bf16_t* __restrict__ Bb, int ldb, int K, f32x4 (&acc)[8][4], bool zero_acc = true) {
    int tid = threadIdx.x; asm volatile("" : "+v"(tid));
    const int wid = tid >> 6, lane = tid & 63, wr = wid >> 2, wc = wid & 3, fr = lane & 15, fq = lane >> 4;
    unsigned voA[2], voB[2];
#pragma unroll
    for (int i = 0; i < 2; ++i) {
        int R, C; stage_rc2(tid * 16 + i * 8192, R, C);
        voA[i] = (unsigned)(R * lda + C) * 2u;
        { const int rho = R & 31; voB[i] = (unsigned)(((R >> 5) * 64 + 8 * ((rho & 15) >> 2) + 4 * (rho >> 4) + (rho & 3)) * ldb + C) * 2u; }
    }
    const int swz = fr * 64 + ((fq * 16) ^ ((fr >> 3) << 5));
    const int aoff = wr * 8192 + swz, boff = wc * 4096 + swz, ldsw = wid * 1024;
    const size_t ahalf = (size_t)128 * lda * 2, bhalf = (size_t)32 * ldb * 2;
    if (zero_acc) {
#pragma unroll
        for (int m = 0; m < 8; ++m)
#pragma unroll
            for (int n = 0; n < 4; ++n) acc[m][n] = (f32x4){0.f, 0.f, 0.f, 0.f};
    }
#define SAo(b, h) (((b) * 2 + (h)) * 16384)
#define SBo(b, h) ((4 + (b) * 2 + (h)) * 16384)
#define STAGE_A(b, h, kt) do { const char* g_ = (const char*)Ab + (h) * ahalf + (size_t)(kt) * 128; _Pragma("unroll") for (int i_ = 0; i_ < 2; ++i_) \
        __builtin_amdgcn_global_load_lds((const unsigned*)(g_ + voA[i_]), (LAS unsigned*)(lds + SAo(b, h) + ldsw + i_ * 8192), 16, 0, 0); } while (0)
#define STAGE_B(b, h, kt) do { const char* g_ = (const char*)Bb + (h) * bhalf + (size_t)(kt) * 128; _Pragma("unroll") for (int i_ = 0; i_ < 2; ++i_) \
        __builtin_amdgcn_global_load_lds((const unsigned*)(g_ + voB[i_]), (LAS unsigned*)(lds + SBo(b, h) + ldsw + i_ * 8192), 16, 0, 0); } while (0)
#define LDA(dst, b, h) _Pragma("unroll") for (int m_ = 0; m_ < 4; ++m_) _Pragma("unroll") for (int k_ = 0; k_ < 2; ++k_) \
        dst[m_][k_] = *(const LAS bf16x8*)(lds + SAo(b, h) + aoff + m_ * 2048 + k_ * 1024)
#define LDB(dst, b, h) _Pragma("unroll") for (int n_ = 0; n_ < 2; ++n_) _Pragma("unroll") for (int k_ = 0; k_ < 2; ++k_) \
        dst[n_][k_] = *(const LAS bf16x8*)(lds + SBo(b, h) + boff + n_ * 2048 + k_ * 1024)
#define MMA(ai, bj, A_, B_) do { __builtin_amdgcn_s_setprio(1); \
        _Pragma("unroll") for (int m_ = 0; m_ < 4; ++m_) _Pragma("unroll") for (int n_ = 0; n_ < 2; ++n_) _Pragma("unroll") for (int k_ = 0; k_ < 2; ++k_) \
            acc[(ai) * 4 + m_][(bj) * 2 + n_] = MFMA16(B_[n_][k_], A_[m_][k_], acc[(ai) * 4 + m_][(bj) * 2 + n_]); \
        __builtin_amdgcn_s_setprio(0); } while (0)
#define WAIT_V(n) asm volatile("s_waitcnt vmcnt(" #n ")" ::: "memory")
#define WAIT_L(n) asm volatile("s_waitcnt lgkmcnt(" #n ")" ::: "memory")
#define BAR __builtin_amdgcn_s_barrier()
#define SCHED __builtin_amdgcn_sched_barrier(0)
    bf16x8 At[4][2], B0[2][2], B1[2][2];
    const int nt = K >> 6;
    __syncthreads();
    STAGE_B(0, 0, 0); STAGE_A(0, 0, 0); STAGE_B(0, 1, 0); STAGE_A(0, 1, 0);
    if (wr == 1) BAR;
    WAIT_V(4); BAR;
    STAGE_B(1, 0, 1); STAGE_A(1, 0, 1); STAGE_B(1, 1, 1);
    WAIT_V(6); BAR;
    for (int t = 0; t < nt - 2; t += 2) {
        LDB(B0, 0, 0); SCHED; LDA(At, 0, 0); STAGE_A(1, 1, t + 1);
        WAIT_L(8); BAR; WAIT_L(0); MMA(0, 0, At, B0); BAR; SCHED;
        LDB(B1, 0, 1); STAGE_B(0, 0, t + 2);
        BAR; WAIT_L(0); MMA(0, 1, At, B1); BAR;
        LDA(At, 0, 1); STAGE_A(0, 0, t + 2);
        BAR; WAIT_L(0); MMA(1, 0, At, B0); BAR; SCHED;
        STAGE_B(0, 1, t + 2);
        WAIT_V(6); BAR; MMA(1, 1, At, B1); BAR;
        LDB(B0, 1, 0); SCHED; LDA(At, 1, 0); STAGE_A(0, 1, t + 2);
        WAIT_L(8); BAR; WAIT_L(0); MMA(0, 0, At, B0); BAR; SCHED;
        LDB(B1, 1, 1); STAGE_B(1, 0, t + 3);
        BAR; WAIT_L(0); MMA(0, 1, At, B1); BAR;
        LDA(At, 1, 1); STAGE_A(1, 0, t + 3);
        BAR; WAIT_L(0); MMA(1, 0, At, B0); BAR; SCHED;
        STAGE_B(1, 1, t + 3);
        WAIT_V(6); BAR; MMA(1, 1, At, B1); BAR;
    }
    { LDB(B0, 0, 0); LDA(At, 0, 0); STAGE_A(1, 1, nt - 1);
      BAR; WAIT_L(0); MMA(0, 0, At, B0); BAR;
      LDB(B1, 0, 1); BAR; WAIT_L(0); MMA(0, 1, At, B1); BAR;
      LDA(At, 0, 1); WAIT_V(4); BAR; WAIT_L(0); MMA(1, 0, At, B0); MMA(1, 1, At, B1); BAR; }
    { LDB(B0, 1, 0); LDA(At, 1, 0); WAIT_V(2); BAR; WAIT_L(0); MMA(0, 0, At, B0); BAR;
      LDB(B1, 1, 1); WAIT_V(0); BAR; WAIT_L(0); MMA(0, 1, At, B1); BAR;
      LDA(At, 1, 1); BAR; WAIT_L(0); MMA(1, 0, At, B0); MMA(1, 1, At, B1); BAR; }
    if (wr == 0) BAR;
#undef SAo
#undef SBo
#undef STAGE_A
#undef STAGE_B
#undef LDA
#undef LDB
#undef MMA
#undef WAIT_V
#undef WAIT_L
#undef BAR
#undef SCHED
}
#define OPAQUE_WS(name) char* name = get_kp()->ws
#define EPI_IDS int tid_ = threadIdx.x; asm volatile("" : "+v"(tid_)); const int wid_ = tid_ >> 6, lane_ = tid_ & 63, wr_ = wid_ >> 2, wc_ = wid_ & 3, fr_ = lane_ & 15, fq_ = lane_ >> 4

__device__ __forceinline__ void tile_map(int L, int nM, int nN, int& pm, int& pn) {
    const int nwg = nM * nN; int wgid = L;
    { const int q = nwg / 8, r = nwg % 8, xcd = wgid % 8, off = wgid / 8; wgid = (xcd < r ? xcd * (q + 1) : r * (q + 1) + (xcd - r) * q) + off; }
    const int nig = 8 * nN, gid = wgid / nig, fm = gid * 8, gsz = (nM - fm) < 8 ? (nM - fm) : 8;
    pm = fm + ((wgid % nig) % gsz); pn = (wgid % nig) / gsz;
}

__device__ __forceinline__ void store8bf(bf16_t* p, f32x4 v0, f32x4 v1) { u32x4 o; o.x = pk2(v0[0], v0[1]); o.y = pk2(v0[2], v0[3]); o.z = pk2(v1[0], v1[1]); o.w = pk2(v1[2], v1[3]); *(u32x4*)p = o; }
__device__ __forceinline__ void load8bf(const bf16_t* p, f32x4& v0, f32x4& v1) { const u32x4 w = *(const u32x4*)p; v0[0] = blo(w.x); v0[1] = bhi(w.x); v0[2] = blo(w.y); v0[3] = bhi(w.y); v1[0] = blo(w.z); v1[1] = bhi(w.z); v1[2] = blo(w.w); v1[3] = bhi(w.w); }
__device__ __forceinline__ f32x4 silu4(f32x4 v) { f32x4 o; for (int j = 0; j < 4; ++j) o[j] = v[j] * sigmoidf_(v[j]); return o; }
__device__ __forceinline__ f32x4 sigm4(f32x4 v) { f32x4 o; for (int j = 0; j < 4; ++j) o[j] = sigmoidf_(v[j]); return o; }
__device__ __forceinline__ float sq4(f32x4 v) { return v[0] * v[0] + v[1] * v[1] + v[2] * v[2] + v[3] * v[3]; }

struct EpiProj {
    bf16_t* proj; bf16_t* krope; float* rsq; const float *cosr, *sinr, *cosm, *sinm; int brow, bcol;
    __device__ __forceinline__ void operator()(f32x4 (&acc)[8][4], int wr, int wc, int fr, int fq) const {
        const int c0 = bcol + wc * 64;
        int type;
        if (bcol < 1024) type = 0; else if (bcol < 2048) type = 1; else if (bcol < 3072) type = 2; else if (bcol < 4096) type = 3;
        else if (bcol < 5120) type = 2; else if (bcol < 6144) type = 3; else if (bcol < 7168) type = 4; else if (bcol < 8192) type = 3;
        else if (bcol < 14336) type = 5; else type = 6;
#pragma unroll
        for (int m = 0; m < 8; ++m) {
            const int t = brow + ROWOFF(wr, m) + fr;
            bf16_t* rowp = proj + (size_t)t * LDP + c0 + 8 * fq;
            if (type == 0 || type == 1) {
                const int blk = (c0 >> 6) & 1; const float sc = type == 0 ? RQSCALE : 1.0f;
                f32x4 o1[2], o2[2];
#pragma unroll
                for (int n = 0; n < 2; ++n) {
                    const int f0 = 32 * blk + 8 * fq + 4 * n;
                    const f32x4 cs = *(const f32x4*)(cosr + (size_t)t * 64 + f0), sn = *(const f32x4*)(sinr + (size_t)t * 64 + f0);
                    const f32x4 x1 = acc[m][n], x2 = acc[m][n + 2];
                    o1[n] = (x1 * cs - x2 * sn) * sc; o2[n] = (x2 * cs + x1 * sn) * sc;
                }
                store8bf(rowp, o1[0], o1[1]); store8bf(rowp + 32, o2[0], o2[1]);
            } else if (type == 2) {
                store8bf(rowp, acc[m][0], acc[m][1]); store8bf(rowp + 32, acc[m][2], acc[m][3]);
            } else if (type == 3) {
                store8bf(rowp, silu4(acc[m][0]), silu4(acc[m][1])); store8bf(rowp + 32, silu4(acc[m][2]), silu4(acc[m][3]));
            } else if (type == 4) {
                float s = sq4(acc[m][0]) + sq4(acc[m][1]) + sq4(acc[m][2]) + sq4(acc[m][3]);
                store8bf(rowp, acc[m][0], acc[m][1]); store8bf(rowp + 32, acc[m][2], acc[m][3]);
                { const int ln_ = fq * 16 + fr; s += shx(s, ln_, 16); s += shx(s, ln_, 32); }
                if (fq == 0) rsq[(size_t)t * 16 + ((c0 - 6144) >> 6)] = s;
            } else if (type == 5) {
                store8bf(rowp, sigm4(acc[m][0]), sigm4(acc[m][1])); store8bf(rowp + 32, sigm4(acc[m][2]), sigm4(acc[m][3]));
            } else {
                if (wc == 0) {
                    f32x4 o1[2], o2[2];
#pragma unroll
                    for (int n = 0; n < 2; ++n) {
                        const int f0 = 8 * fq + 4 * n;
                        const f32x4 cs = *(const f32x4*)(cosm + (size_t)t * 32 + f0), sn = *(const f32x4*)(sinm + (size_t)t * 32 + f0);
                        const f32x4 x1 = acc[m][n], x2 = acc[m][n + 2];
                        o1[n] = x1 * cs - x2 * sn; o2[n] = x2 * cs + x1 * sn;
                    }
                    store8bf(krope + (size_t)t * 64 + 8 * fq, o1[0], o1[1]); store8bf(krope + (size_t)t * 64 + 32 + 8 * fq, o2[0], o2[1]);
                }
            }
        }
    }
};

struct EpiQ {
    bf16_t* qm; const float* rsq; const float *cosm, *sinm; int brow, bcol;
    __device__ __forceinline__ void operator()(f32x4 (&acc)[8][4], int wr, int wc, int fr, int fq) const {
        const int c0 = bcol + wc * 64, head = c0 / 192, within = c0 - head * 192;
        float rsv[8];
#pragma unroll
        for (int m = 0; m < 8; ++m) {
            const int t = brow + ROWOFF(wr, m) + fr;
            const f32x4 r0 = *(const f32x4*)(rsq + (size_t)t * 16), r1 = *(const f32x4*)(rsq + (size_t)t * 16 + 4);
            const float ss = r0[0] + r0[1] + r0[2] + r0[3] + r1[0] + r1[1] + r1[2] + r1[3];
            rsv[m] = rsqrtf(ss * (1.0f / 512.0f) + EPS) * QSCALE;
        }
#pragma unroll
        for (int m = 0; m < 8; ++m) {
            const int t = brow + ROWOFF(wr, m) + fr, b = t >> 11, s = t & 2047;
            const float rs = rsv[m];
            bf16_t* base = qm + ((size_t)((b * 8 + head) * 2048 + s)) * 192 + within + 8 * fq;
            if (within != 128) {
                store8bf(base, acc[m][0] * rs, acc[m][1] * rs); store8bf(base + 32, acc[m][2] * rs, acc[m][3] * rs);
            } else {
                f32x4 o1[2], o2[2];
#pragma unroll
                for (int n = 0; n < 2; ++n) {
                    const int f0 = 8 * fq + 4 * n;
                    const f32x4 cs = *(const f32x4*)(cosm + (size_t)t * 32 + f0), sn = *(const f32x4*)(sinm + (size_t)t * 32 + f0);
                    const f32x4 x1 = acc[m][n] * rs, x2 = acc[m][n + 2] * rs;
                    o1[n] = x1 * cs - x2 * sn; o2[n] = x2 * cs + x1 * sn;
                }
                store8bf(base, o1[0], o1[1]); store8bf(base + 32, o2[0], o2[1]);
            }
        }
    }
};

struct EpiKV {
    bf16_t* kn; bf16_t* vt; const float* rsq; int brow, head;
    __device__ __forceinline__ void operator()(f32x4 (&acc)[8][4], int wr, int wc, int fr, int fq) const {
        float rsv[8];
#pragma unroll
        for (int m = 0; m < 8; ++m) {
            const int t = brow + ROWOFF(wr, m) + fr;
            const f32x4 r0 = *(const f32x4*)(rsq + (size_t)t * 16 + 8), r1 = *(const f32x4*)(rsq + (size_t)t * 16 + 12);
            const float ss = r0[0] + r0[1] + r0[2] + r0[3] + r1[0] + r1[1] + r1[2] + r1[3];
            rsv[m] = rsqrtf(ss * (1.0f / 512.0f) + EPS);
        }
#pragma unroll
        for (int m = 0; m < 8; ++m) {
            const int t = brow + ROWOFF(wr, m) + fr, b = t >> 11, s = t & 2047;
            const float rs = rsv[m];
            if (wc < 2) {
                bf16_t* base = kn + ((size_t)((b * 8 + head) * 2048 + s)) * 128 + wc * 64 + 8 * fq;
                store8bf(base, acc[m][0] * rs, acc[m][1] * rs); store8bf(base + 32, acc[m][2] * rs, acc[m][3] * rs);
            } else {
#pragma unroll
                for (int n = 0; n < 4; ++n)
#pragma unroll
                    for (int j = 0; j < 4; j += 2) {
                        const int d = (wc - 2) * 64 + (n >> 1) * 32 + 8 * fq + 4 * (n & 1) + j;
                        const unsigned pv_ = pk2(acc[m][n][j] * rs, acc[m][n][j + 1] * rs);
                        vt[((size_t)((b * 8 + head) * 128 + d)) * 2048 + s] = (bf16_t)pv_;
                        vt[((size_t)((b * 8 + head) * 128 + d + 1)) * 2048 + s] = (bf16_t)(pv_ >> 16);
                    }
            }
        }
    }
};

struct EpiBranch {
    const bf16_t* gates; bf16_t* merged; int mode, brow, bcol;
    __device__ __forceinline__ void operator()(f32x4 (&acc)[8][4], int wr, int wc, int fr, int fq) const {
        const int col0 = bcol + wc * 64 + 8 * fq;
        const size_t t0 = (size_t)(brow + fr);
#pragma unroll
        for (int m = 0; m < 8; ++m) {
            const size_t t = t0 + ROWOFF(wr, m);
#pragma unroll
            for (int bj = 0; bj < 2; ++bj) {
                const bf16_t* gp = gates + t * LDP + col0 + bj * 32 + mode * 2048;
                f32x4 g0, g1; load8bf(gp, g0, g1);
                if (mode != 2) {
                    f32x4 h0, h1; load8bf(gp + 2048, h0, h1);
#pragma unroll
                    for (int j = 0; j < 4; ++j) {
                        acc[m][2 * bj][j] *= g0[j] * __builtin_amdgcn_rcpf(fmaxf(h0[j], 1e-30f));
                        acc[m][2 * bj + 1][j] *= g1[j] * __builtin_amdgcn_rcpf(fmaxf(h1[j], 1e-30f));
                    }
                } else {
                    store8bf(merged + t * D + col0 + bj * 32, acc[m][2 * bj] * g0, acc[m][2 * bj + 1] * g1);
                }
            }
        }
    }
};

struct EpiOut {
    bf16_t* y; int brow, bcol;
    __device__ __forceinline__ void operator()(f32x4 (&acc)[8][4], int wr, int wc, int fr, int fq) const {
#pragma unroll
        for (int m = 0; m < 8; ++m) {
            const int t = brow + ROWOFF(wr, m) + fr;
            bf16_t* yp = y + (size_t)t * D + bcol + wc * 64 + 8 * fq;
            store8bf(yp, acc[m][0], acc[m][1]); store8bf(yp + 32, acc[m][2], acc[m][3]);
        }
    }
};

__device__ __forceinline__ int win_map(int np) {
    if (np < 2048) { const int base = np & ~127, p = np & 127, blk = p >> 6, half = (p >> 5) & 1, r = p & 31; return base + 32 * blk + 64 * half + r; }
    if (np < 7168) return np;
    if (np < 14336) return np + 64;
    if (np < 14400) return 7168 + (np - 14336);
    return -1;
}

struct ConvArgs { const float* src; const float* gain; bf16_t* dst; int ld, Kt, k0, np0, wmap; };
__device__ __forceinline__ ConvArgs conv_decode(KP p, int ci) {
    char* ws = p->ws;
    constexpr int NCONV_L = 1824 + 48 + 64 + 384 + 256 + 8 + 8;
    ConvArgs a; const int l = ci / NCONV_L; ci -= l * NCONV_L; a.gain = nullptr; a.wmap = 0;
    if (ci < 1824) { const int nt = ci % 114, kt = ci / 114; a.src = p->in[7] + (size_t)l * 2048 * NIN; a.ld = NIN; a.Kt = 2048; a.k0 = kt * 128; a.np0 = nt * 128; a.wmap = 1; a.dst = (bf16_t*)(ws + WS_WI) + (size_t)l * NP1 * 2048; }
    else if ((ci -= 1824) < 48) { const int nt = ci % 12, kt = ci / 12; a.src = p->in[17] + (size_t)l * 512 * 1536; a.ld = 1536; a.Kt = 512; a.k0 = kt * 128; a.np0 = nt * 128; a.gain = p->in[16] + l * 512; a.dst = (bf16_t*)(ws + WS_WUQ) + (size_t)l * 1536 * 512; }
    else if ((ci -= 48) < 64) { const int nt = ci % 16, kt = ci / 16; a.src = p->in[19] + (size_t)l * 512 * 2048; a.ld = 2048; a.Kt = 512; a.k0 = kt * 128; a.np0 = nt * 128; a.gain = p->in[18] + l * 512; a.dst = (bf16_t*)(ws + WS_WUKV) + (size_t)l * 2048 * 512; }
    else if ((ci -= 64) < 384) { const int nt = ci % 16, kt = ci / 16; a.src = p->in[20] + (size_t)l * 3072 * 2048; a.ld = 2048; a.Kt = 3072; a.k0 = kt * 128; a.np0 = nt * 128; a.dst = (bf16_t*)(ws + WS_WB) + (size_t)l * 2048 * 3072; }
    else if ((ci -= 384) < 256) { const int nt = ci % 16, kt = ci / 16; a.src = p->in[21] + (size_t)l * 2048 * 2048; a.ld = 2048; a.Kt = 2048; a.k0 = kt * 128; a.np0 = nt * 128; a.dst = (bf16_t*)(ws + WS_WO) + (size_t)l * 2048 * 2048; }
    else if ((ci -= 256) < 8) { a.src = p->in[11] + (size_t)(l * 8 + ci) * 16384; a.ld = 128; a.Kt = 128; a.k0 = 0; a.np0 = 0; a.dst = (bf16_t*)(ws + WS_WA) + (size_t)(l * 8 + ci) * 16384; }
    else { ci -= 8; a.src = p->in[13] + (size_t)(l * 8 + ci) * 16384; a.ld = 128; a.Kt = 128; a.k0 = 0; a.np0 = 0; a.dst = (bf16_t*)(ws + WS_WX) + (size_t)(l * 8 + ci) * 16384; }
    return a;
}
__device__ __forceinline__ void conv_load(const ConvArgs& c, int tid, f32x4 (&a)[4], f32x4 (&b)[4]) {
    const int c8 = (tid & 15) * 8, np = c.np0 + c8;
    const int n = c.wmap ? win_map(np) : np;
#pragma unroll
    for (int r = 0; r < 4; ++r) {
        const int kl = (tid >> 4) + 32 * r;
        a[r] = (f32x4){0.f, 0.f, 0.f, 0.f}; b[r] = a[r];
        if (n >= 0) { const float* sp = c.src + (size_t)(c.k0 + kl) * c.ld + n; a[r] = __builtin_nontemporal_load((const f32x4*)sp); b[r] = __builtin_nontemporal_load((const f32x4*)(sp + 4)); }
    }
}
__device__ __forceinline__ void conv_finish(LAS char* lds, const ConvArgs& c, int tid, const f32x4 (&a)[4], const f32x4 (&b)[4]) {
    LAS bf16_t* tl = (LAS bf16_t*)lds;
    const int c8 = (tid & 15) * 8;
    __syncthreads();
#pragma unroll
    for (int r = 0; r < 4; ++r) {
        const int kl = (tid >> 4) + 32 * r;
        const float g = c.gain ? c.gain[c.k0 + kl] : 1.0f;
#pragma unroll
        for (int e = 0; e < 4; e += 2) {
            const unsigned pa_ = pk2(a[r][e] * g, a[r][e + 1] * g), pb_ = pk2(b[r][e] * g, b[r][e + 1] * g);
            tl[(c8 + e) * 130 + kl] = (bf16_t)pa_; tl[(c8 + e + 1) * 130 + kl] = (bf16_t)(pa_ >> 16);
            tl[(c8 + 4 + e) * 130 + kl] = (bf16_t)pb_; tl[(c8 + 5 + e) * 130 + kl] = (bf16_t)(pb_ >> 16);
        }
    }
    __syncthreads();
#pragma unroll
    for (int r = 0; r < 4; ++r) {
        const int nl = (tid >> 4) + 32 * r, kc = (tid & 15) * 8;
        const LAS unsigned* rp = (const LAS unsigned*)(tl + nl * 130 + kc);
        u32x4 o; o.x = rp[0]; o.y = rp[1]; o.z = rp[2]; o.w = rp[3];
        *(u32x4*)(c.dst + (size_t)(c.np0 + nl) * c.Kt + c.k0 + kc) = o;
    }
}

__device__ __forceinline__ void conv4(LAS char* lds, KP p, int base) {
    int tid = threadIdx.x; asm volatile("" : "+v"(tid));
    f32x4 a0[4], b0[4], a1[4], b1[4];
    ConvArgs c0 = conv_decode(p, base), c1 = conv_decode(p, base + 1);
    conv_load(c0, tid, a0, b0); conv_load(c1, tid, a1, b1);
    conv_finish(lds, c0, tid, a0, b0);
    c0 = conv_decode(p, base + 2); conv_load(c0, tid, a0, b0);
    conv_finish(lds, c1, tid, a1, b1);
    c1 = conv_decode(p, base + 3); conv_load(c1, tid, a1, b1);
    conv_finish(lds, c0, tid, a0, b0);
    conv_finish(lds, c1, tid, a1, b1);
}

__device__ void phase0(LAS char* lds, KP p) {
    char* ws = p->ws;
    int tid = threadIdx.x; asm volatile("" : "+v"(tid)); const int wid = tid >> 6, lane = tid & 63;
    constexpr int NCONV_L = 1824 + 48 + 64 + 384 + 256 + 8 + 8;
    constexpr int N_ADA = 384, N_ROPE = 128, N_ITEMS = N_ADA + N_ROPE;
    for (int it = blockIdx.x; it < N_ITEMS; it += gridDim.x) {
        if (it < N_ADA) {
            const int l = it / 96, j0 = (it % 96) * 64;
            LAS float* cact = (LAS float*)lds;
            LAS float* red = (LAS float*)(lds + 32768);
            __syncthreads();
            for (int i = tid; i < 8192; i += 512) { const float v = p->in[1][i]; cact[i] = v * sigmoidf_(v); }
            __syncthreads();
            const int cg = lane & 15, kq = lane >> 4;
            const float* wp = p->in[3] + (size_t)l * 2048 * 6144 + j0 + 4 * cg;
            f32x4 a0 = (f32x4){0.f, 0.f, 0.f, 0.f}, a1 = a0, a2 = a0, a3 = a0;
#pragma unroll 16
            for (int j = 0; j < 64; ++j) {
                const int k = wid * 256 + 4 * j + kq;
                const f32x4 w = *(const f32x4*)(wp + (size_t)k * 6144);
                a0 += w * cact[k]; a1 += w * cact[2048 + k]; a2 += w * cact[4096 + k]; a3 += w * cact[6144 + k];
            }
#pragma unroll
            for (int e = 0; e < 4; ++e) {
                a0[e] += shx(a0[e], lane, 16); a0[e] += shx(a0[e], lane, 32); a1[e] += shx(a1[e], lane, 16); a1[e] += shx(a1[e], lane, 32);
                a2[e] += shx(a2[e], lane, 16); a2[e] += shx(a2[e], lane, 32); a3[e] += shx(a3[e], lane, 16); a3[e] += shx(a3[e], lane, 32);
            }
            if (kq == 0) {
                *(LAS f32x4*)(red + (wid * 4 + 0) * 64 + 4 * cg) = a0; *(LAS f32x4*)(red + (wid * 4 + 1) * 64 + 4 * cg) = a1;
                *(LAS f32x4*)(red + (wid * 4 + 2) * 64 + 4 * cg) = a2; *(LAS f32x4*)(red + (wid * 4 + 3) * 64 + 4 * cg) = a3;
            }
            __syncthreads();
            if (tid < 256) {
                const int b = tid >> 6, jl = tid & 63; float s = 0.f;
#pragma unroll
                for (int w = 0; w < 8; ++w) s += red[(w * 4 + b) * 64 + jl];
                ((float*)(ws + WS_MOD))[(size_t)(l * 4 + b) * 6144 + j0 + jl] = s + p->in[4][(size_t)l * 6144 + j0 + jl];
            }
        } else if (it < N_ADA + N_ROPE) {
            const int t0 = (it - N_ADA) * 64;
            for (int e = tid; e < 64 * 96; e += 512) {
                const int tl = e / 96, f = e % 96, t = t0 + tl;
                const float pos = (float)p->pos[t];
                float invf; if (f < 64) invf = exp2f(-(float)(2 * f) * (1.0f / 128.0f) * 13.287712379549449f); else invf = exp2f(-(float)(2 * (f - 64)) * (1.0f / 64.0f) * 13.287712379549449f);
                const float ang = pos * invf;
                double rev = (double)ang * 0.15915494309189535; rev -= rint(rev);
                const float rv = (float)rev;
                const float sn = __builtin_amdgcn_sinf(rv), cs = __builtin_amdgcn_cosf(rv);
                if (f < 64) { ((float*)(ws + WS_COSR))[(size_t)t * 64 + f] = cs; ((float*)(ws + WS_SINR))[(size_t)t * 64 + f] = sn; }
                else { ((float*)(ws + WS_COSM))[(size_t)t * 32 + f - 64] = cs; ((float*)(ws + WS_SINM))[(size_t)t * 32 + f - 64] = sn; }
            }
        }
    }
    {
        constexpr int NCONV = NCONV_L;
        int ci = blockIdx.x;
        f32x4 a0[4], b0[4], a1[4], b1[4];
        ConvArgs c0 = conv_decode(p, ci < NCONV ? ci : 0), c1 = c0;
        if (ci < NCONV) conv_load(c0, tid, a0, b0);
        while (ci < NCONV) {
            const int cn = ci + gridDim.x, cnn = cn + gridDim.x;
            if (cn < NCONV) { c1 = conv_decode(p, cn); conv_load(c1, tid, a1, b1); }
            conv_finish(lds, c0, tid, a0, b0);
            if (cn >= NCONV) break;
            if (cnn < NCONV) { c0 = conv_decode(p, cnn); conv_load(c0, tid, a0, b0); }
            conv_finish(lds, c1, tid, a1, b1);
            ci = cnn;
        }
    }
}

__device__ __forceinline__ float wave_sum(float v, int lane) {
    v = row16_sum(v); v += shx(v, lane, 16); v += shx(v, lane, 32); return v;
}
__device__ void rowpass(KP p, int l  ) {
    char* ws = p->ws;
    int tid = threadIdx.x; asm volatile("" : "+v"(tid));
    const int lane = tid & 63, gw = blockIdx.x * 8 + (tid >> 6), nw = gridDim.x * 8;
    const float* mod = (const float*)(ws + WS_MOD);
    float* xcur = (float*)(ws + WS_XCUR);
    const bf16_t* ybuf = (const bf16_t*)(ws + WS_YBUF);
    bf16_t* hbuf = (bf16_t*)(ws + WS_HBUF);
    for (int g4 = gw; g4 < T / 4; g4 += nw) {
        const int r0 = g4 * 4, b = r0 >> 11;
        f32x4 pa[8], pb[8], pc[8];
        if (l >= 0) {
#pragma unroll
            for (int i = 0; i < 8; ++i) {
                const int c = i * 256 + lane * 4;
                pa[i] = (*(const f32x4*)(mod + (size_t)(l * 4 + b) * 6144 + 4096 + c) + 1.0f) * *(const f32x4*)(p->in[6] + (size_t)l * D + c);
            }
        }
        if (l < DEPTH - 1) {
            const int ln = l + 1;
#pragma unroll
            for (int i = 0; i < 8; ++i) {
                const int c = i * 256 + lane * 4;
                pb[i] = (*(const f32x4*)(mod + (size_t)(ln * 4 + b) * 6144 + 2048 + c) + 1.0f) * *(const f32x4*)(p->in[5] + (size_t)ln * D + c);
                pc[i] = *(const f32x4*)(mod + (size_t)(ln * 4 + b) * 6144 + c);
            }
        }
        const float* xprev = (l <= 0) ? p->in[0] : xcur;
        float* dst = (l == DEPTH - 1) ? p->out : xcur;
#pragma unroll 1
        for (int rr = 0; rr < 4; ++rr) {
            const int row = r0 + rr;
            f32x4 xv[8], yv[8];
#pragma unroll
            for (int i = 0; i < 8; ++i) {
                xv[i] = *(const f32x4*)(xprev + (size_t)row * D + i * 256 + lane * 4);
                if (l >= 0) yv[i] = load4bf(ybuf + (size_t)row * D + i * 256 + lane * 4);
            }
            if (l >= 0) {
                float ss = 0.f;
#pragma unroll
                for (int i = 0; i < 8; ++i) ss += yv[i][0] * yv[i][0] + yv[i][1] * yv[i][1] + yv[i][2] * yv[i][2] + yv[i][3] * yv[i][3];
                ss = wave_sum(ss, lane);
                const float rs = rsqrtf(ss * (1.0f / D) + EPS);
#pragma unroll
                for (int i = 0; i < 8; ++i) {
                    xv[i] = xv[i] + pa[i] * (yv[i] * rs);
                    *(f32x4*)(dst + (size_t)row * D + i * 256 + lane * 4) = xv[i];
                }
            }
            if (l < DEPTH - 1) {
                float ss = 0.f;
#pragma unroll
                for (int i = 0; i < 8; ++i) ss += xv[i][0] * xv[i][0] + xv[i][1] * xv[i][1] + xv[i][2] * xv[i][2] + xv[i][3] * xv[i][3];
                ss = wave_sum(ss, lane);
                const float rs = rsqrtf(ss * (1.0f / D) + EPS);
#pragma unroll
                for (int i = 0; i < 8; ++i) store4bf(hbuf + (size_t)row * D + i * 256 + lane * 4, xv[i] * rs * pb[i] + pc[i]);
            }
        }
    }
}

__device__ __forceinline__ int tix(int row, int col) { return row * 72 + (col ^ (((row >> 3) & 3) << 4)); }
template <bool OUT>
__device__ void ret_item(LAS char* lds, KP p, int l, int item) {
    char* ws = p->ws;
    int tid = threadIdx.x; asm volatile("" : "+v"(tid)); const int wid = tid >> 6, lane = tid & 63, fr = lane & 15, fq = lane >> 4;
    const int g = item & 7, h = (item >> 3) & 7, b = item >> 6;
    LAS bf16_t* Qs = (LAS bf16_t*)(lds);
    LAS bf16_t* Ks = (LAS bf16_t*)(lds + 17408);
    LAS bf16_t* Kt = (LAS bf16_t*)(lds + 34816);
    LAS bf16_t* Vt = (LAS bf16_t*)(lds + 53248);
    LAS bf16_t* St = (LAS bf16_t*)(lds + 71680);
    LAS bf16_t* Ps = (LAS bf16_t*)(lds + 106496);
    LAS float* Os = (LAS float*)(lds);
    const bf16_t* proj = (const bf16_t*)(ws + WS_PROJ);
    float* tot = (float*)(ws + WS_TOT);
    const float gy = __builtin_amdgcn_exp2f(-5.0f - (float)h);
    const float lg2 = -gy * (1.0f + gy * (0.5f + gy * (0.33333334f + gy * (0.25f + gy * 0.2f)))) * 1.4426950408889634f;
    const float d64 = __builtin_amdgcn_exp2f(lg2 * 64.0f), d256 = __builtin_amdgcn_exp2f(lg2 * 256.0f);
    f32x4 sacc[8];
#pragma unroll
    for (int nf = 0; nf < 8; ++nf) sacc[nf] = (f32x4){0.f, 0.f, 0.f, 0.f};
    if (OUT) {
        float w = 1.0f;
        for (int gp = g - 1; gp >= 0; --gp) {
            const float* tp = tot + (size_t)((b * 8 + h) * 8 + gp) * 16384;
            float tv[8][4];
#pragma unroll
            for (int nf = 0; nf < 8; ++nf)
#pragma unroll
                for (int j = 0; j < 4; ++j) tv[nf][j] = tp[(16 * wid + 4 * fq + j) * 128 + 16 * nf + fr];
#pragma unroll
            for (int nf = 0; nf < 8; ++nf)
#pragma unroll
                for (int j = 0; j < 4; ++j) sacc[nf][j] += w * tv[nf][j];
            w *= d256;
        }
    }
    int li[2], lc[2];
#pragma unroll
    for (int r = 0; r < 2; ++r) { const int wt = wid + 8 * r; li[r] = 16 * (wt & 3) + (lane & 15); lc[r] = 8 * (4 * (wt >> 2) + (lane >> 4)); }
    u32x4 gq[2], gk[2], gv[2];
#define RET_LOAD(n_) do { const int t0_ = b * 2048 + (n_) * 64; _Pragma("unroll") for (int r = 0; r < 2; ++r) { \
        const bf16_t* rowp = proj + (size_t)(t0_ + li[r]) * LDP + h * 128 + lc[r]; \
        gk[r] = *(const u32x4*)(rowp + 1024); gv[r] = *(const u32x4*)(rowp + 2048); if (OUT) gq[r] = *(const u32x4*)(rowp); } } while (0)
    RET_LOAD(g * 4);
    const int ni = tid >> 3, npart = tid & 7, ncol = h * 128 + npart * 16;
    f32x4 gv4[4]; u32x4 sgp[2];
    if (OUT) {
#pragma unroll
        for (int e = 0; e < 4; ++e) gv4[e] = *(const f32x4*)(p->in[8] + (size_t)l * 1024 + ncol + e * 4);
    }
    for (int c = 0; c < 4; ++c) {
        const int n = g * 4 + c, t0 = b * 2048 + n * 64;
        if (OUT) { const bf16_t* gp_ = proj + (size_t)(t0 + ni) * LDP + 3072 + ncol; sgp[0] = *(const u32x4*)gp_; sgp[1] = *(const u32x4*)(gp_ + 8); }
        __syncthreads();
#pragma unroll
        for (int r = 0; r < 2; ++r) {
            const int i = li[r], c8 = lc[r];
            if (OUT) { *(LAS u32x4*)(Qs + i * 136 + c8) = gq[r]; *(LAS u32x4*)(Ks + i * 136 + c8) = gk[r]; }
            const float dec = __builtin_amdgcn_exp2f(lg2 * (float)(63 - i));
#pragma unroll
            for (int e = 0; e < 4; ++e) {
                Kt[tix(c8 + 2 * e, i)] = f2bf(blo(gk[r][e]) * dec); Kt[tix(c8 + 2 * e + 1, i)] = f2bf(bhi(gk[r][e]) * dec);
                Vt[tix(c8 + 2 * e, i)] = (bf16_t)(gv[r][e] & 0xffffu); Vt[tix(c8 + 2 * e + 1, i)] = (bf16_t)(gv[r][e] >> 16);
            }
        }
        if (OUT) {
#pragma unroll
            for (int nf = 0; nf < 8; ++nf)
#pragma unroll
                for (int j = 0; j < 4; ++j) St[(16 * wid + 4 * fq + j) * 136 + 16 * nf + fr] = f2bf(sacc[nf][j]);
        }
        if (c + 1 < 4) RET_LOAD(n + 1);
        __syncthreads();
        const int mf = wid & 3, nh = wid >> 2;
        f32x4 o1[4], o2[4];
#pragma unroll
        for (int nf = 0; nf < 4; ++nf) { o1[nf] = (f32x4){0.f, 0.f, 0.f, 0.f}; o2[nf] = (f32x4){0.f, 0.f, 0.f, 0.f}; }
        if (OUT) {
            f32x4 s2[2] = {(f32x4){0.f, 0.f, 0.f, 0.f}, (f32x4){0.f, 0.f, 0.f, 0.f}};
            {
                bf16x8 fa[4], fb0[4], fb1[4];
#pragma unroll
                for (int kk = 0; kk < 4; ++kk) {
                    fa[kk] = *(const LAS bf16x8*)(Qs + (16 * mf + fr) * 136 + kk * 32 + fq * 8);
                    fb0[kk] = *(const LAS bf16x8*)(Ks + (32 * nh + fr) * 136 + kk * 32 + fq * 8);
                    fb1[kk] = *(const LAS bf16x8*)(Ks + (32 * nh + 16 + fr) * 136 + kk * 32 + fq * 8);
                }
#pragma unroll
                for (int kk = 0; kk < 4; ++kk) { s2[0] = MFMA16(fa[kk], fb0[kk], s2[0]); s2[1] = MFMA16(fa[kk], fb1[kk], s2[1]); }
                __builtin_amdgcn_sched_group_barrier(0x100, 12, 0); __builtin_amdgcn_sched_group_barrier(0x008, 8, 0);
            }
            __builtin_amdgcn_sched_barrier(0);
#pragma unroll
            for (int nf = 0; nf < 2; ++nf)
#pragma unroll
                for (int j = 0; j < 4; ++j) {
                    const int i = 16 * mf + 4 * fq + j, jj = 32 * nh + 16 * nf + fr;
                    Ps[i * 72 + jj] = f2bf(s2[nf][j] * __builtin_amdgcn_exp2f(lg2 * fabsf((float)(i - jj))));
                }
            __builtin_amdgcn_sched_barrier(0);
            {
                bf16x8 qa[4], sb[4][4];
#pragma unroll
                for (int kk = 0; kk < 4; ++kk) {
                    qa[kk] = *(const LAS bf16x8*)(Qs + (16 * mf + fr) * 136 + kk * 32 + fq * 8);
#pragma unroll
                    for (int nf = 0; nf < 4; ++nf) sb[kk][nf] = *(const LAS bf16x8*)(St + (64 * nh + 16 * nf + fr) * 136 + kk * 32 + fq * 8);
                }
#pragma unroll
                for (int kk = 0; kk < 4; ++kk)
#pragma unroll
                    for (int nf = 0; nf < 4; ++nf) o2[nf] = MFMA16(qa[kk], sb[kk][nf], o2[nf]);
                __builtin_amdgcn_sched_group_barrier(0x100, 20, 0); __builtin_amdgcn_sched_group_barrier(0x008, 16, 0);
            }
            __builtin_amdgcn_sched_barrier(0);
        }
#pragma unroll
        for (int nf = 0; nf < 8; ++nf) sacc[nf] *= d64;
        __builtin_amdgcn_sched_barrier(0);
        {
            bf16x8 va[2], kb[2][8];
#pragma unroll
            for (int kk = 0; kk < 2; ++kk) {
                va[kk] = *(const LAS bf16x8*)(Vt + tix(16 * wid + fr, kk * 32 + fq * 8));
#pragma unroll
                for (int nf = 0; nf < 8; ++nf) kb[kk][nf] = *(const LAS bf16x8*)(Kt + tix(16 * nf + fr, kk * 32 + fq * 8));
            }
#pragma unroll
            for (int kk = 0; kk < 2; ++kk)
#pragma unroll
                for (int nf = 0; nf < 8; ++nf) sacc[nf] = MFMA16(va[kk], kb[kk][nf], sacc[nf]);
            __builtin_amdgcn_sched_group_barrier(0x100, 18, 0); __builtin_amdgcn_sched_group_barrier(0x008, 16, 0);
        }
        __builtin_amdgcn_sched_barrier(0);
        if (OUT) {
            __syncthreads();
            {
                bf16x8 pa[2], vb[2][4];
#pragma unroll
                for (int kk = 0; kk < 2; ++kk) {
                    pa[kk] = *(const LAS bf16x8*)(Ps + (16 * mf + fr) * 72 + kk * 32 + fq * 8);
#pragma unroll
                    for (int nf = 0; nf < 4; ++nf) vb[kk][nf] = *(const LAS bf16x8*)(Vt + tix(64 * nh + 16 * nf + fr, kk * 32 + fq * 8));
                }
#pragma unroll
                for (int kk = 0; kk < 2; ++kk)
#pragma unroll
                    for (int nf = 0; nf < 4; ++nf) o1[nf] = MFMA16(pa[kk], vb[kk][nf], o1[nf]);
                __builtin_amdgcn_sched_group_barrier(0x100, 10, 0); __builtin_amdgcn_sched_group_barrier(0x008, 8, 0);
            }
            __builtin_amdgcn_sched_barrier(0);
            __builtin_amdgcn_sched_barrier(0);
#pragma unroll
            for (int j = 0; j < 4; ++j) {
                const int i = 16 * mf + 4 * fq + j; const float dq = __builtin_amdgcn_exp2f(lg2 * (float)(i + 1));
#pragma unroll
                for (int nf = 0; nf < 4; ++nf) Os[i * 132 + 64 * nh + 16 * nf + fr] = o1[nf][j] + dq * o2[nf][j];
            }
        }
        if (OUT) {
            __syncthreads();
            const int i = tid >> 3, part = tid & 7, t = t0 + i;
            f32x4 v[4]; float sum = 0.f;
#pragma unroll
            for (int e = 0; e < 4; ++e) { v[e] = *(const LAS f32x4*)(Os + i * 132 + part * 16 + e * 4); sum += v[e][0] + v[e][1] + v[e][2] + v[e][3]; }
            sum += dppf(sum, 0); sum += dppf(sum, 1); sum += shx(sum, lane, 4);
            const float mean = sum * (1.0f / 128.0f);
            float sq = 0.f;
#pragma unroll
            for (int e = 0; e < 4; ++e) { v[e] = v[e] - mean; sq += v[e][0] * v[e][0] + v[e][1] * v[e][1] + v[e][2] * v[e][2] + v[e][3] * v[e][3]; }
            sq += dppf(sq, 0); sq += dppf(sq, 1); sq += shx(sq, lane, 4);
            const float rs = rsqrtf(sq * (1.0f / 128.0f) + EPS);
            bf16_t* yp = (bf16_t*)(ws + WS_YCAT) + (size_t)t * 3072 + ncol;
            f32x4 sg4[4];
            sg4[0][0] = blo(sgp[0].x); sg4[0][1] = bhi(sgp[0].x); sg4[0][2] = blo(sgp[0].y); sg4[0][3] = bhi(sgp[0].y);
            sg4[1][0] = blo(sgp[0].z); sg4[1][1] = bhi(sgp[0].z); sg4[1][2] = blo(sgp[0].w); sg4[1][3] = bhi(sgp[0].w);
            sg4[2][0] = blo(sgp[1].x); sg4[2][1] = bhi(sgp[1].x); sg4[2][2] = blo(sgp[1].y); sg4[2][3] = bhi(sgp[1].y);
            sg4[3][0] = blo(sgp[1].z); sg4[3][1] = bhi(sgp[1].z); sg4[3][2] = blo(sgp[1].w); sg4[3][3] = bhi(sgp[1].w);
            store8bf(yp, v[0] * rs * gv4[0] * sg4[0], v[1] * rs * gv4[1] * sg4[1]);
            store8bf(yp + 8, v[2] * rs * gv4[2] * sg4[2], v[3] * rs * gv4[3] * sg4[3]);
        }
    }
#undef RET_LOAD
    if (!OUT) {
        float* tp = tot + (size_t)item * 16384;
#pragma unroll
        for (int nf = 0; nf < 8; ++nf)
#pragma unroll
            for (int j = 0; j < 4; ++j) tp[(16 * wid + 4 * fq + j) * 128 + 16 * nf + fr] = sacc[nf][j];
    }
}

__device__ void lru_item(LAS char* lds, KP p, int l, int item) {
    char* ws = p->ws;
    int tid = threadIdx.x; asm volatile("" : "+v"(tid)); const int wid = tid >> 6, lane = tid & 63, fr = lane & 15, fq = lane >> 4;
    const int nb = item & 7, n = (item >> 3) & 31, b = item >> 8, t0 = b * 2048 + n * 64, s0 = n * 64;
    LAS bf16_t* Xs = (LAS bf16_t*)(lds);
    LAS float* Xf = (LAS float*)(lds + 17408);
    LAS bf16_t* Wa = (LAS bf16_t*)(lds + 50176);
    LAS bf16_t* Wx = (LAS bf16_t*)(lds + 84992);
    LAS float* As_ = (LAS float*)(lds + 50176);
    LAS float* Bs_ = (LAS float*)(lds + 82944);
    LAS float* Cq = (LAS float*)(lds + 119808);
    const bf16_t* proj = (const bf16_t*)(ws + WS_PROJ);
    const bf16_t* wat = (const bf16_t*)(ws + WS_WA) + (size_t)(l * 8 + nb) * 16384;
    const bf16_t* wxt = (const bf16_t*)(ws + WS_WX) + (size_t)(l * 8 + nb) * 16384;
    float pba[4], pbx[4], plam[4];
#pragma unroll
    for (int nf = 0; nf < 4; ++nf) { const int ch_ = l * 1024 + nb * 128 + 64 * (wid >> 2) + 16 * nf + fr; pba[nf] = p->in[12][ch_]; pbx[nf] = p->in[14][ch_]; plam[nf] = p->in[15][ch_]; }
    __syncthreads();
    {
        u32x4 wa4[4], wx4[4];
#pragma unroll
        for (int r = 0; r < 4; ++r) { const int q = tid + 512 * r, d = q >> 4, c8 = (q & 15) * 8; wa4[r] = *(const u32x4*)(wat + d * 128 + c8); wx4[r] = *(const u32x4*)(wxt + d * 128 + c8); }
#pragma unroll
        for (int r = 0; r < 4; ++r) { const int q = tid + 512 * r, d = q >> 4, c8 = (q & 15) * 8; *(LAS u32x4*)(Wa + d * 136 + c8) = wa4[r]; *(LAS u32x4*)(Wx + d * 136 + c8) = wx4[r]; }
    }
#pragma unroll
    for (int r = 0; r < 2; ++r) {
        const int q = tid + 512 * r, i = q >> 4, c8 = (q & 15) * 8, ch = nb * 128 + c8;
        f32x4 x0 = *(const f32x4*)(p->in[10] + (size_t)l * 1024 + ch), x1 = *(const f32x4*)(p->in[10] + (size_t)l * 1024 + ch + 4);
        u32x4 xv4[4]; f32x4 w04[4], w14[4];
#pragma unroll
        for (int k = 0; k < 4; ++k) {
            const int sk = s0 + i - 3 + k, tk = sk >= 0 ? (t0 + i - 3 + k) : t0;
            xv4[k] = *(const u32x4*)(proj + (size_t)tk * LDP + 4096 + ch);
            w04[k] = *(const f32x4*)(p->in[9] + (size_t)(l * 4 + k) * 1024 + ch); w14[k] = *(const f32x4*)(p->in[9] + (size_t)(l * 4 + k) * 1024 + ch + 4);
        }
#pragma unroll
        for (int k = 0; k < 4; ++k) {
            const float mk = (s0 + i - 3 + k >= 0) ? 1.0f : 0.0f;
            const f32x4 w0 = w04[k] * mk, w1 = w14[k] * mk; const u32x4 xv = xv4[k];
            x0[0] += w0[0] * blo(xv[0]); x0[1] += w0[1] * bhi(xv[0]); x0[2] += w0[2] * blo(xv[1]); x0[3] += w0[3] * bhi(xv[1]);
            x1[0] += w1[0] * blo(xv[2]); x1[1] += w1[1] * bhi(xv[2]); x1[2] += w1[2] * blo(xv[3]); x1[3] += w1[3] * bhi(xv[3]);
        }
        u32x4 o; o.x = pk2(x0[0], x0[1]); o.y = pk2(x0[2], x0[3]); o.z = pk2(x1[0], x1[1]); o.w = pk2(x1[2], x1[3]);
        *(LAS u32x4*)(Xs + i * 136 + c8) = o;
        *(LAS f32x4*)(Xf + i * 128 + c8) = x0; *(LAS f32x4*)(Xf + i * 128 + c8 + 4) = x1;
    }
    __syncthreads();
    const int mf = wid & 3, nh = wid >> 2;
    f32x4 accA[4], accX[4];
#pragma unroll
    for (int nf = 0; nf < 4; ++nf) { accA[nf] = (f32x4){0.f, 0.f, 0.f, 0.f}; accX[nf] = (f32x4){0.f, 0.f, 0.f, 0.f}; }
    __builtin_amdgcn_sched_barrier(0);
#pragma unroll
    for (int half = 0; half < 2; ++half) {
        bf16x8 xa[2], wa_[2][4], wx_[2][4];
#pragma unroll
        for (int kk = 0; kk < 2; ++kk) {
            const int k0 = (half * 2 + kk) * 32;
            xa[kk] = *(const LAS bf16x8*)(Xs + (16 * mf + fr) * 136 + k0 + fq * 8);
#pragma unroll
            for (int nf = 0; nf < 4; ++nf) {
                wa_[kk][nf] = *(const LAS bf16x8*)(Wa + (64 * nh + 16 * nf + fr) * 136 + k0 + fq * 8);
                wx_[kk][nf] = *(const LAS bf16x8*)(Wx + (64 * nh + 16 * nf + fr) * 136 + k0 + fq * 8);
            }
        }
#pragma unroll
        for (int kk = 0; kk < 2; ++kk)
#pragma unroll
            for (int nf = 0; nf < 4; ++nf) { accA[nf] = MFMA16(xa[kk], wa_[kk][nf], accA[nf]); accX[nf] = MFMA16(xa[kk], wx_[kk][nf], accX[nf]); }
        __builtin_amdgcn_sched_group_barrier(0x100, 18, 0); __builtin_amdgcn_sched_group_barrier(0x008, 16, 0);
        __builtin_amdgcn_sched_barrier(0);
    }
    __syncthreads();
#pragma unroll
    for (int nf = 0; nf < 4; ++nf) {
        const int d = 64 * nh + 16 * nf + fr;
        const float ba = pba[nf], bx = pbx[nf], lam = plam[nf];
        const float em = __expf(-fabsf(lam));
        const float l1p = em < 0.01f ? em * (1.0f - em * (0.5f - em * 0.33333334f)) : __logf(1.0f + em);
        const float sp = fmaxf(-lam, 0.0f) + l1p;
#pragma unroll
        for (int j = 0; j < 4; ++j) {
            const int i = 16 * mf + 4 * fq + j;
            const float r = sigmoidf_(accA[nf][j] + ba), ig = sigmoidf_(accX[nf][j] + bx);
            const float la = -8.0f * r * sp;
            As_[i * 128 + d] = __expf(la);
            const float x2 = 2.0f * la;
            const float om = x2 > -0.1f ? -x2 * (1.0f + x2 * (0.5f + x2 * (0.16666667f + x2 * 0.041666668f))) : 1.0f - __expf(x2);
            Bs_[i * 128 + d] = sqrtf(om) * (ig * Xf[i * 128 + d]);
        }
    }
    __syncthreads();
    {
        const int d = tid & 127, q = tid >> 7;
        float h = 0.f, A = 1.f;
#pragma unroll 4
        for (int ii = 0; ii < 16; ++ii) { const int i = 16 * q + ii; const float a = As_[i * 128 + d]; h = a * h + Bs_[i * 128 + d]; A *= a; }
        Cq[(q * 128 + d) * 2] = A; Cq[(q * 128 + d) * 2 + 1] = h;
        __syncthreads();
        float hin = 0.f, Ain = 1.f;
        for (int qq = 0; qq < q; ++qq) { const float Aq = Cq[(qq * 128 + d) * 2], hq = Cq[(qq * 128 + d) * 2 + 1]; hin = Aq * hin + hq; Ain *= Aq; }
        h = hin; A = Ain;
        bf16_t* hl = (bf16_t*)(ws + WS_HLOC) + (size_t)t0 * 1024 + nb * 128 + d;
        bf16_t* ac = (bf16_t*)(ws + WS_ACUM) + (size_t)t0 * 1024 + nb * 128 + d;
#pragma unroll 4
        for (int ii = 0; ii < 16; ++ii) {
            const int i = 16 * q + ii; const float a = As_[i * 128 + d]; h = a * h + Bs_[i * 128 + d]; A *= a;
            hl[(size_t)i * 1024] = f2bf(h); ac[(size_t)i * 1024] = f2bf(A);
        }
        if (q == 3) {
            float* lt = (float*)(ws + WS_LTOT) + (size_t)(b * 32 + n) * 1024 + nb * 128 + d;
            lt[0] = A; lt[(size_t)128 * 1024] = h;
        }
    }
}

__device__ void lru_out_item(KP p, int item) {
    char* ws = p->ws;
    int tid = threadIdx.x; asm volatile("" : "+v"(tid));
    const int n = item & 31, b = item >> 5, t0 = b * 2048 + n * 64, ch = tid * 2;
    const bf16_t* hl = (const bf16_t*)(ws + WS_HLOC); const bf16_t* ac = (const bf16_t*)(ws + WS_ACUM);
    const float* lt = (const float*)(ws + WS_LTOT);
    const bf16_t* proj = (const bf16_t*)(ws + WS_PROJ);
    bf16_t* ycat = (bf16_t*)(ws + WS_YCAT);
    f32x2 carry = (f32x2){0.f, 0.f};
    for (int m0 = 0; m0 < n; m0 += 8) {
        f32x2 A2[8], H2[8];
#pragma unroll
        for (int u = 0; u < 8; ++u) {
            const int m = (m0 + u < n) ? (m0 + u) : (n - 1);
            const size_t tl = (size_t)(b * 32 + m) * 1024 + ch;
            A2[u] = *(const f32x2*)(lt + tl); H2[u] = *(const f32x2*)(lt + (size_t)128 * 1024 + tl);
        }
#pragma unroll
        for (int u = 0; u < 8; ++u) if (m0 + u < n) carry = A2[u] * carry + H2[u];
    }
    for (int i0 = 0; i0 < 64; i0 += 8) {
        unsigned h2[8], a2[8], gw[8];
#pragma unroll
        for (int u = 0; u < 8; ++u) {
            const size_t t = t0 + i0 + u;
            h2[u] = *(const unsigned*)(hl + t * 1024 + ch); a2[u] = *(const unsigned*)(ac + t * 1024 + ch);
            gw[u] = *(const unsigned*)(proj + t * LDP + 5120 + ch);
        }
#pragma unroll
        for (int u = 0; u < 8; ++u) {
            const size_t t = t0 + i0 + u;
            const float y0 = blo(h2[u]) + blo(a2[u]) * carry.x, y1 = bhi(h2[u]) + bhi(a2[u]) * carry.y;
            *(unsigned*)(ycat + t * 3072 + 1024 + ch) = pk2(y0 * blo(gw[u]), y1 * bhi(gw[u]));
        }
    }
}

__device__ void attn_item(LAS char* lds, KP p, int b, int h, int Pp) {
    char* ws = p->ws;
    int tid = threadIdx.x; asm volatile("" : "+v"(tid)); const int wid = tid >> 6, lane = tid & 63, fr = lane & 15, fq = lane >> 4;
    LAS bf16_t* Pw = (LAS bf16_t*)(lds + 81920 + wid * 4608);
    const bf16_t* qm = (const bf16_t*)(ws + WS_QM);
    const bf16_t* kn = (const bf16_t*)(ws + WS_KN) + (size_t)(b * 8 + h) * 2048 * 128;
    const bf16_t* kr = (const bf16_t*)(ws + WS_KROPE) + (size_t)b * 2048 * 64;
    const bf16_t* vt = (const bf16_t*)(ws + WS_VT) + (size_t)(b * 8 + h) * 128 * 2048;
    const int s0 = Pp * 256 + wid * 32, nkt = 4 * Pp + 4, qc = 4 * Pp + (wid >> 1);
    bf16x8 qf[2][6];
#pragma unroll
    for (int mi = 0; mi < 2; ++mi)
#pragma unroll
        for (int ks = 0; ks < 6; ++ks) qf[mi][ks] = *(const bf16x8*)(qm + ((size_t)((b * 8 + h) * 2048 + s0 + 16 * mi + fr)) * 192 + ks * 32 + fq * 8);
    f32x4 o[2][8];
#pragma unroll
    for (int mi = 0; mi < 2; ++mi)
#pragma unroll
        for (int nd = 0; nd < 8; ++nd) o[mi][nd] = (f32x4){0.f, 0.f, 0.f, 0.f};
    float mrow[2][4], lsum[2][4];
#pragma unroll
    for (int mi = 0; mi < 2; ++mi)
#pragma unroll
        for (int j = 0; j < 4; ++j) { mrow[mi][j] = -1e30f; lsum[mi][j] = 0.f; }
    const bf16_t* ksrc[3]; int kstep[3];
#pragma unroll
    for (int r = 0; r < 3; ++r) {
        const int q = tid + 512 * r, row = q / 24, pc = q - row * 24, lc = pc ^ ((row >> 1) & 7);
        if (lc < 16) { ksrc[r] = kn + (size_t)row * 128 + lc * 8; kstep[r] = 64 * 128; } else { ksrc[r] = kr + (size_t)row * 64 + (lc - 16) * 8; kstep[r] = 64 * 64; }
    }
    const bf16_t* vsrc[2];
#pragma unroll
    for (int r = 0; r < 2; ++r) { const int q = tid + 512 * r, d = q >> 3, pc = q & 7; vsrc[r] = vt + (size_t)d * 2048 + ((pc ^ ((d >> 1) & 7)) * 8); }
    const int ldsw = wid * 1024;
#define ATT_STAGE(kt, buf) do { _Pragma("unroll") for (int r_ = 0; r_ < 3; ++r_) \
        __builtin_amdgcn_global_load_lds((const unsigned*)(ksrc[r_] + (size_t)(kt) * kstep[r_]), (LAS unsigned*)(lds + (buf) * 24576 + ldsw + r_ * 8192), 16, 0, 0); \
      _Pragma("unroll") for (int r_ = 0; r_ < 2; ++r_) \
        __builtin_amdgcn_global_load_lds((const unsigned*)(vsrc[r_] + (kt) * 64), (LAS unsigned*)(lds + 49152 + (buf) * 16384 + ldsw + r_ * 8192), 16, 0, 0); } while (0)
    const int f7 = (fr >> 1) & 7, xq = fq ^ (f7 & 3), yq = f7 >> 2;
    const int ka0 = fr * 384 + xq * 16 + yq * 64, ka1 = fr * 384 + xq * 16 + (1 - yq) * 64;
    const int va0 = fr * 128 + xq * 16 + yq * 64, va1 = fr * 128 + xq * 16 + (1 - yq) * 64;
    __syncthreads();
    ATT_STAGE(0, 0); WAIT_V0(); __syncthreads();
    for (int kt = 0; kt < nkt; ++kt) {
        const int cur = kt & 1;
        if (kt + 1 < nkt) ATT_STAGE(kt + 1, cur ^ 1);
        if (kt <= qc) {
            const LAS char* Kb = (const LAS char*)(lds + cur * 24576);
            const LAS char* Vb = (const LAS char*)(lds + 49152 + cur * 16384);
            f32x4 s[2][4];
#pragma unroll
            for (int mi = 0; mi < 2; ++mi)
#pragma unroll
                for (int n = 0; n < 4; ++n) s[mi][n] = (f32x4){0.f, 0.f, 0.f, 0.f};
            __builtin_amdgcn_sched_barrier(0);
            __builtin_amdgcn_s_setprio(1);
            {
                bf16x8 kf[6][4];
#pragma unroll
                for (int ks = 0; ks < 6; ++ks)
#pragma unroll
                    for (int n = 0; n < 4; ++n) kf[ks][n] = *(const LAS bf16x8*)(Kb + ((ks & 1) ? ka1 : ka0) + n * 6144 + (ks >> 1) * 128);
#pragma unroll
                for (int ks = 0; ks < 6; ++ks)
#pragma unroll
                    for (int n = 0; n < 4; ++n) { s[0][n] = MFMA16(qf[0][ks], kf[ks][n], s[0][n]); s[1][n] = MFMA16(qf[1][ks], kf[ks][n], s[1][n]); }
                __builtin_amdgcn_sched_group_barrier(0x100, 8, 0);
                __builtin_amdgcn_sched_group_barrier(0x008, 8, 0); __builtin_amdgcn_sched_group_barrier(0x100, 4, 0);
                __builtin_amdgcn_sched_group_barrier(0x008, 8, 0); __builtin_amdgcn_sched_group_barrier(0x100, 4, 0);
                __builtin_amdgcn_sched_group_barrier(0x008, 8, 0); __builtin_amdgcn_sched_group_barrier(0x100, 4, 0);
                __builtin_amdgcn_sched_group_barrier(0x008, 8, 0); __builtin_amdgcn_sched_group_barrier(0x100, 4, 0);
                __builtin_amdgcn_sched_group_barrier(0x008, 16, 0);
            }
            __builtin_amdgcn_s_setprio(0);
            __builtin_amdgcn_sched_barrier(0);
#pragma unroll
            for (int mi = 0; mi < 2; ++mi)
#pragma unroll
                for (int j = 0; j < 4; ++j) {
                    float mx = fmaxf(fmaxf(s[mi][0][j], s[mi][1][j]), fmaxf(s[mi][2][j], s[mi][3][j]));
                    mx = row16_max(mx);
                    const float mnew = fmaxf(mrow[mi][j], mx);
                    if (__builtin_amdgcn_ballot_w64(mnew != mrow[mi][j]) != 0ull) {
                        const float alpha = __builtin_amdgcn_exp2f(mrow[mi][j] - mnew);
                        mrow[mi][j] = mnew; lsum[mi][j] *= alpha;
#pragma unroll
                        for (int nd = 0; nd < 8; ++nd) o[mi][nd][j] *= alpha;
                    }
#pragma unroll
                    for (int n = 0; n < 4; ++n) { const float pe = __builtin_amdgcn_exp2f(s[mi][n][j] - mnew); lsum[mi][j] += pe; Pw[(16 * mi + 4 * fq + j) * 72 + n * 16 + fr] = (bf16_t)pk2(pe, 0.f); }
                }
            WAIT_L0(); __builtin_amdgcn_wave_barrier();
            __builtin_amdgcn_sched_barrier(0);
            __builtin_amdgcn_s_setprio(1);
            {
                bf16x8 pa[2][2], vb[2][8];
#pragma unroll
                for (int ks2 = 0; ks2 < 2; ++ks2)
#pragma unroll
                    for (int mi = 0; mi < 2; ++mi) pa[mi][ks2] = *(const LAS bf16x8*)(Pw + (16 * mi + fr) * 72 + ks2 * 32 + fq * 8);
#pragma unroll
                for (int ks2 = 0; ks2 < 2; ++ks2)
#pragma unroll
                    for (int nd = 0; nd < 8; ++nd) vb[ks2][nd] = *(const LAS bf16x8*)(Vb + (ks2 ? va1 : va0) + nd * 2048);
#pragma unroll
                for (int ks2 = 0; ks2 < 2; ++ks2)
#pragma unroll
                    for (int nd = 0; nd < 8; ++nd) { o[0][nd] = MFMA16(pa[0][ks2], vb[ks2][nd], o[0][nd]); o[1][nd] = MFMA16(pa[1][ks2], vb[ks2][nd], o[1][nd]); }
                __builtin_amdgcn_sched_group_barrier(0x100, 12, 0);
                __builtin_amdgcn_sched_group_barrier(0x008, 4, 0); __builtin_amdgcn_sched_group_barrier(0x100, 2, 0);
                __builtin_amdgcn_sched_group_barrier(0x008, 4, 0); __builtin_amdgcn_sched_group_barrier(0x100, 2, 0);
                __builtin_amdgcn_sched_group_barrier(0x008, 4, 0); __builtin_amdgcn_sched_group_barrier(0x100, 2, 0);
                __builtin_amdgcn_sched_group_barrier(0x008, 4, 0); __builtin_amdgcn_sched_group_barrier(0x100, 2, 0);
                __builtin_amdgcn_sched_group_barrier(0x008, 16, 0);
            }
            __builtin_amdgcn_s_setprio(0);
            __builtin_amdgcn_sched_barrier(0);
        }
        WAIT_V0(); __syncthreads();
    }
#undef ATT_STAGE
    const bf16_t* proj = (const bf16_t*)(ws + WS_PROJ);
    bf16_t* ycat = (bf16_t*)(ws + WS_YCAT);
    LAS bf16_t* Ow = (LAS bf16_t*)(lds + wid * 8704);
#pragma unroll
    for (int mi = 0; mi < 2; ++mi)
#pragma unroll
        for (int j = 0; j < 4; ++j) {
            const float ls = row16_sum(lsum[mi][j]);
            const float inv = 1.0f / ls;
#pragma unroll
            for (int nd = 0; nd < 8; ++nd) Ow[(16 * mi + 4 * fq + j) * 136 + nd * 16 + fr] = f2bf(o[mi][nd][j] * inv);
        }
    WAIT_L0(); __builtin_amdgcn_wave_barrier();
#pragma unroll
    for (int r = 0; r < 8; ++r) {
        const int q = lane + 64 * r, row = q >> 4, c8 = (q & 15) * 8;
        const size_t t = (size_t)b * 2048 + s0 + row;
        const u32x4 ov = *(const LAS u32x4*)(Ow + row * 136 + c8);
        const u32x4 gv = *(const u32x4*)(proj + t * LDP + 7168 + h * 128 + c8);
        u32x4 y;
#pragma unroll
        for (int e = 0; e < 4; ++e) y[e] = pk2(blo(ov[e]) * blo(gv[e]), bhi(ov[e]) * bhi(gv[e]));
        *(u32x4*)(ycat + t * 3072 + 2048 + h * 128 + c8) = y;
    }
}

#define XB_TMO      128
#define XB_XCNT(j)  (256  + 64 * (j))
#define XB_XSUB(j)  (1280 + 64 * (j))
#define XB_XGEN(j)  (2304 + 64 * (j))
#define XB_TOP      3328
#define XB_TOPGEN   3392
#define XCD_BAR_WORDS 3456
#define XB_SPIN_CAP (1u << 18)
__device__ __forceinline__ unsigned xb_ld(unsigned* p)              { return __hip_atomic_load(p, __ATOMIC_RELAXED, __HIP_MEMORY_SCOPE_AGENT); }
__device__ __forceinline__ unsigned xb_add(unsigned* p, unsigned v) { return __hip_atomic_fetch_add(p, v, __ATOMIC_RELAXED, __HIP_MEMORY_SCOPE_AGENT); }
__device__ __forceinline__ unsigned xb_xcc_id() { return (unsigned)__builtin_amdgcn_s_getreg((3 << 11) | 20) & 0xFu; }
#define XB_SPIN(cond, bar) do { unsigned _sp = 0; while (cond) { __builtin_amdgcn_s_sleep(1); \
    if ((++_sp & 255u) == 0u) { if (xb_ld(&(bar)[XB_TMO])) break; if (_sp > XB_SPIN_CAP) { atomicAdd(&(bar)[XB_TMO], 1u); break; } } } } while (0)
struct XcdBarrier { unsigned* bar; unsigned x; volatile LAS unsigned* st; };
__device__ __forceinline__ XcdBarrier xcd_barrier_post(unsigned* bar, volatile LAS unsigned* st) {
    XcdBarrier b; b.bar = bar; b.x = xb_xcc_id(); b.st = st;
    if (threadIdx.x == 0) (void)xb_add(&bar[XB_XCNT(b.x)], 1u);
    return b;
}
__device__ __forceinline__ void xcd_barrier_complete(unsigned* bar, unsigned x, unsigned& nloc, unsigned& nx) {
    const unsigned G = gridDim.x * gridDim.y * gridDim.z;
    unsigned sum, cnt, mine, sp = 0u;
    for (;;) {
        sum = 0u; cnt = 0u; mine = 0u;
#pragma unroll
        for (unsigned j = 0; j < 16; ++j) { const unsigned c = xb_ld(&bar[XB_XCNT(j)]); sum += c; cnt += (c > 0u) ? 1u : 0u; mine = (j == x) ? c : mine; }
        if (sum == G) break;
        __builtin_amdgcn_s_sleep(1);
        if ((++sp & 255u) == 0u) { if (xb_ld(&bar[XB_TMO])) break; if (sp > XB_SPIN_CAP) { atomicAdd(&bar[XB_TMO], 1u); break; } }
    }
    nloc = mine > 0u ? mine : 1u; nx = cnt > 0u ? cnt : 1u;
}
__device__ __forceinline__ void xcd_barrier(const XcdBarrier& b) {
    asm volatile("s_waitcnt vmcnt(0)" ::: "memory");
    __syncthreads();
    if (threadIdx.x == 0) {
        unsigned* bar = b.bar; asm volatile("" : "+s"(bar));
        __builtin_amdgcn_s_waitcnt(0);
        unsigned nloc = b.st[0], nx = b.st[1];
        if (nloc == 0u) { xcd_barrier_complete(bar, b.x, nloc, nx); b.st[0] = nloc; b.st[1] = nx; }
        const unsigned old = xb_add(&bar[XB_XSUB(b.x)], 1u);
        const unsigned gen = old / nloc;
        if (old + 1u == (gen + 1u) * nloc) {
            __builtin_amdgcn_fence(__ATOMIC_RELEASE, "agent");
            asm volatile("s_waitcnt vmcnt(0)" ::: "memory");
            const unsigned og = xb_add(&bar[XB_TOP], 1u);
            const unsigned tg = og / nx;
            if (og + 1u == (tg + 1u) * nx) xb_add(&bar[XB_TOPGEN], 1u);
            else XB_SPIN(xb_ld(&bar[XB_TOPGEN]) == tg, bar);
            __builtin_amdgcn_fence(__ATOMIC_ACQUIRE, "agent");
            xb_add(&bar[XB_XGEN(b.x)], 1u);
            asm volatile("s_waitcnt vmcnt(0)" ::: "memory");
        } else {
            XB_SPIN(xb_ld(&bar[XB_XGEN(b.x)]) == gen, bar);
            __builtin_amdgcn_fence(__ATOMIC_ACQUIRE, "agent");
            asm volatile("s_waitcnt vmcnt(0)" ::: "memory");
        }
    }
    __syncthreads();
}

#define Q_BEGIN(ctrp) unsigned* qctr_ = (ctrp); volatile LAS int* qslot_ = (volatile LAS int*)(lds + 131072 + 8); int qnxt_ = 0
#define Q_ISSUE() do { int r_ = 0; if (threadIdx.x == 0) r_ = (int)__hip_atomic_fetch_add(qctr_, 1u, __ATOMIC_RELAXED, __HIP_MEMORY_SCOPE_AGENT); qnxt_ = r_; } while (0)
#define Q_TAKE(it) do { __syncthreads(); if (threadIdx.x == 0) *qslot_ = G + qnxt_; __syncthreads(); (it) = *qslot_; } while (0)

__global__ void __launch_bounds__(512) fwd_megakernel(Params parg) {
    __shared__ __attribute__((aligned(1024))) char shm[131072 + 16];
    LAS char* lds = (LAS char*)shm;
    const int G = gridDim.x, c = blockIdx.x;
    volatile LAS unsigned* xst = (volatile LAS unsigned*)(lds + 131072);
    unsigned* xbar = (unsigned*)(parg.ws + WS_BAR);
    if (threadIdx.x == 0) { xst[0] = 0u; xst[1] = 0u; }
    __syncthreads();
    XcdBarrier xb = xcd_barrier_post(xbar, xst);
    if (parg.ph_lo > 1000) cg::this_grid().sync();
#define GRID_SYNC() xcd_barrier(xb)
    for (int ph = parg.ph_lo; ph < parg.ph_hi; ++ph) {
      const int ptype = ph < 2 ? ph : 2 + (ph - 2) % 6;
      const int nrep = 1 + ((REPMASK >> ptype) & 1);
      for (int rep = 0; rep < nrep; ++rep) {
        if (rep) GRID_SYNC();
        const bool skip_epi = VAR_NOEPI && (rep + 1 < nrep);
        KP p = get_kp();
        char* ws = p->ws;
        if (ph == 0) {
            if (PMASK & 1) phase0(lds, p);
        } else if (ph == 1) {
            if (PMASK & 2) rowpass(p, -1);
        } else {
            const int l = (ph - 2) / 6, sub = (ph - 2) % 6;
            if (sub == 0 && (PMASK & 4)) {
                const bf16_t* A = (const bf16_t*)(ws + WS_HBUF);
                const bf16_t* Bt = (const bf16_t*)(ws + WS_WI) + (size_t)l * NP1 * 2048;
                for (int L = c; L < 32 * 56; L += G) {
                    int pm, pn; tile_map(L, 32, 56, pm, pn);
                    f32x4 acc[8][4];
                    gemm256(lds, A + (size_t)pm * 256 * 2048, 2048, Bt + (size_t)pn * 256 * 2048, 2048, 2048, acc);
                    OPAQUE_WS(wx); EPI_IDS;
                    EpiProj e{(bf16_t*)(wx + WS_PROJ), (bf16_t*)(wx + WS_KROPE), (float*)(wx + WS_RSQ), (const float*)(wx + WS_COSR), (const float*)(wx + WS_SINR),
                              (const float*)(wx + WS_COSM), (const float*)(wx + WS_SINM), pm * 256, pn * 256};
                    if (!skip_epi) e(acc, wr_, wc_, fr_, fq_);
                }
            } else if (sub == 1 && (PMASK & 8)) {
                Q_BEGIN(xbar + 3520 + (ph * 2 + rep) * 8);
                const int nP2 = 32 + 192 + 256 + 256 + 1024 + (l + 1 < DEPTH ? 324 : 0);
                for (int it = c; it < nP2;) {
                    KP p = get_kp(); char* ws = p->ws;
                    if (it >= 480) Q_ISSUE();
                    if (it < 32) {
                        const int pm = it;
                        f32x4 acc[8][4];
                        gemm256(lds, (const bf16_t*)(ws + WS_HBUF) + (size_t)pm * 256 * 2048, 2048, (const bf16_t*)(ws + WS_WI) + (size_t)l * NP1 * 2048 + (size_t)14336 * 2048, 2048, 2048, acc);
                        Q_ISSUE();
                        OPAQUE_WS(wx); EPI_IDS;
                        EpiProj e{(bf16_t*)(wx + WS_PROJ), (bf16_t*)(wx + WS_KROPE), (float*)(wx + WS_RSQ), (const float*)(wx + WS_COSR), (const float*)(wx + WS_SINR),
                                  (const float*)(wx + WS_COSM), (const float*)(wx + WS_SINM), pm * 256, 14336};
                        if (!skip_epi) e(acc, wr_, wc_, fr_, fq_);
                    } else if (it < 224) {
                        const int i2 = it - 32, pm = i2 & 31, pn = i2 >> 5;
                        f32x4 acc[8][4];
                        gemm256(lds, (const bf16_t*)(ws + WS_PROJ) + (size_t)pm * 256 * LDP + 6144, LDP, (const bf16_t*)(ws + WS_WUQ) + (size_t)l * 1536 * 512 + (size_t)pn * 256 * 512, 512, 512, acc);
                        Q_ISSUE();
                        OPAQUE_WS(wx); EPI_IDS;
                        EpiQ e{(bf16_t*)(wx + WS_QM), (const float*)(wx + WS_RSQ), (const float*)(wx + WS_COSM), (const float*)(wx + WS_SINM), pm * 256, pn * 256};
                        if (!skip_epi) e(acc, wr_, wc_, fr_, fq_);
                    } else if (it < 480) {
                        const int i2 = it - 224, pm = i2 & 31, pn = i2 >> 5;
                        f32x4 acc[8][4];
                        gemm256(lds, (const bf16_t*)(ws + WS_PROJ) + (size_t)pm * 256 * LDP + 6656, LDP, (const bf16_t*)(ws + WS_WUKV) + (size_t)l * 2048 * 512 + (size_t)pn * 256 * 512, 512, 512, acc);
                        Q_ISSUE();
                        OPAQUE_WS(wx); EPI_IDS;
                        EpiKV e{(bf16_t*)(wx + WS_KN), (bf16_t*)(wx + WS_VT), (const float*)(wx + WS_RSQ), pm * 256, pn};
                        if (!skip_epi) e(acc, wr_, wc_, fr_, fq_);
                    } else if (it < 736) {
                        ret_item<false>(lds, p, l, it - 480);
                    } else if (it < 1760) {
                        lru_item(lds, p, l, it - 736);
                    } else {
                        conv4(lds, p, (l + 1) * 2592 + (it - 1760) * 4);
                    }
                    Q_TAKE(it);
                }
            } else if (sub == 2 && (PMASK & 16)) {
                Q_BEGIN(xbar + 3520 + (ph * 2 + rep) * 8);
                const int nP3 = 256 + 256 + 128 + (l + 1 < DEPTH ? 324 : 0);
                for (int it = c; it < nP3;) {
                    KP p = get_kp();
                    Q_ISSUE();
                    if (it < 256) {
                        const int bh = it & 31, Pp = 7 - (it >> 5);
                        attn_item(lds, p, bh >> 3, bh & 7, Pp);
                    } else if (it < 512) {
                        ret_item<true>(lds, p, l, it - 256);
                    } else if (it < 640) {
                        lru_out_item(p, it - 512);
                    } else {
                        conv4(lds, p, (l + 1) * 2592 + 1296 + (it - 640) * 4);
                    }
                    Q_TAKE(it);
                }
            } else if (sub == 3 && (PMASK & 32)) {
                for (int L = c; L < 256; L += G) {
                    int pm, pn; tile_map(L, 32, 8, pm, pn);
                    f32x4 acc[8][4];
#pragma unroll
                    for (int m_ = 0; m_ < 8; ++m_)
#pragma unroll
                        for (int n_ = 0; n_ < 4; ++n_) acc[m_][n_] = (f32x4){0.f, 0.f, 0.f, 0.f};
#pragma unroll 1
                    for (int i = 0; i < 3; ++i) {
                        gemm256(lds, (const bf16_t*)(ws + WS_YCAT) + (size_t)pm * 256 * 3072 + i * 1024, 3072,
                                (const bf16_t*)(ws + WS_WB) + (size_t)l * 2048 * 3072 + (size_t)pn * 256 * 3072 + i * 1024, 3072, 1024, acc, false);
                        OPAQUE_WS(wx); EPI_IDS;
                        EpiBranch e{(const bf16_t*)(wx + WS_PROJ) + 8192, (bf16_t*)(wx + WS_MERGED), i, pm * 256, pn * 256};
                        if (!skip_epi || i < 2) e(acc, wr_, wc_, fr_, fq_);
                    }
                }
            } else if (sub == 4 && (PMASK & 64)) {
                for (int L = c; L < 256; L += G) {
                    int pm, pn; tile_map(L, 32, 8, pm, pn);
                    f32x4 acc[8][4];
                    gemm256(lds, (const bf16_t*)(ws + WS_MERGED) + (size_t)pm * 256 * 2048, 2048, (const bf16_t*)(ws + WS_WO) + (size_t)l * 2048 * 2048 + (size_t)pn * 256 * 2048, 2048, 2048, acc);
                    OPAQUE_WS(wx); EPI_IDS;
                    EpiOut e{(bf16_t*)(wx + WS_YBUF), pm * 256, pn * 256};
                    if (!skip_epi) e(acc, wr_, wc_, fr_, fq_);
                }
            } else if (sub == 5 && (PMASK & 128)) {
                rowpass(p, l);
            }
        }
      }
        if (ph + 1 < parg.ph_hi) GRID_SYNC();
    }
}

extern "C" void kernel_launch(void* const* d_in, const int* in_sizes, int n_in, void* d_out, int out_size, void* d_ws, size_t ws_size, hipStream_t stream) {
    static int grid_blocks = 0;
    if (!grid_blocks) {
        int dev = 0, cus = 0, per_cu = 0;
        hipGetDevice(&dev);
        hipDeviceGetAttribute(&cus, hipDeviceAttributeMultiprocessorCount, dev);
        hipOccupancyMaxActiveBlocksPerMultiprocessor(&per_cu, fwd_megakernel, 512, 0);
        if (per_cu < 1) { fprintf(stderr, "kernel_launch: occupancy query returned %d\n", per_cu); per_cu = 1; }
        if (per_cu > 1) per_cu = 1;
        grid_blocks = cus * per_cu;
        if (ws_size < WS_END) fprintf(stderr, "kernel_launch: workspace too small: %zu < %zu\n", ws_size, (size_t)WS_END);
    }
    if (n_in != 22 || ws_size < WS_END) return;
    Params p{};
    for (int i = 0; i < 22; ++i) p.in[i] = (const float*)d_in[i];
    p.pos = (const int*)d_in[2];
    p.out = (float*)d_out;
    p.ws = (char*)d_ws;
    constexpr int NPH = 2 + 6 * DEPTH;
#if MULTI_LAUNCH
    for (int ph = 0; ph < NPH; ++ph) {
        p.ph_lo = ph; p.ph_hi = ph + 1;
        hipLaunchKernelGGL(fwd_megakernel, dim3(grid_blocks), dim3(512), 0, stream, p);
    }
#else
    p.ph_lo = 0; p.ph_hi = NPH;
    if (hipMemsetAsync((char*)d_ws + WS_BAR, 0, 4096 * 4, stream) != hipSuccess) { fprintf(stderr, "kernel_launch: hipMemsetAsync failed\n"); return; }
    void* args[] = {&p};
    hipError_t e = hipLaunchCooperativeKernel((void*)fwd_megakernel, dim3(grid_blocks), dim3(512), args, 0, stream);
    if (e != hipSuccess) fprintf(stderr, "cooperative launch failed: %s (grid %d)\n", hipGetErrorString(e), grid_blocks);
#endif
}
```

```cpp
#include <hip/hip_runtime.h>
#include <hip/hip_cooperative_groups.h>
#include <cstdio>
namespace cg = cooperative_groups;

#ifndef MULTI_LAUNCH
#define MULTI_LAUNCH 0
#endif

#ifndef PMASK
#define PMASK 0xff
#endif
#ifndef VAR_NOEPI
#define VAR_NOEPI 0
#endif
#ifndef REPMASK
#define REPMASK 0
#endif
#define LAS __attribute__((address_space(3)))
typedef unsigned short bf16_t;
typedef short bf16x8 __attribute__((ext_vector_type(8)));
typedef float f32x4 __attribute__((ext_vector_type(4)));
typedef float f32x2 __attribute__((ext_vector_type(2)));
typedef unsigned u32x4 __attribute__((ext_vector_type(4)));
typedef unsigned u32x2 __attribute__((ext_vector_type(2)));

constexpr int T = 8192, D = 2048, SEQ = 2048, DEPTH = 4;
constexpr int LDP = 14336;
constexpr int NP1 = 14592;
constexpr int NIN = 14400;
constexpr float EPS = 1e-6f;
constexpr float QSCALE = 0.07216878364870322f * 1.4426950408889634f;
constexpr float RQSCALE = 0.08838834764831845f;

constexpr size_t al256(size_t x) { return (x + 255) & ~(size_t)255; }
constexpr size_t WS_WI = 0;
constexpr size_t WS_WUQ = WS_WI + al256((size_t)DEPTH * NP1 * 2048 * 2);
constexpr size_t WS_WUKV = WS_WUQ + al256((size_t)DEPTH * 1536 * 512 * 2);
constexpr size_t WS_WB = WS_WUKV + al256((size_t)DEPTH * 2048 * 512 * 2);
constexpr size_t WS_WO = WS_WB + al256((size_t)DEPTH * 2048 * 3072 * 2);
constexpr size_t WS_WA = WS_WO + al256((size_t)DEPTH * 2048 * 2048 * 2);
constexpr size_t WS_WX = WS_WA + al256((size_t)DEPTH * 8 * 128 * 128 * 2);
constexpr size_t WS_MOD = WS_WX + al256((size_t)DEPTH * 8 * 128 * 128 * 2);
constexpr size_t WS_COSR = WS_MOD + al256((size_t)DEPTH * 4 * 6144 * 4);
constexpr size_t WS_SINR = WS_COSR + al256((size_t)T * 64 * 4);
constexpr size_t WS_COSM = WS_SINR + al256((size_t)T * 64 * 4);
constexpr size_t WS_SINM = WS_COSM + al256((size_t)T * 32 * 4);
constexpr size_t WS_XCUR = WS_SINM + al256((size_t)T * 32 * 4);
constexpr size_t WS_HBUF = WS_XCUR + al256((size_t)T * D * 4);
constexpr size_t WS_PROJ = WS_HBUF + al256((size_t)T * D * 2);
constexpr size_t WS_KROPE = WS_PROJ + al256((size_t)T * LDP * 2);
constexpr size_t WS_RSQ = WS_KROPE + al256((size_t)T * 64 * 2);
constexpr size_t WS_QM = WS_RSQ + al256((size_t)T * 16 * 4);
constexpr size_t WS_KN = WS_QM + al256((size_t)T * 8 * 192 * 2);
constexpr size_t WS_VT = WS_KN + al256((size_t)T * 8 * 128 * 2);
constexpr size_t WS_TOT = WS_VT + al256((size_t)T * 8 * 128 * 2);
constexpr size_t WS_HLOC = WS_TOT + al256((size_t)4 * 8 * 8 * 16384 * 4);
constexpr size_t WS_ACUM = WS_HLOC + al256((size_t)T * 1024 * 4);
constexpr size_t WS_YCAT = WS_ACUM + al256((size_t)T * 1024 * 4);
constexpr size_t WS_MACC = WS_YCAT + al256((size_t)T * 3072 * 2);
constexpr size_t WS_MERGED = WS_MACC + al256((size_t)T * D * 4);
constexpr size_t WS_YBUF = WS_MERGED + al256((size_t)T * D * 2);
constexpr size_t WS_BAR = WS_YBUF + al256((size_t)T * D * 4);
constexpr size_t WS_LTOT = WS_BAR + al256((size_t)4096 * 4);
constexpr size_t WS_END = WS_LTOT + al256((size_t)2 * 128 * 1024 * 4);

struct Params {
    const float* in[22];
    const int* pos;
    float* out;
    char* ws;
    int ph_lo, ph_hi;
};

typedef const Params __attribute__((address_space(4)))* KP;
__device__ __forceinline__ KP get_kp() { KP k = (KP)__builtin_amdgcn_kernarg_segment_ptr(); asm volatile("" : "+s"(k)); return k; }

__device__ __forceinline__ float bf2f(unsigned h) { return __uint_as_float(h << 16); }
__device__ __forceinline__ bf16_t f2bf(float f) { unsigned u = __float_as_uint(f); return (bf16_t)((u + 0x7fffu + ((u >> 16) & 1u)) >> 16); }
__device__ __forceinline__ unsigned pk2(float lo, float hi) { unsigned r; asm("s_nop 1\n\tv_cvt_pk_bf16_f32 %0, %1, %2" : "=v"(r) : "v"(lo), "v"(hi)); return r; }
__device__ __forceinline__ float blo(unsigned w) { return __uint_as_float(w << 16); }
__device__ __forceinline__ float bhi(unsigned w) { return __uint_as_float(w & 0xffff0000u); }
__device__ __forceinline__ float sigmoidf_(float x) { return __builtin_amdgcn_rcpf(1.0f + __builtin_amdgcn_exp2f(-1.4426950408889634f * x)); }
__device__ __forceinline__ float shx(float v, int lane, int k) { return __int_as_float(__builtin_amdgcn_ds_bpermute((lane ^ k) << 2, __float_as_int(v))); }
__device__ __forceinline__ float dppf(float v, const int ctrl_sel) {
    int r;
    if (ctrl_sel == 0) r = __builtin_amdgcn_update_dpp(0, __float_as_int(v), 0xB1, 0xf, 0xf, true);
    else if (ctrl_sel == 1) r = __builtin_amdgcn_update_dpp(0, __float_as_int(v), 0x4E, 0xf, 0xf, true);
    else if (ctrl_sel == 2) r = __builtin_amdgcn_update_dpp(0, __float_as_int(v), 0x124, 0xf, 0xf, true);
    else r = __builtin_amdgcn_update_dpp(0, __float_as_int(v), 0x128, 0xf, 0xf, true);
    return __int_as_float(r);
}
__device__ __forceinline__ float row16_max(float v) { v = fmaxf(v, dppf(v, 0)); v = fmaxf(v, dppf(v, 1)); v = fmaxf(v, dppf(v, 2)); v = fmaxf(v, dppf(v, 3)); return v; }
__device__ __forceinline__ float row16_sum(float v) { v += dppf(v, 0); v += dppf(v, 1); v += dppf(v, 2); v += dppf(v, 3); return v; }

__device__ __forceinline__ void store4bf(bf16_t* p, f32x4 v) { u32x2 o; o.x = pk2(v[0], v[1]); o.y = pk2(v[2], v[3]); *(u32x2*)p = o; }
__device__ __forceinline__ f32x4 load4bf(const bf16_t* p) { u32x2 w = *(const u32x2*)p; f32x4 r; r[0] = blo(w.x); r[1] = bhi(w.x); r[2] = blo(w.y); r[3] = bhi(w.y); return r; }
#define MFMA16(a, b, c) __builtin_amdgcn_mfma_f32_16x16x32_bf16((a), (b), (c), 0, 0, 0)
#define WAIT_V0() asm volatile("s_waitcnt vmcnt(0)" ::: "memory")
#define WAIT_L0() asm volatile("s_waitcnt lgkmcnt(0)" ::: "memory")

__device__ __forceinline__ int lds_byte2(int r, int c) { int st = (r >> 4) * 2 + (c >> 5), ob = (r & 15) * 64 + (c & 31) * 2; return st * 1024 + (ob ^ (((ob >> 9) & 1) << 5)); }
__device__ __forceinline__ void stage_rc2(int b, int& R, int& C) { int st = b >> 10, sb = b & 1023, swz = sb ^ (((sb >> 9) & 1) << 5); R = (st >> 1) * 16 + swz / 64; C = (st & 1) * 32 + (swz % 64) / 2; }

#define ROWOFF(wr, mi) ((((mi) >> 2) * 128) + (wr) * 64 + (((mi) & 3) * 16))
__device__ __forceinline__ void gemm256(LAS char* lds, const bf16_t* __restrict__ Ab, int lda, const bf16_t* __restrict__ Bb, int ldb, int K, f32x4 (&acc)[8][4], bool zero_acc = true) {
    int tid = threadIdx.x; asm volatile("" : "+v"(tid));
    const int wid = tid >> 6, lane = tid & 63, wr = wid >> 2, wc = wid & 3, fr = lane & 15, fq = lane >> 4;
    unsigned voA[2], voB[2];
#pragma unroll
    for (int i = 0; i < 2; ++i) {
        int R, C; stage_rc2(tid * 16 + i * 8192, R, C);
        voA[i] = (unsigned)(R * lda + C) * 2u;
        { const int rho = R & 31; voB[i] = (unsigned)(((R >> 5) * 64 + 8 * ((rho & 15) >> 2) + 4 * (rho >> 4) + (rho & 3)) * ldb + C) * 2u; }
    }
    const int swz = fr * 64 + ((fq * 16) ^ ((fr >> 3) << 5));
    const int aoff = wr * 8192 + swz, boff = wc * 4096 + swz, ldsw = wid * 1024;
    const size_t ahalf = (size_t)128 * lda * 2, bhalf = (size_t)32 * ldb * 2;
    if (zero_acc) {
#pragma unroll
        for (int m = 0; m < 8; ++m)
#pragma unroll
            for (int n = 0; n < 4; ++n) acc[m][n] = (f32x4){0.f, 0.f, 0.f, 0.f};
    }
#define SAo(b, h) (((b) * 2 + (h)) * 16384)
#define SBo(b, h) ((4 + (b) * 2 + (h)) * 16384)
#define STAGE_A(b, h, kt) do { const char* g_ = (const char*)Ab + (h) * ahalf + (size_t)(kt) * 128; _Pragma("unroll") for (int i_ = 0; i_ < 2; ++i_) \
        __builtin_amdgcn_global_load_lds((const unsigned*)(g_ + voA[i_]), (LAS unsigned*)(lds + SAo(b, h) + ldsw + i_ * 8192), 16, 0, 0); } while (0)
#define STAGE_B(b, h, kt) do { const char* g_ = (const char*)Bb + (h) * bhalf + (size_t)(kt) * 128; _Pragma("unroll") for (int i_ = 0; i_ < 2; ++i_) \
        __builtin_amdgcn_global_load_lds((const unsigned*)(g_ + voB[i_]), (LAS unsigned*)(lds + SBo(b, h) + ldsw + i_ * 8192), 16, 0, 0); } while (0)
#define LDA(dst, b, h) _Pragma("unroll") for (int m_ = 0; m_ < 4; ++m_) _Pragma("unroll") for (int k_ = 0; k_ < 2; ++k_) \
        dst[m_][k_] = *(const LAS bf16x8*)(lds + SAo(b, h) + aoff + m_ * 2048 + k_ * 1024)
#define LDB(dst, b, h) _Pragma("unroll") for (int n_ = 0; n_ < 2; ++n_) _Pragma("unroll") for (int k_ = 0; k_ < 2; ++k_) \
        dst[n_][k_] = *(const LAS bf16x8*)(lds + SBo(b, h) + boff + n_ * 2048 + k_ * 1024)
#define MMA(ai, bj, A_, B_) do { __builtin_amdgcn_s_setprio(1); \
        _Pragma("unroll") for (int m_ = 0; m_ < 4; ++m_) _Pragma("unroll") for (int n_ = 0; n_ < 2; ++n_) _Pragma("unroll") for (int k_ = 0; k_ < 2; ++k_) \
            acc[(ai) * 4 + m_][(bj) * 2 + n_] = MFMA16(B_[n_][k_], A_[m_][k_], acc[(ai) * 4 + m_][(bj) * 2 + n_]); \
        __builtin_amdgcn_s_setprio(0); } while (0)
#define WAIT_V(n) asm volatile("s_waitcnt vmcnt(" #n ")" ::: "memory")
#define WAIT_L(n) asm volatile("s_waitcnt lgkmcnt(" #n ")" ::: "memory")
#define BAR __builtin_amdgcn_s_barrier()
#define SCHED __builtin_amdgcn_sched_barrier(0)
    bf16x8 At[4][2], B0[2][2], B1[2][2];
    const int nt = K >> 6;
    __syncthreads();
    STAGE_B(0, 0, 0); STAGE_A(0, 0, 0); STAGE_B(0, 1, 0); STAGE_A(0, 1, 0);
    if (wr == 1) BAR;
    WAIT_V(4); BAR;
    STAGE_B(1, 0, 1); STAGE_A(1, 0, 1); STAGE_B(1, 1, 1);
    WAIT_V(6); BAR;
    for (int t = 0; t < nt - 2; t += 2) {
        LDB(B0, 0, 0); SCHED; LDA(At, 0, 0); STAGE_A(1, 1, t + 1);
        WAIT_L(8); BAR; WAIT_L(0); MMA(0, 0, At, B0); BAR; SCHED;
        LDB(B1, 0, 1); STAGE_B(0, 0, t + 2);
        BAR; WAIT_L(0); MMA(0, 1, At, B1); BAR;
        LDA(At, 0, 1); STAGE_A(0, 0, t + 2);
        BAR; WAIT_L(0); MMA(1, 0, At, B0); BAR; SCHED;
        STAGE_B(0, 1, t + 2);
        WAIT_V(6); BAR; MMA(1, 1, At, B1); BAR;
        LDB(B0, 1, 0); SCHED; LDA(At, 1, 0); STAGE_A(0, 1, t + 2);
        WAIT_L(8); BAR; WAIT_L(0); MMA(0, 0, At, B0); BAR; SCHED;
        LDB(B1, 1, 1); STAGE_B(1, 0, t + 3);
        BAR; WAIT_L(0); MMA(0, 1, At, B1); BAR;
        LDA(At, 1, 1); STAGE_A(1, 0, t + 3);
        BAR; WAIT_L(0); MMA(1, 0, At, B0); BAR; SCHED;
        STAGE_B(1, 1, t + 3);
        WAIT_V(6); BAR; MMA(1, 1, At, B1); BAR;
    }
    { LDB(B0, 0, 0); LDA(At, 0, 0); STAGE_A(1, 1, nt - 1);
      BAR; WAIT_L(0); MMA(0, 0, At, B0); BAR;
      LDB(B1, 0, 1); BAR; WAIT_L(0); MMA(0, 1, At, B1); BAR;
      LDA(At, 0, 1); WAIT_V(4); BAR; WAIT_L(0); MMA(1, 0, At, B0); MMA(1, 1, At, B1); BAR; }
    { LDB(B0, 1, 0); LDA(At, 1, 0); WAIT_V(2); BAR; WAIT_L(0); MMA(0, 0, At, B0); BAR;
      LDB(B1, 1, 1); WAIT_V(0); BAR; WAIT_L(0); MMA(0, 1, At, B1); BAR;
      LDA(At, 1, 1); BAR; WAIT_L(0); MMA(1, 0, At, B0); MMA(1, 1, At, B1); BAR; }
    if (wr == 0) BAR;
#undef SAo
#undef SBo
#undef STAGE_A
#undef STAGE_B
#undef LDA
#undef LDB
#undef MMA
#undef WAIT_V
#undef WAIT_L
#undef BAR
#undef SCHED
}
#define OPAQUE_WS(name) char* name = get_kp()->ws
#define EPI_IDS int tid_ = threadIdx.x; asm volatile("" : "+v"(tid_)); const int wid_ = tid_ >> 6, lane_ = tid_ & 63, wr_ = wid_ >> 2, wc_ = wid_ & 3, fr_ = lane_ & 15, fq_ = lane_ >> 4

__device__ __forceinline__ void tile_map(int L, int nM, int nN, int& pm, int& pn) {
    const int nwg = nM * nN; int wgid = L;
    { const int q = nwg / 8, r = nwg % 8, xcd = wgid % 8, off = wgid / 8; wgid = (xcd < r ? xcd * (q + 1) : r * (q + 1) + (xcd - r) * q) + off; }
    const int nig = 8 * nN, gid = wgid / nig, fm = gid * 8, gsz = (nM - fm) < 8 ? (nM - fm) : 8;
    pm = fm + ((wgid % nig) % gsz); pn = (wgid % nig) / gsz;
}

__device__ __forceinline__ void store8bf(bf16_t* p, f32x4 v0, f32x4 v1) { u32x4 o; o.x = pk2(v0[0], v0[1]); o.y = pk2(v0[2], v0[3]); o.z = pk2(v1[0], v1[1]); o.w = pk2(v1[2], v1[3]); *(u32x4*)p = o; }
__device__ __forceinline__ void load8bf(const bf16_t* p, f32x4& v0, f32x4& v1) { const u32x4 w = *(const u32x4*)p; v0[0] = blo(w.x); v0[1] = bhi(w.x); v0[2] = blo(w.y); v0[3] = bhi(w.y); v1[0] = blo(w.z); v1[1] = bhi(w.z); v1[2] = blo(w.w); v1[3] = bhi(w.w); }
__device__ __forceinline__ f32x4 silu4(f32x4 v) { f32x4 o; for (int j = 0; j < 4; ++j) o[j] = v[j] * sigmoidf_(v[j]); return o; }
__device__ __forceinline__ f32x4 sigm4(f32x4 v) { f32x4 o; for (int j = 0; j < 4; ++j) o[j] = sigmoidf_(v[j]); return o; }
__device__ __forceinline__ float sq4(f32x4 v) { return v[0] * v[0] + v[1] * v[1] + v[2] * v[2] + v[3] * v[3]; }

struct EpiProj {
    bf16_t* proj; bf16_t* krope; float* rsq; const float *cosr, *sinr, *cosm, *sinm; int brow, bcol;
    __device__ __forceinline__ void operator()(f32x4 (&acc)[8][4], int wr, int wc, int fr, int fq) const {
        const int c0 = bcol + wc * 64;
        int type;
        if (bcol < 1024) type = 0; else if (bcol < 2048) type = 1; else if (bcol < 3072) type = 2; else if (bcol < 4096) type = 3;
        else if (bcol < 5120) type = 2; else if (bcol < 6144) type = 3; else if (bcol < 7168) type = 4; else if (bcol < 8192) type = 3;
        else if (bcol < 14336) type = 5; else type = 6;
#pragma unroll
        for (int m = 0; m < 8; ++m) {
            const int t = brow + ROWOFF(wr, m) + fr;
            bf16_t* rowp = proj + (size_t)t * LDP + c0 + 8 * fq;
            if (type == 0 || type == 1) {
                const int blk = (c0 >> 6) & 1; const float sc = type == 0 ? RQSCALE : 1.0f;
                f32x4 o1[2], o2[2];
#pragma unroll
                for (int n = 0; n < 2; ++n) {
                    const int f0 = 32 * blk + 8 * fq + 4 * n;
                    const f32x4 cs = *(const f32x4*)(cosr + (size_t)t * 64 + f0), sn = *(const f32x4*)(sinr + (size_t)t * 64 + f0);
                    const f32x4 x1 = acc[m][n], x2 = acc[m][n + 2];
                    o1[n] = (x1 * cs - x2 * sn) * sc; o2[n] = (x2 * cs + x1 * sn) * sc;
                }
                store8bf(rowp, o1[0], o1[1]); store8bf(rowp + 32, o2[0], o2[1]);
            } else if (type == 2) {
                store8bf(rowp, acc[m][0], acc[m][1]); store8bf(rowp + 32, acc[m][2], acc[m][3]);
            } else if (type == 3) {
                store8bf(rowp, silu4(acc[m][0]), silu4(acc[m][1])); store8bf(rowp + 32, silu4(acc[m][2]), silu4(acc[m][3]));
            } else if (type == 4) {
                float s = sq4(acc[m][0]) + sq4(acc[m][1]) + sq4(acc[m][2]) + sq4(acc[m][3]);
                store8bf(rowp, acc[m][0], acc[m][1]); store8bf(rowp + 32, acc[m][2], acc[m][3]);
                { const int ln_ = fq * 16 + fr; s += shx(s, ln_, 16); s += shx(s, ln_, 32); }
                if (fq == 0) rsq[(size_t)t * 16 + ((c0 - 6144) >> 6)] = s;
            } else if (type == 5) {
                store8bf(rowp, sigm4(acc[m][0]), sigm4(acc[m][1])); store8bf(rowp + 32, sigm4(acc[m][2]), sigm4(acc[m][3]));
            } else {
                if (wc == 0) {
                    f32x4 o1[2], o2[2];
#pragma unroll
                    for (int n = 0; n < 2; ++n) {
                        const int f0 = 8 * fq + 4 * n;
                        const f32x4 cs = *(const f32x4*)(cosm + (size_t)t * 32 + f0), sn = *(const f32x4*)(sinm + (size_t)t * 32 + f0);
                        const f32x4 x1 = acc[m][n], x2 = acc[m][n + 2];
                        o1[n] = x1 * cs - x2 * sn; o2[n] = x2 * cs + x1 * sn;
                    }
                    store8bf(krope + (size_t)t * 64 + 8 * fq, o1[0], o1[1]); store8bf(krope + (size_t)t * 64 + 32 + 8 * fq, o2[0], o2[1]);
                }
            }
        }
    }
};

struct EpiQ {
    bf16_t* qm; const float* rsq; const float *cosm, *sinm; int brow, bcol;
    __device__ __forceinline__ void operator()(f32x4 (&acc)[8][4], int wr, int wc, int fr, int fq) const {
        const int c0 = bcol + wc * 64, head = c0 / 192, within = c0 - head * 192;
        float rsv[8];
#pragma unroll
        for (int m = 0; m < 8; ++m) {
            const int t = brow + ROWOFF(wr, m) + fr;
            const f32x4 r0 = *(const f32x4*)(rsq + (size_t)t * 16), r1 = *(const f32x4*)(rsq + (size_t)t * 16 + 4);
            const float ss = r0[0] + r0[1] + r0[2] + r0[3] + r1[0] + r1[1] + r1[2] + r1[3];
            rsv[m] = rsqrtf(ss * (1.0f / 512.0f) + EPS) * QSCALE;
        }
#pragma unroll
        for (int m = 0; m < 8; ++m) {
            const int t = brow + ROWOFF(wr, m) + fr, b = t >> 11, s = t & 2047;
            const float rs = rsv[m];
            bf16_t* base = qm + ((size_t)((b * 8 + head) * 2048 + s)) * 192 + within + 8 * fq;
            if (within != 128) {
                store8bf(base, acc[m][0] * rs, acc[m][1] * rs); store8bf(base + 32, acc[m][2] * rs, acc[m][3] * rs);
            } else {
                f32x4 o1[2], o2[2];
#pragma unroll
                for (int n = 0; n < 2; ++n) {
                    const int f0 = 8 * fq + 4 * n;
                    const f32x4 cs = *(const f32x4*)(cosm + (size_t)t * 32 + f0), sn = *(const f32x4*)(sinm + (size_t)t * 32 + f0);
                    const f32x4 x1 = acc[m][n] * rs, x2 = acc[m][n + 2] * rs;
                    o1[n] = x1 * cs - x2 * sn; o2[n] = x2 * cs + x1 * sn;
                }
                store8bf(base, o1[0], o1[1]); store8bf(base + 32, o2[0], o2[1]);
            }
        }
    }
};

struct EpiKV {
    bf16_t* kn; bf16_t* vt; const float* rsq; int brow, head;
    __device__ __forceinline__ void operator()(f32x4 (&acc)[8][4], int wr, int wc, int fr, int fq) const {
        float rsv[8];
#pragma unroll
        for (int m = 0; m < 8; ++m) {
            const int t = brow + ROWOFF(wr, m) + fr;
            const f32x4 r0 = *(const f32x4*)(rsq + (size_t)t * 16 + 8), r1 = *(const f32x4*)(rsq + (size_t)t * 16 + 12);
            const float ss = r0[0] + r0[1] + r0[2] + r0[3] + r1[0] + r1[1] + r1[2] + r1[3];
            rsv[m] = rsqrtf(ss * (1.0f / 512.0f) + EPS);
        }
#pragma unroll
        for (int m = 0; m < 8; ++m) {
            const int t = brow + ROWOFF(wr, m) + fr, b = t >> 11, s = t & 2047;
            const float rs = rsv[m];
            if (wc < 2) {
                bf16_t* base = kn + ((size_t)((b * 8 + head) * 2048 + s)) * 128 + wc * 64 + 8 * fq;
                store8bf(base, acc[m][0] * rs, acc[m][1] * rs); store8bf(base + 32, acc[m][2] * rs, acc[m][3] * rs);
            } else {
#pragma unroll
                for (int n = 0; n < 4; ++n)
#pragma unroll
                    for (int j = 0; j < 4; j += 2) {
                        const int d = (wc - 2) * 64 + (n >> 1) * 32 + 8 * fq + 4 * (n & 1) + j;
                        const unsigned pv_ = pk2(acc[m][n][j] * rs, acc[m][n][j + 1] * rs);
                        vt[((size_t)((b * 8 + head) * 128 + d)) * 2048 + s] = (bf16_t)pv_;
                        vt[((size_t)((b * 8 + head) * 128 + d + 1)) * 2048 + s] = (bf16_t)(pv_ >> 16);
                    }
            }
        }
    }
};

struct EpiBranch {
    const bf16_t* gates; bf16_t* merged; int mode, brow, bcol;
    __device__ __forceinline__ void operator()(f32x4 (&acc)[8][4], int wr, int wc, int fr, int fq) const {
        const int col0 = bcol + wc * 64 + 8 * fq;
        const size_t t0 = (size_t)(brow + fr);
#pragma unroll
        for (int m = 0; m < 8; ++m) {
            const size_t t = t0 + ROWOFF(wr, m);
#pragma unroll
            for (int bj = 0; bj < 2; ++bj) {
                const bf16_t* gp = gates + t * LDP + col0 + bj * 32 + mode * 2048;
                f32x4 g0, g1; load8bf(gp, g0, g1);
                if (mode != 2) {
                    f32x4 h0, h1; load8bf(gp + 2048, h0, h1);
#pragma unroll
                    for (int j = 0; j < 4; ++j) {
                        acc[m][2 * bj][j] *= g0[j] * __builtin_amdgcn_rcpf(fmaxf(h0[j], 1e-30f));
                        acc[m][2 * bj + 1][j] *= g1[j] * __builtin_amdgcn_rcpf(fmaxf(h1[j], 1e-30f));
                    }
                } else {
                    store8bf(merged + t * D + col0 + bj * 32, acc[m][2 * bj] * g0, acc[m][2 * bj + 1] * g1);
                }
            }
        }
    }
};

struct EpiOut {
    bf16_t* y; int brow, bcol;
    __device__ __forceinline__ void operator()(f32x4 (&acc)[8][4], int wr, int wc, int fr, int fq) const {
#pragma unroll
        for (int m = 0; m < 8; ++m) {
            const int t = brow + ROWOFF(wr, m) + fr;
            bf16_t* yp = y + (size_t)t * D + bcol + wc * 64 + 8 * fq;
            store8bf(yp, acc[m][0], acc[m][1]); store8bf(yp + 32, acc[m][2], acc[m][3]);
        }
    }
};

__device__ __forceinline__ int win_map(int np) {
    if (np < 2048) { const int base = np & ~127, p = np & 127, blk = p >> 6, half = (p >> 5) & 1, r = p & 31; return base + 32 * blk + 64 * half + r; }
    if (np < 7168) return np;
    if (np < 14336) return np + 64;
    if (np < 14400) return 7168 + (np - 14336);
    return -1;
}

struct ConvArgs { const float* src; const float* gain; bf16_t* dst; int ld, Kt, k0, np0, wmap; };
__device__ __forceinline__ ConvArgs conv_decode(KP p, int ci) {
    char* ws = p->ws;
    constexpr int NCONV_L = 1824 + 48 + 64 + 384 + 256 + 8 + 8;
    ConvArgs a; const int l = ci / NCONV_L; ci -= l * NCONV_L; a.gain = nullptr; a.wmap = 0;
    if (ci < 1824) { const int nt = ci % 114, kt = ci / 114; a.src = p->in[7] + (size_t)l * 2048 * NIN; a.ld = NIN; a.Kt = 2048; a.k0 = kt * 128; a.np0 = nt * 128; a.wmap = 1; a.dst = (bf16_t*)(ws + WS_WI) + (size_t)l * NP1 * 2048; }
    else if ((ci -= 1824) < 48) { const int nt = ci % 12, kt = ci / 12; a.src = p->in[17] + (size_t)l * 512 * 1536; a.ld = 1536; a.Kt = 512; a.k0 = kt * 128; a.np0 = nt * 128; a.gain = p->in[16] + l * 512; a.dst = (bf16_t*)(ws + WS_WUQ) + (size_t)l * 1536 * 512; }
    else if ((ci -= 48) < 64) { const int nt = ci % 16, kt = ci / 16; a.src = p->in[19] + (size_t)l * 512 * 2048; a.ld = 2048; a.Kt = 512; a.k0 = kt * 128; a.np0 = nt * 128; a.gain = p->in[18] + l * 512; a.dst = (bf16_t*)(ws + WS_WUKV) + (size_t)l * 2048 * 512; }
    else if ((ci -= 64) < 384) { const int nt = ci % 16, kt = ci / 16; a.src = p->in[20] + (size_t)l * 3072 * 2048; a.ld = 2048; a.Kt = 3072; a.k0 = kt * 128; a.np0 = nt * 128; a.dst = (bf16_t*)(ws + WS_WB) + (size_t)l * 2048 * 3072; }
    else if ((ci -= 384) < 256) { const int nt = ci % 16, kt = ci / 16; a.src = p->in[21] + (size_t)l * 2048 * 2048; a.ld = 2048; a.Kt = 2048; a.k0 = kt * 128; a.np0 = nt * 128; a.dst = (bf16_t*)(ws + WS_WO) + (size_t)l * 2048 * 2048; }
    else if ((ci -= 256) < 8) { a.src = p->in[11] + (size_t)(l * 8 + ci) * 16384; a.ld = 128; a.Kt = 128; a.k0 = 0; a.np0 = 0; a.dst = (bf16_t*)(ws + WS_WA) + (size_t)(l * 8 + ci) * 16384; }
    else { ci -= 8; a.src = p->in[13] + (size_t)(l * 8 + ci) * 16384; a.ld = 128; a.Kt = 128; a.k0 = 0; a.np0 = 0; a.dst = (bf16_t*)(ws + WS_WX) + (size_t)(l * 8 + ci) * 16384; }
    return a;
}
__device__ __forceinline__ void conv_load(const ConvArgs& c, int tid, f32x4 (&a)[4], f32x4 (&b)[4]) {
    const int c8 = (tid & 15) * 8, np = c.np0 + c8;
    const int n = c.wmap ? win_map(np) : np;
#pragma unroll
    for (int r = 0; r < 4; ++r) {
        const int kl = (tid >> 4) + 32 * r;
        a[r] = (f32x4){0.f, 0.f, 0.f, 0.f}; b[r] = a[r];
        if (n >= 0) { const float* sp = c.src + (size_t)(c.k0 + kl) * c.ld + n; a[r] = __builtin_nontemporal_load((const f32x4*)sp); b[r] = __builtin_nontemporal_load((const f32x4*)(sp + 4)); }
    }
}
__device__ __forceinline__ void conv_finish(LAS char* lds, const ConvArgs& c, int tid, const f32x4 (&a)[4], const f32x4 (&b)[4]) {
    LAS bf16_t* tl = (LAS bf16_t*)lds;
    const int c8 = (tid & 15) * 8;
    __syncthreads();
#pragma unroll
    for (int r = 0; r < 4; ++r) {
        const int kl = (tid >> 4) + 32 * r;
        const float g = c.gain ? c.gain[c.k0 + kl] : 1.0f;
#pragma unroll
        for (int e = 0; e < 4; e += 2) {
            const unsigned pa_ = pk2(a[r][e] * g, a[r][e + 1] * g), pb_ = pk2(b[r][e] * g, b[r][e + 1] * g);
            tl[(c8 + e) * 130 + kl] = (bf16_t)pa_; tl[(c8 + e + 1) * 130 + kl] = (bf16_t)(pa_ >> 16);
            tl[(c8 + 4 + e) * 130 + kl] = (bf16_t)pb_; tl[(c8 + 5 + e) * 130 + kl] = (bf16_t)(pb_ >> 16);
        }
    }
    __syncthreads();
#pragma unroll
    for (int r = 0; r < 4; ++r) {
        const int nl = (tid >> 4) + 32 * r, kc = (tid & 15) * 8;
        const LAS unsigned* rp = (const LAS unsigned*)(tl + nl * 130 + kc);
        u32x4 o; o.x = rp[0]; o.y = rp[1]; o.z = rp[2]; o.w = rp[3];
        *(u32x4*)(c.dst + (size_t)(c.np0 + nl) * c.Kt + c.k0 + kc) = o;
    }
}

__device__ __forceinline__ void conv4(LAS char* lds, KP p, int base) {
    int tid = threadIdx.x; asm volatile("" : "+v"(tid));
    f32x4 a0[4], b0[4], a1[4], b1[4];
    ConvArgs c0 = conv_decode(p, base), c1 = conv_decode(p, base + 1);
    conv_load(c0, tid, a0, b0); conv_load(c1, tid, a1, b1);
    conv_finish(lds, c0, tid, a0, b0);
    c0 = conv_decode(p, base + 2); conv_load(c0, tid, a0, b0);
    conv_finish(lds, c1, tid, a1, b1);
    c1 = conv_decode(p, base + 3); conv_load(c1, tid, a1, b1);
    conv_finish(lds, c0, tid, a0, b0);
    conv_finish(lds, c1, tid, a1, b1);
}

__device__ void phase0(LAS char* lds, KP p) {
    char* ws = p->ws;
    int tid = threadIdx.x; asm volatile("" : "+v"(tid)); const int wid = tid >> 6, lane = tid & 63;
    constexpr int NCONV_L = 1824 + 48 + 64 + 384 + 256 + 8 + 8;
    constexpr int N_ADA = 384, N_ROPE = 128, N_ITEMS = N_ADA + N_ROPE;
    for (int it = blockIdx.x; it < N_ITEMS; it += gridDim.x) {
        if (it < N_ADA) {
            const int l = it / 96, j0 = (it % 96) * 64;
            LAS float* cact = (LAS float*)lds;
            LAS float* red = (LAS float*)(lds + 32768);
            __syncthreads();
            for (int i = tid; i < 8192; i += 512) { const float v = p->in[1][i]; cact[i] = v * sigmoidf_(v); }
            __syncthreads();
            const int cg = lane & 15, kq = lane >> 4;
            const float* wp = p->in[3] + (size_t)l * 2048 * 6144 + j0 + 4 * cg;
            f32x4 a0 = (f32x4){0.f, 0.f, 0.f, 0.f}, a1 = a0, a2 = a0, a3 = a0;
#pragma unroll 16
            for (int j = 0; j < 64; ++j) {
                const int k = wid * 256 + 4 * j + kq;
                const f32x4 w = *(const f32x4*)(wp + (size_t)k * 6144);
                a0 += w * cact[k]; a1 += w * cact[2048 + k]; a2 += w * cact[4096 + k]; a3 += w * cact[6144 + k];
            }
#pragma unroll
            for (int e = 0; e < 4; ++e) {
                a0[e] += shx(a0[e], lane, 16); a0[e] += shx(a0[e], lane, 32); a1[e] += shx(a1[e], lane, 16); a1[e] += shx(a1[e], lane, 32);
                a2[e] += shx(a2[e], lane, 16); a2[e] += shx(a2[e], lane, 32); a3[e] += shx(a3[e], lane, 16); a3[e] += shx(a3[e], lane, 32);
            }
            if (kq == 0) {
                *(LAS f32x4*)(red + (wid * 4 + 0) * 64 + 4 * cg) = a0; *(LAS f32x4*)(red + (wid * 4 + 1) * 64 + 4 * cg) = a1;
                *(LAS f32x4*)(red + (wid * 4 + 2) * 64 + 4 * cg) = a2; *(LAS f32x4*)(red + (wid * 4 + 3) * 64 + 4 * cg) = a3;
            }
            __syncthreads();
            if (tid < 256) {
                const int b = tid >> 6, jl = tid & 63; float s = 0.f;
#pragma unroll
                for (int w = 0; w < 8; ++w) s += red[(w * 4 + b) * 64 + jl];
                ((float*)(ws + WS_MOD))[(size_t)(l * 4 + b) * 6144 + j0 + jl] = s + p->in[4][(size_t)l * 6144 + j0 + jl];
            }
        } else if (it < N_ADA + N_ROPE) {
            const int t0 = (it - N_ADA) * 64;
            for (int e = tid; e < 64 * 96; e += 512) {
                const int tl = e / 96, f = e % 96, t = t0 + tl;
                const float pos = (float)p->pos[t];
                float invf; if (f < 64) invf = exp2f(-(float)(2 * f) * (1.0f / 128.0f) * 13.287712379549449f); else invf = exp2f(-(float)(2 * (f - 64)) * (1.0f / 64.0f) * 13.287712379549449f);
                const float ang = pos * invf;
                double rev = (double)ang * 0.15915494309189535; rev -= rint(rev);
                const float rv = (float)rev;
                const float sn = __builtin_amdgcn_sinf(rv), cs = __builtin_amdgcn_cosf(rv);
                if (f < 64) { ((float*)(ws + WS_COSR))[(size_t)t * 64 + f] = cs; ((float*)(ws + WS_SINR))[(size_t)t * 64 + f] = sn; }
                else { ((float*)(ws + WS_COSM))[(size_t)t * 32 + f - 64] = cs; ((float*)(ws + WS_SINM))[(size_t)t * 32 + f - 64] = sn; }
            }
        }
    }
    {
        constexpr int NCONV = NCONV_L;
        int ci = blockIdx.x;
        f32x4 a0[4], b0[4], a1[4], b1[4];
        ConvArgs c0 = conv_decode(p, ci < NCONV ? ci : 0), c1 = c0;
        if (ci < NCONV) conv_load(c0, tid, a0, b0);
        while (ci < NCONV) {
            const int cn = ci + gridDim.x, cnn = cn + gridDim.x;
            if (cn < NCONV) { c1 = conv_decode(p, cn); conv_load(c1, tid, a1, b1); }
            conv_finish(lds, c0, tid, a0, b0);
            if (cn >= NCONV) break;
            if (cnn < NCONV) { c0 = conv_decode(p, cnn); conv_load(c0, tid, a0, b0); }
            conv_finish(lds, c1, tid, a1, b1);
            ci = cnn;
        }
    }
}

__device__ __forceinline__ float wave_sum(float v, int lane) {
    v = row16_sum(v); v += shx(v, lane, 16); v += shx(v, lane, 32); return v;
}
__device__ void rowpass(KP p, int l  ) {
    char* ws = p->ws;
    int tid = threadIdx.x; asm volatile("" : "+v"(tid));
    const int lane = tid & 63, gw = blockIdx.x * 8 + (tid >> 6), nw = gridDim.x * 8;
    const float* mod = (const float*)(ws + WS_MOD);
    float* xcur = (float*)(ws + WS_XCUR);
    const bf16_t* ybuf = (const bf16_t*)(ws + WS_YBUF);
    bf16_t* hbuf = (bf16_t*)(ws + WS_HBUF);
    for (int g4 = gw; g4 < T / 4; g4 += nw) {
        const int r0 = g4 * 4, b = r0 >> 11;
        f32x4 pa[8], pb[8], pc[8];
        if (l >= 0) {
#pragma unroll
            for (int i = 0; i < 8; ++i) {
                const int c = i * 256 + lane * 4;
                pa[i] = (*(const f32x4*)(mod + (size_t)(l * 4 + b) * 6144 + 4096 + c) + 1.0f) * *(const f32x4*)(p->in[6] + (size_t)l * D + c);
            }
        }
        if (l < DEPTH - 1) {
            const int ln = l + 1;
#pragma unroll
            for (int i = 0; i < 8; ++i) {
                const int c = i * 256 + lane * 4;
                pb[i] = (*(const f32x4*)(mod + (size_t)(ln * 4 + b) * 6144 + 2048 + c) + 1.0f) * *(const f32x4*)(p->in[5] + (size_t)ln * D + c);
                pc[i] = *(const f32x4*)(mod + (size_t)(ln * 4 + b) * 6144 + c);
            }
        }
        const float* xprev = (l <= 0) ? p->in[0] : xcur;
        float* dst = (l == DEPTH - 1) ? p->out : xcur;
#pragma unroll 1
        for (int rr = 0; rr < 4; ++rr) {
            const int row = r0 + rr;
            f32x4 xv[8], yv[8];
#pragma unroll
            for (int i = 0; i < 8; ++i) {
                xv[i] = *(const f32x4*)(xprev + (size_t)row * D + i * 256 + lane * 4);
                if (l >= 0) yv[i] = load4bf(ybuf + (size_t)row * D + i * 256 + lane * 4);
            }
            if (l >= 0) {
                float ss = 0.f;
#pragma unroll
                for (int i = 0; i < 8; ++i) ss += yv[i][0] * yv[i][0] + yv[i][1] * yv[i][1] + yv[i][2] * yv[i][2] + yv[i][3] * yv[i][3];
                ss = wave_sum(ss, lane);
                const float rs = rsqrtf(ss * (1.0f / D) + EPS);
#pragma unroll
                for (int i = 0; i < 8; ++i) {
                    xv[i] = xv[i] + pa[i] * (yv[i] * rs);
                    *(f32x4*)(dst + (size_t)row * D + i * 256 + lane * 4) = xv[i];
                }
            }
            if (l < DEPTH - 1) {
                float ss = 0.f;
#pragma unroll
                for (int i = 0; i < 8; ++i) ss += xv[i][0] * xv[i][0] + xv[i][1] * xv[i][1] + xv[i][2] * xv[i][2] + xv[i][3] * xv[i][3];
                ss = wave_sum(ss, lane);
                const float rs = rsqrtf(ss * (1.0f / D) + EPS);
#pragma unroll
                for (int i = 0; i < 8; ++i) store4bf(hbuf + (size_t)row * D + i * 256 + lane * 4, xv[i] * rs * pb[i] + pc[i]);
            }
        }
    }
}

__device__ __forceinline__ int tix(int row, int col) { return row * 72 + (col ^ (((row >> 3) & 3) << 4)); }
template <bool OUT>
__device__ void ret_item(LAS char* lds, KP p, int l, int item) {
    char* ws = p->ws;
    int tid = threadIdx.x; asm volatile("" : "+v"(tid)); const int wid = tid >> 6, lane = tid & 63, fr = lane & 15, fq = lane >> 4;
    const int g = item & 7, h = (item >> 3) & 7, b = item >> 6;
    LAS bf16_t* Qs = (LAS bf16_t*)(lds);
    LAS bf16_t* Ks = (LAS bf16_t*)(lds + 17408);
    LAS bf16_t* Kt = (LAS bf16_t*)(lds + 34816);
    LAS bf16_t* Vt = (LAS bf16_t*)(lds + 53248);
    LAS bf16_t* St = (LAS bf16_t*)(lds + 71680);
    LAS bf16_t* Ps = (LAS bf16_t*)(lds + 106496);
    LAS float* Os = (LAS float*)(lds);
    const bf16_t* proj = (const bf16_t*)(ws + WS_PROJ);
    float* tot = (float*)(ws + WS_TOT);
    const float gy = __builtin_amdgcn_exp2f(-5.0f - (float)h);
    const float lg2 = -gy * (1.0f + gy * (0.5f + gy * (0.33333334f + gy * (0.25f + gy * 0.2f)))) * 1.4426950408889634f;
    const float d64 = __builtin_amdgcn_exp2f(lg2 * 64.0f), d256 = __builtin_amdgcn_exp2f(lg2 * 256.0f);
    f32x4 sacc[8];
#pragma unroll
    for (int nf = 0; nf < 8; ++nf) sacc[nf] = (f32x4){0.f, 0.f, 0.f, 0.f};
    if (OUT) {
        float w = 1.0f;
        for (int gp = g - 1; gp >= 0; --gp) {
            const float* tp = tot + (size_t)((b * 8 + h) * 8 + gp) * 16384;
            float tv[8][4];
#pragma unroll
            for (int nf = 0; nf < 8; ++nf)
#pragma unroll
                for (int j = 0; j < 4; ++j) tv[nf][j] = tp[(16 * wid + 4 * fq + j) * 128 + 16 * nf + fr];
#pragma unroll
            for (int nf = 0; nf < 8; ++nf)
#pragma unroll
                for (int j = 0; j < 4; ++j) sacc[nf][j] += w * tv[nf][j];
            w *= d256;
        }
    }
    int li[2], lc[2];
#pragma unroll
    for (int r = 0; r < 2; ++r) { const int wt = wid + 8 * r; li[r] = 16 * (wt & 3) + (lane & 15); lc[r] = 8 * (4 * (wt >> 2) + (lane >> 4)); }
    if (!OUT) {
        LAS bf16_t* Kt2 = (LAS bf16_t*)(lds);
        LAS bf16_t* Vt2 = (LAS bf16_t*)(lds + 71680);
        u32x4 pk_[2][2], pv_[2][2];
#define RET_LOAD2(n_) do { _Pragma("unroll") for (int cc = 0; cc < 2; ++cc) { const int t0_ = b * 2048 + ((n_) + cc) * 64; _Pragma("unroll") for (int r = 0; r < 2; ++r) { \
            const bf16_t* rowp = proj + (size_t)(t0_ + li[r]) * LDP + h * 128 + lc[r]; \
            pk_[cc][r] = *(const u32x4*)(rowp + 1024); pv_[cc][r] = *(const u32x4*)(rowp + 2048); } } } while (0)
        RET_LOAD2(g * 4);
        for (int cp = 0; cp < 2; ++cp) {
            __syncthreads();
#pragma unroll
            for (int cc = 0; cc < 2; ++cc) {
                LAS bf16_t* Kd = cc ? Kt2 : Kt; LAS bf16_t* Vd = cc ? Vt2 : Vt;
#pragma unroll
                for (int r = 0; r < 2; ++r) {
                    const int i = li[r], c8 = lc[r];
                    const float dec = __builtin_amdgcn_exp2f(lg2 * (float)(63 - i));
#pragma unroll
                    for (int e = 0; e < 4; ++e) {
                        Kd[tix(c8 + 2 * e, i)] = f2bf(blo(pk_[cc][r][e]) * dec); Kd[tix(c8 + 2 * e + 1, i)] = f2bf(bhi(pk_[cc][r][e]) * dec);
                        Vd[tix(c8 + 2 * e, i)] = (bf16_t)(pv_[cc][r][e] & 0xffffu); Vd[tix(c8 + 2 * e + 1, i)] = (bf16_t)(pv_[cc][r][e] >> 16);
                    }
                }
            }
            if (cp == 0) RET_LOAD2(g * 4 + 2);
            __syncthreads();
#pragma unroll
            for (int cc = 0; cc < 2; ++cc) {
                const LAS bf16_t* Ks_ = cc ? Kt2 : Kt; const LAS bf16_t* Vs_ = cc ? Vt2 : Vt;
#pragma unroll
                for (int nf = 0; nf < 8; ++nf) sacc[nf] *= d64;
                __builtin_amdgcn_sched_barrier(0);
                {
                    bf16x8 va[2], kb[2][8];
#pragma unroll
                    for (int kk = 0; kk < 2; ++kk) {
                        va[kk] = *(const LAS bf16x8*)(Vs_ + tix(16 * wid + fr, kk * 32 + fq * 8));
#pragma unroll
                        for (int nf = 0; nf < 8; ++nf) kb[kk][nf] = *(const LAS bf16x8*)(Ks_ + tix(16 * nf + fr, kk * 32 + fq * 8));
                    }
#pragma unroll
                    for (int kk = 0; kk < 2; ++kk)
#pragma unroll
                        for (int nf = 0; nf < 8; ++nf) sacc[nf] = MFMA16(va[kk], kb[kk][nf], sacc[nf]);
                    __builtin_amdgcn_sched_group_barrier(0x100, 18, 0); __builtin_amdgcn_sched_group_barrier(0x008, 16, 0);
                }
                __builtin_amdgcn_sched_barrier(0);
            }
        }
#undef RET_LOAD2
        float* tp = tot + (size_t)item * 16384;
#pragma unroll
        for (int nf = 0; nf < 8; ++nf)
#pragma unroll
            for (int j = 0; j < 4; ++j) tp[(16 * wid + 4 * fq + j) * 128 + 16 * nf + fr] = sacc[nf][j];
        return;
    }
    u32x4 gq[2], gk[2], gv[2];
#define RET_LOAD(n_) do { const int t0_ = b * 2048 + (n_) * 64; _Pragma("unroll") for (int r = 0; r < 2; ++r) { \
        const bf16_t* rowp = proj + (size_t)(t0_ + li[r]) * LDP + h * 128 + lc[r]; \
        gk[r] = *(const u32x4*)(rowp + 1024); gv[r] = *(const u32x4*)(rowp + 2048); if (OUT) gq[r] = *(const u32x4*)(rowp); } } while (0)
    RET_LOAD(g * 4);
    const int ni = tid >> 3, npart = tid & 7, ncol = h * 128 + npart * 16;
    f32x4 gv4[4]; u32x4 sgp[2];
    if (OUT) {
#pragma unroll
        for (int e = 0; e < 4; ++e) gv4[e] = *(const f32x4*)(p->in[8] + (size_t)l * 1024 + ncol + e * 4);
    }
    for (int c = 0; c < 4; ++c) {
        const int n = g * 4 + c, t0 = b * 2048 + n * 64;
        if (OUT) { const bf16_t* gp_ = proj + (size_t)(t0 + ni) * LDP + 3072 + ncol; sgp[0] = *(const u32x4*)gp_; sgp[1] = *(const u32x4*)(gp_ + 8); }
        __syncthreads();
#pragma unroll
        for (int r = 0; r < 2; ++r) {
            const int i = li[r], c8 = lc[r];
            if (OUT) { *(LAS u32x4*)(Qs + i * 136 + c8) = gq[r]; *(LAS u32x4*)(Ks + i * 136 + c8) = gk[r]; }
            const float dec = __builtin_amdgcn_exp2f(lg2 * (float)(63 - i));
#pragma unroll
            for (int e = 0; e < 4; ++e) {
                Kt[tix(c8 + 2 * e, i)] = f2bf(blo(gk[r][e]) * dec); Kt[tix(c8 + 2 * e + 1, i)] = f2bf(bhi(gk[r][e]) * dec);
                Vt[tix(c8 + 2 * e, i)] = (bf16_t)(gv[r][e] & 0xffffu); Vt[tix(c8 + 2 * e + 1, i)] = (bf16_t)(gv[r][e] >> 16);
            }
        }
        if (OUT) {
#pragma unroll
            for (int nf = 0; nf < 8; ++nf)
#pragma unroll
                for (int j = 0; j < 4; ++j) St[(16 * wid + 4 * fq + j) * 136 + 16 * nf + fr] = f2bf(sacc[nf][j]);
        }
        if (c + 1 < 4) RET_LOAD(n + 1);
        __syncthreads();
        const int mf = wid & 3, nh = wid >> 2;
        f32x4 o1[4], o2[4];
#pragma unroll
        for (int nf = 0; nf < 4; ++nf) { o1[nf] = (f32x4){0.f, 0.f, 0.f, 0.f}; o2[nf] = (f32x4){0.f, 0.f, 0.f, 0.f}; }
        if (OUT) {
            f32x4 s2[2] = {(f32x4){0.f, 0.f, 0.f, 0.f}, (f32x4){0.f, 0.f, 0.f, 0.f}};
            {
                bf16x8 fa[4], fb0[4], fb1[4];
#pragma unroll
                for (int kk = 0; kk < 4; ++kk) {
                    fa[kk] = *(const LAS bf16x8*)(Qs + (16 * mf + fr) * 136 + kk * 32 + fq * 8);
                    fb0[kk] = *(const LAS bf16x8*)(Ks + (32 * nh + fr) * 136 + kk * 32 + fq * 8);
                    fb1[kk] = *(const LAS bf16x8*)(Ks + (32 * nh + 16 + fr) * 136 + kk * 32 + fq * 8);
                }
#pragma unroll
                for (int kk = 0; kk < 4; ++kk) { s2[0] = MFMA16(fa[kk], fb0[kk], s2[0]); s2[1] = MFMA16(fa[kk], fb1[kk], s2[1]); }
                __builtin_amdgcn_sched_group_barrier(0x100, 12, 0); __builtin_amdgcn_sched_group_barrier(0x008, 8, 0);
            }
            __builtin_amdgcn_sched_barrier(0);
#pragma unroll
            for (int nf = 0; nf < 2; ++nf)
#pragma unroll
                for (int j = 0; j < 4; ++j) {
                    const int i = 16 * mf + 4 * fq + j, jj = 32 * nh + 16 * nf + fr;
                    Ps[i * 72 + jj] = f2bf(s2[nf][j] * __builtin_amdgcn_exp2f(lg2 * fabsf((float)(i - jj))));
                }
            __builtin_amdgcn_sched_barrier(0);
            {
                bf16x8 qa[4], sb[4][4];
#pragma unroll
                for (int kk = 0; kk < 4; ++kk) {
                    qa[kk] = *(const LAS bf16x8*)(Qs + (16 * mf + fr) * 136 + kk * 32 + fq * 8);
#pragma unroll
                    for (int nf = 0; nf < 4; ++nf) sb[kk][nf] = *(const LAS bf16x8*)(St + (64 * nh + 16 * nf + fr) * 136 + kk * 32 + fq * 8);
                }
#pragma unroll
                for (int kk = 0; kk < 4; ++kk)
#pragma unroll
                    for (int nf = 0; nf < 4; ++nf) o2[nf] = MFMA16(qa[kk], sb[kk][nf], o2[nf]);
                __builtin_amdgcn_sched_group_barrier(0x100, 20, 0); __builtin_amdgcn_sched_group_barrier(0x008, 16, 0);
            }
            __builtin_amdgcn_sched_barrier(0);
        }
#pragma unroll
        for (int nf = 0; nf < 8; ++nf) sacc[nf] *= d64;
        __builtin_amdgcn_sched_barrier(0);
        {
            bf16x8 va[2], kb[2][8];
#pragma unroll
            for (int kk = 0; kk < 2; ++kk) {
                va[kk] = *(const LAS bf16x8*)(Vt + tix(16 * wid + fr, kk * 32 + fq * 8));
#pragma unroll
                for (int nf = 0; nf < 8; ++nf) kb[kk][nf] = *(const LAS bf16x8*)(Kt + tix(16 * nf + fr, kk * 32 + fq * 8));
            }
#pragma unroll
            for (int kk = 0; kk < 2; ++kk)
#pragma unroll
                for (int nf = 0; nf < 8; ++nf) sacc[nf] = MFMA16(va[kk], kb[kk][nf], sacc[nf]);
            __builtin_amdgcn_sched_group_barrier(0x100, 18, 0); __builtin_amdgcn_sched_group_barrier(0x008, 16, 0);
        }
        __builtin_amdgcn_sched_barrier(0);
        if (OUT) {
            __syncthreads();
            {
                bf16x8 pa[2], vb[2][4];
#pragma unroll
                for (int kk = 0; kk < 2; ++kk) {
                    pa[kk] = *(const LAS bf16x8*)(Ps + (16 * mf + fr) * 72 + kk * 32 + fq * 8);
#pragma unroll
                    for (int nf = 0; nf < 4; ++nf) vb[kk][nf] = *(const LAS bf16x8*)(Vt + tix(64 * nh + 16 * nf + fr, kk * 32 + fq * 8));
                }
#pragma unroll
                for (int kk = 0; kk < 2; ++kk)
#pragma unroll
                    for (int nf = 0; nf < 4; ++nf) o1[nf] = MFMA16(pa[kk], vb[kk][nf], o1[nf]);
                __builtin_amdgcn_sched_group_barrier(0x100, 10, 0); __builtin_amdgcn_sched_group_barrier(0x008, 8, 0);
            }
            __builtin_amdgcn_sched_barrier(0);
            __builtin_amdgcn_sched_barrier(0);
#pragma unroll
            for (int j = 0; j < 4; ++j) {
                const int i = 16 * mf + 4 * fq + j; const float dq = __builtin_amdgcn_exp2f(lg2 * (float)(i + 1));
#pragma unroll
                for (int nf = 0; nf < 4; ++nf) Os[i * 132 + 64 * nh + 16 * nf + fr] = o1[nf][j] + dq * o2[nf][j];
            }
        }
        if (OUT) {
            __syncthreads();
            const int i = tid >> 3, part = tid & 7, t = t0 + i;
            f32x4 v[4]; float sum = 0.f;
#pragma unroll
            for (int e = 0; e < 4; ++e) { v[e] = *(const LAS f32x4*)(Os + i * 132 + part * 16 + e * 4); sum += v[e][0] + v[e][1] + v[e][2] + v[e][3]; }
            sum += dppf(sum, 0); sum += dppf(sum, 1); sum += shx(sum, lane, 4);
            const float mean = sum * (1.0f / 128.0f);
            float sq = 0.f;
#pragma unroll
            for (int e = 0; e < 4; ++e) { v[e] = v[e] - mean; sq += v[e][0] * v[e][0] + v[e][1] * v[e][1] + v[e][2] * v[e][2] + v[e][3] * v[e][3]; }
            sq += dppf(sq, 0); sq += dppf(sq, 1); sq += shx(sq, lane, 4);
            const float rs = rsqrtf(sq * (1.0f / 128.0f) + EPS);
            bf16_t* yp = (bf16_t*)(ws + WS_YCAT) + (size_t)t * 3072 + ncol;
            f32x4 sg4[4];
            sg4[0][0] = blo(sgp[0].x); sg4[0][1] = bhi(sgp[0].x); sg4[0][2] = blo(sgp[0].y); sg4[0][3] = bhi(sgp[0].y);
            sg4[1][0] = blo(sgp[0].z); sg4[1][1] = bhi(sgp[0].z); sg4[1][2] = blo(sgp[0].w); sg4[1][3] = bhi(sgp[0].w);
            sg4[2][0] = blo(sgp[1].x); sg4[2][1] = bhi(sgp[1].x); sg4[2][2] = blo(sgp[1].y); sg4[2][3] = bhi(sgp[1].y);
            sg4[3][0] = blo(sgp[1].z); sg4[3][1] = bhi(sgp[1].z); sg4[3][2] = blo(sgp[1].w); sg4[3][3] = bhi(sgp[1].w);
            store8bf(yp, v[0] * rs * gv4[0] * sg4[0], v[1] * rs * gv4[1] * sg4[1]);
            store8bf(yp + 8, v[2] * rs * gv4[2] * sg4[2], v[3] * rs * gv4[3] * sg4[3]);
        }
    }
#undef RET_LOAD
    if (!OUT) {
        float* tp = tot + (size_t)item * 16384;
#pragma unroll
        for (int nf = 0; nf < 8; ++nf)
#pragma unroll
            for (int j = 0; j < 4; ++j) tp[(16 * wid + 4 * fq + j) * 128 + 16 * nf + fr] = sacc[nf][j];
    }
}

__device__ void lru_item(LAS char* lds, KP p, int l, int item) {
    char* ws = p->ws;
    int tid = threadIdx.x; asm volatile("" : "+v"(tid)); const int wid = tid >> 6, lane = tid & 63, fr = lane & 15, fq = lane >> 4;
    const int nb = item & 7, n = (item >> 3) & 31, b = item >> 8, t0 = b * 2048 + n * 64, s0 = n * 64;
    LAS bf16_t* Xs = (LAS bf16_t*)(lds);
    LAS float* Xf = (LAS float*)(lds + 17408);
    LAS bf16_t* Wa = (LAS bf16_t*)(lds + 50176);
    LAS bf16_t* Wx = (LAS bf16_t*)(lds + 84992);
    LAS float* As_ = (LAS float*)(lds + 50176);
    LAS float* Bs_ = (LAS float*)(lds + 82944);
    LAS float* Cq = (LAS float*)(lds + 119808);
    const bf16_t* proj = (const bf16_t*)(ws + WS_PROJ);
    const bf16_t* wat = (const bf16_t*)(ws + WS_WA) + (size_t)(l * 8 + nb) * 16384;
    const bf16_t* wxt = (const bf16_t*)(ws + WS_WX) + (size_t)(l * 8 + nb) * 16384;
    float pba[4], pbx[4], plam[4];
#pragma unroll
    for (int nf = 0; nf < 4; ++nf) { const int ch_ = l * 1024 + nb * 128 + 64 * (wid >> 2) + 16 * nf + fr; pba[nf] = p->in[12][ch_]; pbx[nf] = p->in[14][ch_]; plam[nf] = p->in[15][ch_]; }
    __syncthreads();
    {
        u32x4 wa4[4], wx4[4];
#pragma unroll
        for (int r = 0; r < 4; ++r) { const int q = tid + 512 * r, d = q >> 4, c8 = (q & 15) * 8; wa4[r] = *(const u32x4*)(wat + d * 128 + c8); wx4[r] = *(const u32x4*)(wxt + d * 128 + c8); }
#pragma unroll
        for (int r = 0; r < 4; ++r) { const int q = tid + 512 * r, d = q >> 4, c8 = (q & 15) * 8; *(LAS u32x4*)(Wa + d * 136 + c8) = wa4[r]; *(LAS u32x4*)(Wx + d * 136 + c8) = wx4[r]; }
    }
#pragma unroll
    for (int r = 0; r < 2; ++r) {
        const int q = tid + 512 * r, i = q >> 4, c8 = (q & 15) * 8, ch = nb * 128 + c8;
        f32x4 x0 = *(const f32x4*)(p->in[10] + (size_t)l * 1024 + ch), x1 = *(const f32x4*)(p->in[10] + (size_t)l * 1024 + ch + 4);
        u32x4 xv4[4]; f32x4 w04[4], w14[4];
#pragma unroll
        for (int k = 0; k < 4; ++k) {
            const int sk = s0 + i - 3 + k, tk = sk >= 0 ? (t0 + i - 3 + k) : t0;
            xv4[k] = *(const u32x4*)(proj + (size_t)tk * LDP + 4096 + ch);
            w04[k] = *(const f32x4*)(p->in[9] + (size_t)(l * 4 + k) * 1024 + ch); w14[k] = *(const f32x4*)(p->in[9] + (size_t)(l * 4 + k) * 1024 + ch + 4);
        }
#pragma unroll
        for (int k = 0; k < 4; ++k) {
            const float mk = (s0 + i - 3 + k >= 0) ? 1.0f : 0.0f;
            const f32x4 w0 = w04[k] * mk, w1 = w14[k] * mk; const u32x4 xv = xv4[k];
            x0[0] += w0[0] * blo(xv[0]); x0[1] += w0[1] * bhi(xv[0]); x0[2] += w0[2] * blo(xv[1]); x0[3] += w0[3] * bhi(xv[1]);
            x1[0] += w1[0] * blo(xv[2]); x1[1] += w1[1] * bhi(xv[2]); x1[2] += w1[2] * blo(xv[3]); x1[3] += w1[3] * bhi(xv[3]);
        }
        u32x4 o; o.x = pk2(x0[0], x0[1]); o.y = pk2(x0[2], x0[3]); o.z = pk2(x1[0], x1[1]); o.w = pk2(x1[2], x1[3]);
        *(LAS u32x4*)(Xs + i * 136 + c8) = o;
        *(LAS f32x4*)(Xf + i * 128 + c8) = x0; *(LAS f32x4*)(Xf + i * 128 + c8 + 4) = x1;
    }
    __syncthreads();
    const int mf = wid & 3, nh = wid >> 2;
    f32x4 accA[4], accX[4];
#pragma unroll
    for (int nf = 0; nf < 4; ++nf) { accA[nf] = (f32x4){0.f, 0.f, 0.f, 0.f}; accX[nf] = (f32x4){0.f, 0.f, 0.f, 0.f}; }
    __builtin_amdgcn_sched_barrier(0);
#pragma unroll
    for (int half = 0; half < 2; ++half) {
        bf16x8 xa[2], wa_[2][4], wx_[2][4];
#pragma unroll
        for (int kk = 0; kk < 2; ++kk) {
            const int k0 = (half * 2 + kk) * 32;
            xa[kk] = *(const LAS bf16x8*)(Xs + (16 * mf + fr) * 136 + k0 + fq * 8);
#pragma unroll
            for (int nf = 0; nf < 4; ++nf) {
                wa_[kk][nf] = *(const LAS bf16x8*)(Wa + (64 * nh + 16 * nf + fr) * 136 + k0 + fq * 8);
                wx_[kk][nf] = *(const LAS bf16x8*)(Wx + (64 * nh + 16 * nf + fr) * 136 + k0 + fq * 8);
            }
        }
#pragma unroll
        for (int kk = 0; kk < 2; ++kk)
#pragma unroll
            for (int nf = 0; nf < 4; ++nf) { accA[nf] = MFMA16(xa[kk], wa_[kk][nf], accA[nf]); accX[nf] = MFMA16(xa[kk], wx_[kk][nf], accX[nf]); }
        __builtin_amdgcn_sched_group_barrier(0x100, 18, 0); __builtin_amdgcn_sched_group_barrier(0x008, 16, 0);
        __builtin_amdgcn_sched_barrier(0);
    }
    __syncthreads();
#pragma unroll
    for (int nf = 0; nf < 4; ++nf) {
        const int d = 64 * nh + 16 * nf + fr;
        const float ba = pba[nf], bx = pbx[nf], lam = plam[nf];
        const float em = __expf(-fabsf(lam));
        const float l1p = em < 0.01f ? em * (1.0f - em * (0.5f - em * 0.33333334f)) : __logf(1.0f + em);
        const float sp = fmaxf(-lam, 0.0f) + l1p;
#pragma unroll
        for (int j = 0; j < 4; ++j) {
            const int i = 16 * mf + 4 * fq + j;
            const float r = sigmoidf_(accA[nf][j] + ba), ig = sigmoidf_(accX[nf][j] + bx);
            const float la = -8.0f * r * sp;
            As_[i * 128 + d] = __expf(la);
            const float x2 = 2.0f * la;
            const float om = x2 > -0.1f ? -x2 * (1.0f + x2 * (0.5f + x2 * (0.16666667f + x2 * 0.041666668f))) : 1.0f - __expf(x2);
            Bs_[i * 128 + d] = sqrtf(om) * (ig * Xf[i * 128 + d]);
        }
    }
    __syncthreads();
    {
        const int d = tid & 127, q = tid >> 7;
        float h = 0.f, A = 1.f;
#pragma unroll 4
        for (int ii = 0; ii < 16; ++ii) { const int i = 16 * q + ii; const float a = As_[i * 128 + d]; h = a * h + Bs_[i * 128 + d]; A *= a; }
        Cq[(q * 128 + d) * 2] = A; Cq[(q * 128 + d) * 2 + 1] = h;
        __syncthreads();
        float hin = 0.f, Ain = 1.f;
        for (int qq = 0; qq < q; ++qq) { const float Aq = Cq[(qq * 128 + d) * 2], hq = Cq[(qq * 128 + d) * 2 + 1]; hin = Aq * hin + hq; Ain *= Aq; }
        h = hin; A = Ain;
        bf16_t* hl = (bf16_t*)(ws + WS_HLOC) + (size_t)t0 * 1024 + nb * 128 + d;
        bf16_t* ac = (bf16_t*)(ws + WS_ACUM) + (size_t)t0 * 1024 + nb * 128 + d;
#pragma unroll 4
        for (int ii = 0; ii < 16; ++ii) {
            const int i = 16 * q + ii; const float a = As_[i * 128 + d]; h = a * h + Bs_[i * 128 + d]; A *= a;
            hl[(size_t)i * 1024] = f2bf(h); ac[(size_t)i * 1024] = f2bf(A);
        }
        if (q == 3) {
            float* lt = (float*)(ws + WS_LTOT) + (size_t)(b * 32 + n) * 1024 + nb * 128 + d;
            lt[0] = A; lt[(size_t)128 * 1024] = h;
        }
    }
}

__device__ void lru_out_item(KP p, int item) {
    char* ws = p->ws;
    int tid = threadIdx.x; asm volatile("" : "+v"(tid));
    const int n = item & 31, b = item >> 5, t0 = b * 2048 + n * 64, ch = tid * 2;
    const bf16_t* hl = (const bf16_t*)(ws + WS_HLOC); const bf16_t* ac = (const bf16_t*)(ws + WS_ACUM);
    const float* lt = (const float*)(ws + WS_LTOT);
    const bf16_t* proj = (const bf16_t*)(ws + WS_PROJ);
    bf16_t* ycat = (bf16_t*)(ws + WS_YCAT);
    f32x2 carry = (f32x2){0.f, 0.f};
    for (int m0 = 0; m0 < n; m0 += 8) {
        f32x2 A2[8], H2[8];
#pragma unroll
        for (int u = 0; u < 8; ++u) {
            const int m = (m0 + u < n) ? (m0 + u) : (n - 1);
            const size_t tl = (size_t)(b * 32 + m) * 1024 + ch;
            A2[u] = *(const f32x2*)(lt + tl); H2[u] = *(const f32x2*)(lt + (size_t)128 * 1024 + tl);
        }
#pragma unroll
        for (int u = 0; u < 8; ++u) if (m0 + u < n) carry = A2[u] * carry + H2[u];
    }
    for (int i0 = 0; i0 < 64; i0 += 8) {
        unsigned h2[8], a2[8], gw[8];
#pragma unroll
        for (int u = 0; u < 8; ++u) {
            const size_t t = t0 + i0 + u;
            h2[u] = *(const unsigned*)(hl + t * 1024 + ch); a2[u] = *(const unsigned*)(ac + t * 1024 + ch);
            gw[u] = *(const unsigned*)(proj + t * LDP + 5120 + ch);
        }
#pragma unroll
        for (int u = 0; u < 8; ++u) {
            const size_t t = t0 + i0 + u;
            const float y0 = blo(h2[u]) + blo(a2[u]) * carry.x, y1 = bhi(h2[u]) + bhi(a2[u]) * carry.y;
            *(unsigned*)(ycat + t * 3072 + 1024 + ch) = pk2(y0 * blo(gw[u]), y1 * bhi(gw[u]));
        }
    }
}

__device__ void attn_item(LAS char* lds, KP p, int b, int h, int Pp) {
    char* ws = p->ws;
    int tid = threadIdx.x; asm volatile("" : "+v"(tid)); const int wid = tid >> 6, lane = tid & 63, fr = lane & 15, fq = lane >> 4;
    LAS bf16_t* Pw = (LAS bf16_t*)(lds + 81920 + wid * 4608);
    const bf16_t* qm = (const bf16_t*)(ws + WS_QM);
    const bf16_t* kn = (const bf16_t*)(ws + WS_KN) + (size_t)(b * 8 + h) * 2048 * 128;
    const bf16_t* kr = (const bf16_t*)(ws + WS_KROPE) + (size_t)b * 2048 * 64;
    const bf16_t* vt = (const bf16_t*)(ws + WS_VT) + (size_t)(b * 8 + h) * 128 * 2048;
    const int s0 = Pp * 256 + wid * 32, nkt = 4 * Pp + 4, qc = 4 * Pp + (wid >> 1);
    bf16x8 qf[2][6];
#pragma unroll
    for (int mi = 0; mi < 2; ++mi)
#pragma unroll
        for (int ks = 0; ks < 6; ++ks) qf[mi][ks] = *(const bf16x8*)(qm + ((size_t)((b * 8 + h) * 2048 + s0 + 16 * mi + fr)) * 192 + ks * 32 + fq * 8);
    f32x4 o[2][8];
#pragma unroll
    for (int mi = 0; mi < 2; ++mi)
#pragma unroll
        for (int nd = 0; nd < 8; ++nd) o[mi][nd] = (f32x4){0.f, 0.f, 0.f, 0.f};
    float mrow[2][4], lsum[2][4];
#pragma unroll
    for (int mi = 0; mi < 2; ++mi)
#pragma unroll
        for (int j = 0; j < 4; ++j) { mrow[mi][j] = -1e30f; lsum[mi][j] = 0.f; }
    const bf16_t* ksrc[3]; int kstep[3];
#pragma unroll
    for (int r = 0; r < 3; ++r) {
        const int q = tid + 512 * r, row = q / 24, pc = q - row * 24, lc = pc ^ ((row >> 1) & 7);
        if (lc < 16) { ksrc[r] = kn + (size_t)row * 128 + lc * 8; kstep[r] = 64 * 128; } else { ksrc[r] = kr + (size_t)row * 64 + (lc - 16) * 8; kstep[r] = 64 * 64; }
    }
    const bf16_t* vsrc[2];
#pragma unroll
    for (int r = 0; r < 2; ++r) { const int q = tid + 512 * r, d = q >> 3, pc = q & 7; vsrc[r] = vt + (size_t)d * 2048 + ((pc ^ ((d >> 1) & 7)) * 8); }
    const int ldsw = wid * 1024;
#define ATT_STAGE(kt, buf) do { _Pragma("unroll") for (int r_ = 0; r_ < 3; ++r_) \
        __builtin_amdgcn_global_load_lds((const unsigned*)(ksrc[r_] + (size_t)(kt) * kstep[r_]), (LAS unsigned*)(lds + (buf) * 24576 + ldsw + r_ * 8192), 16, 0, 0); \
      _Pragma("unroll") for (int r_ = 0; r_ < 2; ++r_) \
        __builtin_amdgcn_global_load_lds((const unsigned*)(vsrc[r_] + (kt) * 64), (LAS unsigned*)(lds + 49152 + (buf) * 16384 + ldsw + r_ * 8192), 16, 0, 0); } while (0)
    const int f7 = (fr >> 1) & 7, xq = fq ^ (f7 & 3), yq = f7 >> 2;
    const int ka0 = fr * 384 + xq * 16 + yq * 64, ka1 = fr * 384 + xq * 16 + (1 - yq) * 64;
    const int va0 = fr * 128 + xq * 16 + yq * 64, va1 = fr * 128 + xq * 16 + (1 - yq) * 64;
    __syncthreads();
    ATT_STAGE(0, 0); WAIT_V0(); __syncthreads();
    for (int kt = 0; kt < nkt; ++kt) {
        const int cur = kt & 1;
        if (kt + 1 < nkt) ATT_STAGE(kt + 1, cur ^ 1);
        if (kt <= qc) {
            const LAS char* Kb = (const LAS char*)(lds + cur * 24576);
            const LAS char* Vb = (const LAS char*)(lds + 49152 + cur * 16384);
            f32x4 s[2][4];
#pragma unroll
            for (int mi = 0; mi < 2; ++mi)
#pragma unroll
                for (int n = 0; n < 4; ++n) s[mi][n] = (f32x4){0.f, 0.f, 0.f, 0.f};
            __builtin_amdgcn_sched_barrier(0);
            __builtin_amdgcn_s_setprio(1);
            {
                bf16x8 kf[6][4];
#pragma unroll
                for (int ks = 0; ks < 6; ++ks)
#pragma unroll
                    for (int n = 0; n < 4; ++n) kf[ks][n] = *(const LAS bf16x8*)(Kb + ((ks & 1) ? ka1 : ka0) + n * 6144 + (ks >> 1) * 128);
#pragma unroll
                for (int ks = 0; ks < 6; ++ks)
#pragma unroll
                    for (int n = 0; n < 4; ++n) { s[0][n] = MFMA16(qf[0][ks], kf[ks][n], s[0][n]); s[1][n] = MFMA16(qf[1][ks], kf[ks][n], s[1][n]); }
                __builtin_amdgcn_sched_group_barrier(0x100, 8, 0);
                __builtin_amdgcn_sched_group_barrier(0x008, 8, 0); __builtin_amdgcn_sched_group_barrier(0x100, 4, 0);
                __builtin_amdgcn_sched_group_barrier(0x008, 8, 0); __builtin_amdgcn_sched_group_barrier(0x100, 4, 0);
                __builtin_amdgcn_sched_group_barrier(0x008, 8, 0); __builtin_amdgcn_sched_group_barrier(0x100, 4, 0);
                __builtin_amdgcn_sched_group_barrier(0x008, 8, 0); __builtin_amdgcn_sched_group_barrier(0x100, 4, 0);
                __builtin_amdgcn_sched_group_barrier(0x008, 16, 0);
            }
            __builtin_amdgcn_s_setprio(0);
            __builtin_amdgcn_sched_barrier(0);
#pragma unroll
            for (int mi = 0; mi < 2; ++mi)
#pragma unroll
                for (int j = 0; j < 4; ++j) {
                    float mx = fmaxf(fmaxf(s[mi][0][j], s[mi][1][j]), fmaxf(s[mi][2][j], s[mi][3][j]));
                    mx = row16_max(mx);
                    const float mnew = fmaxf(mrow[mi][j], mx);
                    if (__builtin_amdgcn_ballot_w64(mnew != mrow[mi][j]) != 0ull) {
                        const float alpha = __builtin_amdgcn_exp2f(mrow[mi][j] - mnew);
                        mrow[mi][j] = mnew; lsum[mi][j] *= alpha;
#pragma unroll
                        for (int nd = 0; nd < 8; ++nd) o[mi][nd][j] *= alpha;
                    }
#pragma unroll
                    for (int n = 0; n < 4; ++n) { const float pe = __builtin_amdgcn_exp2f(s[mi][n][j] - mnew); lsum[mi][j] += pe; Pw[(16 * mi + 4 * fq + j) * 72 + n * 16 + fr] = (bf16_t)pk2(pe, 0.f); }
                }
            WAIT_L0(); __builtin_amdgcn_wave_barrier();
            __builtin_amdgcn_sched_barrier(0);
            __builtin_amdgcn_s_setprio(1);
            {
                bf16x8 pa[2][2], vb[2][8];
#pragma unroll
                for (int ks2 = 0; ks2 < 2; ++ks2)
#pragma unroll
                    for (int mi = 0; mi < 2; ++mi) pa[mi][ks2] = *(const LAS bf16x8*)(Pw + (16 * mi + fr) * 72 + ks2 * 32 + fq * 8);
#pragma unroll
                for (int ks2 = 0; ks2 < 2; ++ks2)
#pragma unroll
                    for (int nd = 0; nd < 8; ++nd) vb[ks2][nd] = *(const LAS bf16x8*)(Vb + (ks2 ? va1 : va0) + nd * 2048);
#pragma unroll
                for (int ks2 = 0; ks2 < 2; ++ks2)
#pragma unroll
                    for (int nd = 0; nd < 8; ++nd) { o[0][nd] = MFMA16(pa[0][ks2], vb[ks2][nd], o[0][nd]); o[1][nd] = MFMA16(pa[1][ks2], vb[ks2][nd], o[1][nd]); }
                __builtin_amdgcn_sched_group_barrier(0x100, 12, 0);
                __builtin_amdgcn_sched_group_barrier(0x008, 4, 0); __builtin_amdgcn_sched_group_barrier(0x100, 2, 0);
                __builtin_amdgcn_sched_group_barrier(0x008, 4, 0); __builtin_amdgcn_sched_group_barrier(0x100, 2, 0);
                __builtin_amdgcn_sched_group_barrier(0x008, 4, 0); __builtin_amdgcn_sched_group_barrier(0x100, 2, 0);
                __builtin_amdgcn_sched_group_barrier(0x008, 4, 0); __builtin_amdgcn_sched_group_barrier(0x100, 2, 0);
                __builtin_amdgcn_sched_group_barrier(0x008, 16, 0);
            }
            __builtin_amdgcn_s_setprio(0);
            __builtin_amdgcn_sched_barrier(0);
        }
        WAIT_V0(); __syncthreads();
    }
#undef ATT_STAGE
    const bf16_t* proj = (const bf16_t*)(ws + WS_PROJ);
    bf16_t* ycat = (bf16_t*)(ws + WS_YCAT);
    LAS bf16_t* Ow = (LAS bf16_t*)(lds + wid * 8704);
#pragma unroll
    for (int mi = 0; mi < 2; ++mi)
#pragma unroll
        for (int j = 0; j < 4; ++j) {
            const float ls = row16_sum(lsum[mi][j]);
            const float inv = 1.0f / ls;
#pragma unroll
            for (int nd = 0; nd < 8; ++nd) Ow[(16 * mi + 4 * fq + j) * 136 + nd * 16 + fr] = f2bf(o[mi][nd][j] * inv);
        }
    WAIT_L0(); __builtin_amdgcn_wave_barrier();
#pragma unroll
    for (int r = 0; r < 8; ++r) {
        const int q = lane + 64 * r, row = q >> 4, c8 = (q & 15) * 8;
        const size_t t = (size_t)b * 2048 + s0 + row;
        const u32x4 ov = *(const LAS u32x4*)(Ow + row * 136 + c8);
        const u32x4 gv = *(const u32x4*)(proj + t * LDP + 7168 + h * 128 + c8);
        u32x4 y;
#pragma unroll
        for (int e = 0; e < 4; ++e) y[e] = pk2(blo(ov[e]) * blo(gv[e]), bhi(ov[e]) * bhi(gv[e]));
        *(u32x4*)(ycat + t * 3072 + 2048 + h * 128 + c8) = y;
    }
}

#define XB_TMO      128
#define XB_XCNT(j)  (256  + 64 * (j))
#define XB_XSUB(j)  (1280 + 64 * (j))
#define XB_XGEN(j)  (2304 + 64 * (j))
#define XB_TOP      3328
#define XB_TOPGEN   3392
#define XCD_BAR_WORDS 3456
#define XB_SPIN_CAP (1u << 18)
__device__ __forceinline__ unsigned xb_ld(unsigned* p)              { return __hip_atomic_load(p, __ATOMIC_RELAXED, __HIP_MEMORY_SCOPE_AGENT); }
__device__ __forceinline__ unsigned xb_add(unsigned* p, unsigned v) { return __hip_atomic_fetch_add(p, v, __ATOMIC_RELAXED, __HIP_MEMORY_SCOPE_AGENT); }
__device__ __forceinline__ unsigned xb_xcc_id() { return (unsigned)__builtin_amdgcn_s_getreg((3 << 11) | 20) & 0xFu; }
#define XB_SPIN(cond, bar) do { unsigned _sp = 0; while (cond) { __builtin_amdgcn_s_sleep(1); \
    if ((++_sp & 255u) == 0u) { if (xb_ld(&(bar)[XB_TMO])) break; if (_sp > XB_SPIN_CAP) { atomicAdd(&(bar)[XB_TMO], 1u); break; } } } } while (0)
struct XcdBarrier { unsigned* bar; unsigned x; volatile LAS unsigned* st; };
__device__ __forceinline__ XcdBarrier xcd_barrier_post(unsigned* bar, volatile LAS unsigned* st) {
    XcdBarrier b; b.bar = bar; b.x = xb_xcc_id(); b.st = st;
    if (threadIdx.x == 0) (void)xb_add(&bar[XB_XCNT(b.x)], 1u);
    return b;
}
__device__ __forceinline__ void xcd_barrier_complete(unsigned* bar, unsigned x, unsigned& nloc, unsigned& nx) {
    const unsigned G = gridDim.x * gridDim.y * gridDim.z;
    unsigned sum, cnt, mine, sp = 0u;
    for (;;) {
        sum = 0u; cnt = 0u; mine = 0u;
#pragma unroll
        for (unsigned j = 0; j < 16; ++j) { const unsigned c = xb_ld(&bar[XB_XCNT(j)]); sum += c; cnt += (c > 0u) ? 1u : 0u; mine = (j == x) ? c : mine; }
        if (sum == G) break;
        __builtin_amdgcn_s_sleep(1);
        if ((++sp & 255u) == 0u) { if (xb_ld(&bar[XB_TMO])) break; if (sp > XB_SPIN_CAP) { atomicAdd(&bar[XB_TMO], 1u); break; } }
    }
    nloc = mine > 0u ? mine : 1u; nx = cnt > 0u ? cnt : 1u;
}
__device__ __forceinline__ void xcd_barrier(const XcdBarrier& b) {
    asm volatile("s_waitcnt vmcnt(0)" ::: "memory");
    __syncthreads();
    if (threadIdx.x == 0) {
        unsigned* bar = b.bar; asm volatile("" : "+s"(bar));
        __builtin_amdgcn_s_waitcnt(0);
        unsigned nloc = b.st[0], nx = b.st[1];
        if (nloc == 0u) { xcd_barrier_complete(bar, b.x, nloc, nx); b.st[0] = nloc; b.st[1] = nx; }
        const unsigned old = xb_add(&bar[XB_XSUB(b.x)], 1u);
        const unsigned gen = old / nloc;
        if (old + 1u == (gen + 1u) * nloc) {
            __builtin_amdgcn_fence(__ATOMIC_RELEASE, "agent");
            asm volatile("s_waitcnt vmcnt(0)" ::: "memory");
            const unsigned og = xb_add(&bar[XB_TOP], 1u);
            const unsigned tg = og / nx;
            if (og + 1u == (tg + 1u) * nx) xb_add(&bar[XB_TOPGEN], 1u);
            else XB_SPIN(xb_ld(&bar[XB_TOPGEN]) == tg, bar);
            __builtin_amdgcn_fence(__ATOMIC_ACQUIRE, "agent");
            xb_add(&bar[XB_XGEN(b.x)], 1u);
            asm volatile("s_waitcnt vmcnt(0)" ::: "memory");
        } else {
            XB_SPIN(xb_ld(&bar[XB_XGEN(b.x)]) == gen, bar);
            __builtin_amdgcn_fence(__ATOMIC_ACQUIRE, "agent");
            asm volatile("s_waitcnt vmcnt(0)" ::: "memory");
        }
    }
    __syncthreads();
}

#define Q_BEGIN(ctrp) unsigned* qctr_ = (ctrp); volatile LAS int* qslot_ = (volatile LAS int*)(lds + 131072 + 8); int qnxt_ = 0
#define Q_ISSUE() do { int r_ = 0; if (threadIdx.x == 0) r_ = (int)__hip_atomic_fetch_add(qctr_, 1u, __ATOMIC_RELAXED, __HIP_MEMORY_SCOPE_AGENT); qnxt_ = r_; } while (0)
#define Q_TAKE(it) do { __syncthreads(); if (threadIdx.x == 0) *qslot_ = G + qnxt_; __syncthreads(); (it) = *qslot_; } while (0)

__global__ void __launch_bounds__(512) fwd_megakernel(Params parg) {
    __shared__ __attribute__((aligned(1024))) char shm[131072 + 16];
    LAS char* lds = (LAS char*)shm;
    const int G = gridDim.x, c = blockIdx.x;
    volatile LAS unsigned* xst = (volatile LAS unsigned*)(lds + 131072);
    unsigned* xbar = (unsigned*)(parg.ws + WS_BAR);
    if (threadIdx.x == 0) { xst[0] = 0u; xst[1] = 0u; }
    __syncthreads();
    XcdBarrier xb = xcd_barrier_post(xbar, xst);
    if (parg.ph_lo > 1000) cg::this_grid().sync();
#define GRID_SYNC() xcd_barrier(xb)
    for (int ph = parg.ph_lo; ph < parg.ph_hi; ++ph) {
      const int ptype = ph < 2 ? ph : 2 + (ph - 2) % 6;
      const int nrep = 1 + ((REPMASK >> ptype) & 1);
      for (int rep = 0; rep < nrep; ++rep) {
        if (rep) GRID_SYNC();
        const bool skip_epi = VAR_NOEPI && (rep + 1 < nrep);
        KP p = get_kp();
        char* ws = p->ws;
        if (ph == 0) {
            if (PMASK & 1) phase0(lds, p);
        } else if (ph == 1) {
            if (PMASK & 2) rowpass(p, -1);
        } else {
            const int l = (ph - 2) / 6, sub = (ph - 2) % 6;
            if (sub == 0 && (PMASK & 4)) {
                const bf16_t* A = (const bf16_t*)(ws + WS_HBUF);
                const bf16_t* Bt = (const bf16_t*)(ws + WS_WI) + (size_t)l * NP1 * 2048;
                for (int L = c; L < 32 * 56; L += G) {
                    int pm, pn; tile_map(L, 32, 56, pm, pn);
                    f32x4 acc[8][4];
                    gemm256(lds, A + (size_t)pm * 256 * 2048, 2048, Bt + (size_t)pn * 256 * 2048, 2048, 2048, acc);
                    OPAQUE_WS(wx); EPI_IDS;
                    EpiProj e{(bf16_t*)(wx + WS_PROJ), (bf16_t*)(wx + WS_KROPE), (float*)(wx + WS_RSQ), (const float*)(wx + WS_COSR), (const float*)(wx + WS_SINR),
                              (const float*)(wx + WS_COSM), (const float*)(wx + WS_SINM), pm * 256, pn * 256};
                    if (!skip_epi) e(acc, wr_, wc_, fr_, fq_);
                }
            } else if (sub == 1 && (PMASK & 8)) {
                Q_BEGIN(xbar + 3520 + (ph * 2 + rep) * 8);
                const int nP2 = 32 + 192 + 256 + 256 + 1024 + (l + 1 < DEPTH ? 324 : 0);
                for (int it = c; it < nP2;) {
                    KP p = get_kp(); char* ws = p->ws;
                    if (it >= 480) Q_ISSUE();
                    if (it < 32) {
                        const int pm = it;
                        f32x4 acc[8][4];
                        gemm256(lds, (const bf16_t*)(ws + WS_HBUF) + (size_t)pm * 256 * 2048, 2048, (const bf16_t*)(ws + WS_WI) + (size_t)l * NP1 * 2048 + (size_t)14336 * 2048, 2048, 2048, acc);
                        Q_ISSUE();
                        OPAQUE_WS(wx); EPI_IDS;
                        EpiProj e{(bf16_t*)(wx + WS_PROJ), (bf16_t*)(wx + WS_KROPE), (float*)(wx + WS_RSQ), (const float*)(wx + WS_COSR), (const float*)(wx + WS_SINR),
                                  (const float*)(wx + WS_COSM), (const float*)(wx + WS_SINM), pm * 256, 14336};
                        if (!skip_epi) e(acc, wr_, wc_, fr_, fq_);
                    } else if (it < 224) {
                        const int i2 = it - 32, pm = i2 & 31, pn = i2 >> 5;
                        f32x4 acc[8][4];
                        gemm256(lds, (const bf16_t*)(ws + WS_PROJ) + (size_t)pm * 256 * LDP + 6144, LDP, (const bf16_t*)(ws + WS_WUQ) + (size_t)l * 1536 * 512 + (size_t)pn * 256 * 512, 512, 512, acc);
                        Q_ISSUE();
                        OPAQUE_WS(wx); EPI_IDS;
                        EpiQ e{(bf16_t*)(wx + WS_QM), (const float*)(wx + WS_RSQ), (const float*)(wx + WS_COSM), (const float*)(wx + WS_SINM), pm * 256, pn * 256};
                        if (!skip_epi) e(acc, wr_, wc_, fr_, fq_);
                    } else if (it < 480) {
                        const int i2 = it - 224, pm = i2 & 31, pn = i2 >> 5;
                        f32x4 acc[8][4];
                        gemm256(lds, (const bf16_t*)(ws + WS_PROJ) + (size_t)pm * 256 * LDP + 6656, LDP, (const bf16_t*)(ws + WS_WUKV) + (size_t)l * 2048 * 512 + (size_t)pn * 256 * 512, 512, 512, acc);
                        Q_ISSUE();
                        OPAQUE_WS(wx); EPI_IDS;
                        EpiKV e{(bf16_t*)(wx + WS_KN), (bf16_t*)(wx + WS_VT), (const float*)(wx + WS_RSQ), pm * 256, pn};
                        if (!skip_epi) e(acc, wr_, wc_, fr_, fq_);
                    } else if (it < 736) {
                        ret_item<false>(lds, p, l, it - 480);
                    } else if (it < 1760) {
                        lru_item(lds, p, l, it - 736);
                    } else {
                        conv4(lds, p, (l + 1) * 2592 + (it - 1760) * 4);
                    }
                    Q_TAKE(it);
                }
            } else if (sub == 2 && (PMASK & 16)) {
                Q_BEGIN(xbar + 3520 + (ph * 2 + rep) * 8);
                const int nP3 = 256 + 256 + 128 + (l + 1 < DEPTH ? 324 : 0);
                for (int it = c; it < nP3;) {
                    KP p = get_kp();
                    Q_ISSUE();
                    if (it < 256) {
                        const int bh = it & 31, Pp = 7 - (it >> 5);
                        attn_item(lds, p, bh >> 3, bh & 7, Pp);
                    } else if (it < 512) {
                        ret_item<true>(lds, p, l, it - 256);
                    } else if (it < 640) {
                        lru_out_item(p, it - 512);
                    } else {
                        conv4(lds, p, (l + 1) * 2592 + 1296 + (it - 640) * 4);
                    }
                    Q_TAKE(it);
                }
            } else if (sub == 3 && (PMASK & 32)) {
                for (int L = c; L < 256; L += G) {
                    int pm, pn; tile_map(L, 32, 8, pm, pn);
                    f32x4 acc[8][4];
#pragma unroll
                    for (int m_ = 0; m_ < 8; ++m_)
#pragma unroll
                        for (int n_ = 0; n_ < 4; ++n_) acc[m_][n_] = (f32x4){0.f, 0.f, 0.f, 0.f};
#pragma unroll 1
                    for (int i = 0; i < 3; ++i) {
                        gemm256(lds, (const bf16_t*)(ws + WS_YCAT) + (size_t)pm * 256 * 3072 + i * 1024, 3072,
                                (const bf16_t*)(ws + WS_WB) + (size_t)l * 2048 * 3072 + (size_t)pn * 256 * 3072 + i * 1024, 3072, 1024, acc, false);
                        OPAQUE_WS(wx); EPI_IDS;
                        EpiBranch e{(const bf16_t*)(wx + WS_PROJ) + 8192, (bf16_t*)(wx + WS_MERGED), i, pm * 256, pn * 256};
                        if (!skip_epi || i < 2) e(acc, wr_, wc_, fr_, fq_);
                    }
                }
            } else if (sub == 4 && (PMASK & 64)) {
                for (int L = c; L < 256; L += G) {
                    int pm, pn; tile_map(L, 32, 8, pm, pn);
                    f32x4 acc[8][4];
                    gemm256(lds, (const bf16_t*)(ws + WS_MERGED) + (size_t)pm * 256 * 2048, 2048, (const bf16_t*)(ws + WS_WO) + (size_t)l * 2048 * 2048 + (size_t)pn * 256 * 2048, 2048, 2048, acc);
                    OPAQUE_WS(wx); EPI_IDS;
                    EpiOut e{(bf16_t*)(wx + WS_YBUF), pm * 256, pn * 256};
                    if (!skip_epi) e(acc, wr_, wc_, fr_, fq_);
                }
            } else if (sub == 5 && (PMASK & 128)) {
                rowpass(p, l);
            }
        }
      }
        if (ph + 1 < parg.ph_hi) GRID_SYNC();
    }
}

extern "C" void kernel_launch(void* const* d_in, const int* in_sizes, int n_in, void* d_out, int out_size, void* d_ws, size_t ws_size, hipStream_t stream) {
    static int grid_blocks = 0;
    if (!grid_blocks) {
        int dev = 0, cus = 0, per_cu = 0;
        hipGetDevice(&dev);
        hipDeviceGetAttribute(&cus, hipDeviceAttributeMultiprocessorCount, dev);
        hipOccupancyMaxActiveBlocksPerMultiprocessor(&per_cu, fwd_megakernel, 512, 0);
        if (per_cu < 1) { fprintf(stderr, "kernel_launch: occupancy query returned %d\n", per_cu); per_cu = 1; }
        if (per_cu > 1) per_cu = 1;
        grid_blocks = cus * per_cu;
        if (ws_size < WS_END) fprintf(stderr, "kernel_launch: workspace too small: %zu < %zu\n", ws_size, (size_t)WS_END);
    }
    if (n_in != 22 || ws_size < WS_END) return;
    Params p{};
    for (int i = 0; i < 22; ++i) p.in[i] = (const float*)d_in[i];
    p.pos = (const int*)d_in[2];
    p.out = (float*)d_out;
    p.ws = (char*)d_ws;
    constexpr int NPH = 2 + 6 * DEPTH;
#if MULTI_LAUNCH
    for (int ph = 0; ph < NPH; ++ph) {
        p.ph_lo = ph; p.ph_hi = ph + 1;
        hipLaunchKernelGGL(fwd_megakernel, dim3(grid_blocks), dim3(512), 0, stream, p);
    }
#else
    p.ph_lo = 0; p.ph_hi = NPH;
    if (hipMemsetAsync((char*)d_ws + WS_BAR, 0, 4096 * 4, stream) != hipSuccess) { fprintf(stderr, "kernel_launch: hipMemsetAsync failed\n"); return; }
    void* args[] = {&p};
    hipError_t e = hipLaunchCooperativeKernel((void*)fwd_megakernel, dim3(grid_blocks), dim3(512), args, 0, stream);
    if (e != hipSuccess) fprintf(stderr, "cooperative launch failed: %s (grid %d)\n", hipGetErrorString(e), grid_blocks);
#endif
}
```

```cpp
#include <hip/hip_runtime.h>
#include <hip/hip_cooperative_groups.h>
#include <cstdio>
namespace cg = cooperative_groups;

#ifndef MULTI_LAUNCH
#define MULTI_LAUNCH 0
#endif

#ifndef PMASK
#define PMASK 0xff
#endif
#ifndef VAR_NOEPI
#define VAR_NOEPI 0
#endif
#ifndef REPMASK
#define REPMASK 0
#endif
#define LAS __attribute__((address_space(3)))
typedef unsigned short bf16_t;
typedef short bf16x8 __attribute__((ext_vector_type(8)));
typedef float f32x4 __attribute__((ext_vector_type(4)));
typedef float f32x2 __attribute__((ext_vector_type(2)));
typedef unsigned u32x4 __attribute__((ext_vector_type(4)));
typedef unsigned u32x2 __attribute__((ext_vector_type(2)));

constexpr int T = 8192, D = 2048, SEQ = 2048, DEPTH = 4;
constexpr int LDP = 14336;
constexpr int NP1 = 14592;
constexpr int NIN = 14400;
constexpr float EPS = 1e-6f;
constexpr float QSCALE = 0.07216878364870322f * 1.4426950408889634f;
constexpr float RQSCALE = 0.08838834764831845f;

constexpr size_t al256(size_t x) { return (x + 255) & ~(size_t)255; }
constexpr size_t WS_WI = 0;
constexpr size_t WS_WUQ = WS_WI + al256((size_t)DEPTH * NP1 * 2048 * 2);
constexpr size_t WS_WUKV = WS_WUQ + al256((size_t)DEPTH * 1536 * 512 * 2);
constexpr size_t WS_WB = WS_WUKV + al256((size_t)DEPTH * 2048 * 512 * 2);
constexpr size_t WS_WO = WS_WB + al256((size_t)DEPTH * 2048 * 3072 * 2);
constexpr size_t WS_WA = WS_WO + al256((size_t)DEPTH * 2048 * 2048 * 2);
constexpr size_t WS_WX = WS_WA + al256((size_t)DEPTH * 8 * 128 * 128 * 2);
constexpr size_t WS_MOD = WS_WX + al256((size_t)DEPTH * 8 * 128 * 128 * 2);
constexpr size_t WS_COSR = WS_MOD + al256((size_t)DEPTH * 4 * 6144 * 4);
constexpr size_t WS_SINR = WS_COSR + al256((size_t)T * 64 * 4);
constexpr size_t WS_COSM = WS_SINR + al256((size_t)T * 64 * 4);
constexpr size_t WS_SINM = WS_COSM + al256((size_t)T * 32 * 4);
constexpr size_t WS_XCUR = WS_SINM + al256((size_t)T * 32 * 4);
constexpr size_t WS_HBUF = WS_XCUR + al256((size_t)T * D * 4);
constexpr size_t WS_PROJ = WS_HBUF + al256((size_t)T * D * 2);
constexpr size_t WS_KROPE = WS_PROJ + al256((size_t)T * LDP * 2);
constexpr size_t WS_RSQ = WS_KROPE + al256((size_t)T * 64 * 2);
constexpr size_t WS_QM = WS_RSQ + al256((size_t)T * 16 * 4);
constexpr size_t WS_KN = WS_QM + al256((size_t)T * 8 * 192 * 2);
constexpr size_t WS_VT = WS_KN + al256((size_t)T * 8 * 128 * 2);
constexpr size_t WS_TOT = WS_VT + al256((size_t)T * 8 * 128 * 2);
constexpr size_t WS_HLOC = WS_TOT + al256((size_t)4 * 8 * 8 * 16384 * 4);
constexpr size_t WS_ACUM = WS_HLOC + al256((size_t)T * 1024 * 4);
constexpr size_t WS_YCAT = WS_ACUM + al256((size_t)T * 1024 * 4);
constexpr size_t WS_MACC = WS_YCAT + al256((size_t)T * 3072 * 2);
constexpr size_t WS_MERGED = WS_MACC + al256((size_t)T * D * 4);
constexpr size_t WS_YBUF = WS_MERGED + al256((size_t)T * D * 2);
constexpr size_t WS_BAR = WS_YBUF + al256((size_t)T * D * 4);
constexpr size_t WS_LTOT = WS_BAR + al256((size_t)4096 * 4);
constexpr size_t WS_END = WS_LTOT + al256((size_t)2 * 128 * 1024 * 4);

struct Params {
    const float* in[22];
    const int* pos;
    float* out;
    char* ws;
    int ph_lo, ph_hi;
};

typedef const Params __attribute__((address_space(4)))* KP;
__device__ __forceinline__ KP get_kp() { KP k = (KP)__builtin_amdgcn_kernarg_segment_ptr(); asm volatile("" : "+s"(k)); return k; }

__device__ __forceinline__ float bf2f(unsigned h) { return __uint_as_float(h << 16); }
__device__ __forceinline__ bf16_t f2bf(float f) { unsigned u = __float_as_uint(f); return (bf16_t)((u + 0x7fffu + ((u >> 16) & 1u)) >> 16); }
__device__ __forceinline__ unsigned pk2(float lo, float hi) { unsigned r; asm("s_nop 1\n\tv_cvt_pk_bf16_f32 %0, %1, %2" : "=v"(r) : "v"(lo), "v"(hi)); return r; }
__device__ __forceinline__ float blo(unsigned w) { return __uint_as_float(w << 16); }
__device__ __forceinline__ float bhi(unsigned w) { return __uint_as_float(w & 0xffff0000u); }
__device__ __forceinline__ float sigmoidf_(float x) { return __builtin_amdgcn_rcpf(1.0f + __builtin_amdgcn_exp2f(-1.4426950408889634f * x)); }
__device__ __forceinline__ float shx(float v, int lane, int k) { return __int_as_float(__builtin_amdgcn_ds_bpermute((lane ^ k) << 2, __float_as_int(v))); }
__device__ __forceinline__ float dppf(float v, const int ctrl_sel) {
    int r;
    if (ctrl_sel == 0) r = __builtin_amdgcn_update_dpp(0, __float_as_int(v), 0xB1, 0xf, 0xf, true);
    else if (ctrl_sel == 1) r = __builtin_amdgcn_update_dpp(0, __float_as_int(v), 0x4E, 0xf, 0xf, true);
    else if (ctrl_sel == 2) r = __builtin_amdgcn_update_dpp(0, __float_as_int(v), 0x124, 0xf, 0xf, true);
    else r = __builtin_amdgcn_update_dpp(0, __float_as_int(v), 0x128, 0xf, 0xf, true);
    return __int_as_float(r);
}
__device__ __forceinline__ float row16_max(float v) { v = fmaxf(v, dppf(v, 0)); v = fmaxf(v, dppf(v, 1)); v = fmaxf(v, dppf(v, 2)); v = fmaxf(v, dppf(v, 3)); return v; }
__device__ __forceinline__ float row16_sum(float v) { v += dppf(v, 0); v += dppf(v, 1); v += dppf(v, 2); v += dppf(v, 3); return v; }

__device__ __forceinline__ void store4bf(bf16_t* p, f32x4 v) { u32x2 o; o.x = pk2(v[0], v[1]); o.y = pk2(v[2], v[3]); *(u32x2*)p = o; }
__device__ __forceinline__ f32x4 load4bf(const bf16_t* p) { u32x2 w = *(const u32x2*)p; f32x4 r; r[0] = blo(w.x); r[1] = bhi(w.x); r[2] = blo(w.y); r[3] = bhi(w.y); return r; }
#define MFMA16(a, b, c) __builtin_amdgcn_mfma_f32_16x16x32_bf16((a), (b), (c), 0, 0, 0)
#define WAIT_V0() asm volatile("s_waitcnt vmcnt(0)" ::: "memory")
#define WAIT_L0() asm volatile("s_waitcnt lgkmcnt(0)" ::: "memory")

__device__ __forceinline__ int lds_byte2(int r, int c) { int st = (r >> 4) * 2 + (c >> 5), ob = (r & 15) * 64 + (c & 31) * 2; return st * 1024 + (ob ^ (((ob >> 9) & 1) << 5)); }
__device__ __forceinline__ void stage_rc2(int b, int& R, int& C) { int st = b >> 10, sb = b & 1023, swz = sb ^ (((sb >> 9) & 1) << 5); R = (st >> 1) * 16 + swz / 64; C = (st & 1) * 32 + (swz % 64) / 2; }

#define ROWOFF(wr, mi) ((((mi) >> 2) * 128) + (wr) * 64 + (((mi) & 3) * 16))
__device__ __forceinline__ void gemm256(LAS char* lds, const bf16_t* __restrict__ Ab, int lda, const bf16_t* __restrict__ Bb, int ldb, int K, f32x4 (&acc)[8][4], bool zero_acc = true) {
    int tid = threadIdx.x; asm volatile("" : "+v"(tid));
    const int wid = tid >> 6, lane = tid & 63, wr = wid >> 2, wc = wid & 3, fr = lane & 15, fq = lane >> 4;
    unsigned voA[2], voB[2];
#pragma unroll
    for (int i = 0; i < 2; ++i) {
        int R, C; stage_rc2(tid * 16 + i * 8192, R, C);
        voA[i] = (unsigned)(R * lda + C) * 2u;
        { const int rho = R & 31; voB[i] = (unsigned)(((R >> 5) * 64 + 8 * ((rho & 15) >> 2) + 4 * (rho >> 4) + (rho & 3)) * ldb + C) * 2u; }
    }
    const int swz = fr * 64 + ((fq * 16) ^ ((fr >> 3) << 5));
    const int aoff = wr * 8192 + swz, boff = wc * 4096 + swz, ldsw = wid * 1024;
    const size_t ahalf = (size_t)128 * lda * 2, bhalf = (size_t)32 * ldb * 2;
    if (zero_acc) {
#pragma unroll
        for (int m = 0; m < 8; ++m)
#pragma unroll
            for (int n = 0; n < 4; ++n) acc[m][n] = (f32x4){0.f, 0.f, 0.f, 0.f};
    }
#define SAo(b, h) (((b) * 2 + (h)) * 16384)
#define SBo(b, h) ((4 + (b) * 2 + (h)) * 16384)
#define STAGE_A(b, h, kt) do { const char* g_ = (const char*)Ab + (h) * ahalf + (size_t)(kt) * 128; _Pragma("unroll") for (int i_ = 0; i_ < 2; ++i_) \
        __builtin_amdgcn_global_load_lds((const unsigned*)(g_ + voA[i_]), (LAS unsigned*)(lds + SAo(b, h) + ldsw + i_ * 8192), 16, 0, 0); } while (0)
#define STAGE_B(b, h, kt) do { const char* g_ = (const char*)Bb + (h) * bhalf + (size_t)(kt) * 128; _Pragma("unroll") for (int i_ = 0; i_ < 2; ++i_) \
        __builtin_amdgcn_global_load_lds((const unsigned*)(g_ + voB[i_]), (LAS unsigned*)(lds + SBo(b, h) + ldsw + i_ * 8192), 16, 0, 0); } while (0)
#define LDA(dst, b, h) _Pragma("unroll") for (int m_ = 0; m_ < 4; ++m_) _Pragma("unroll") for (int k_ = 0; k_ < 2; ++k_) \
        dst[m_][k_] = *(const LAS bf16x8*)(lds + SAo(b, h) + aoff + m_ * 2048 + k_ * 1024)
#define LDB(dst, b, h) _Pragma("unroll") for (int n_ = 0; n_ < 2; ++n_) _Pragma("unroll") for (int k_ = 0; k_ < 2; ++k_) \
        dst[n_][k_] = *(const LAS bf16x8*)(lds + SBo(b, h) + boff + n_ * 2048 + k_ * 1024)
#define MMA(ai, bj, A_, B_) do { __builtin_amdgcn_s_setprio(1); \
        _Pragma("unroll") for (int m_ = 0; m_ < 4; ++m_) _Pragma("unroll") for (int n_ = 0; n_ < 2; ++n_) _Pragma("unroll") for (int k_ = 0; k_ < 2; ++k_) \
            acc[(ai) * 4 + m_][(bj) * 2 + n_] = MFMA16(B_[n_][k_], A_[m_][k_], acc[(ai) * 4 + m_][(bj) * 2 + n_]); \
        __builtin_amdgcn_s_setprio(0); } while (0)
#define WAIT_V(n) asm volatile("s_waitcnt vmcnt(" #n ")" ::: "memory")
#define WAIT_L(n) asm volatile("s_waitcnt lgkmcnt(" #n ")" ::: "memory")
#define BAR __builtin_amdgcn_s_barrier()
#define SCHED __builtin_amdgcn_sched_barrier(0)
    bf16x8 At[4][2], B0[2][2], B1[2][2];
    const int nt = K >> 6;
    __syncthreads();
    STAGE_B(0, 0, 0); STAGE_A(0, 0, 0); STAGE_B(0, 1, 0); STAGE_A(0, 1, 0);
    if (wr == 1) BAR;
    WAIT_V(4); BAR;
    STAGE_B(1, 0, 1); STAGE_A(1, 0, 1); STAGE_B(1, 1, 1);
    WAIT_V(6); BAR;
    for (int t = 0; t < nt - 2; t += 2) {
        LDB(B0, 0, 0); SCHED; LDA(At, 0, 0); STAGE_A(1, 1, t + 1);
        WAIT_L(8); BAR; WAIT_L(0); MMA(0, 0, At, B0); BAR; SCHED;
        LDB(B1, 0, 1); STAGE_B(0, 0, t + 2);
        BAR; WAIT_L(0); MMA(0, 1, At, B1); BAR;
        LDA(At, 0, 1); STAGE_A(0, 0, t + 2);
        BAR; WAIT_L(0); MMA(1, 0, At, B0); BAR; SCHED;
        STAGE_B(0, 1, t + 2);
        WAIT_V(6); BAR; MMA(1, 1, At, B1); BAR;
        LDB(B0, 1, 0); SCHED; LDA(At, 1, 0); STAGE_A(0, 1, t + 2);
        WAIT_L(8); BAR; WAIT_L(0); MMA(0, 0, At, B0); BAR; SCHED;
        LDB(B1, 1, 1); STAGE_B(1, 0, t + 3);
        BAR; WAIT_L(0); MMA(0, 1, At, B1); BAR;
        LDA(At, 1, 1); STAGE_A(1, 0, t + 3);
        BAR; WAIT_L(0); MMA(1, 0, At, B0); BAR; SCHED;
        STAGE_B(1, 1, t + 3);
        WAIT_V(6); BAR; MMA(1, 1, At, B1); BAR;
    }
    { LDB(B0, 0, 0); LDA(At, 0, 0); STAGE_A(1, 1, nt - 1);
      BAR; WAIT_L(0); MMA(0, 0, At, B0); BAR;
      LDB(B1, 0, 1); BAR; WAIT_L(0); MMA(0, 1, At, B1); BAR;
      LDA(At, 0, 1); WAIT_V(4); BAR; WAIT_L(0); MMA(1, 0, At, B0); MMA(1, 1, At, B1); BAR; }
    { LDB(B0, 1, 0); LDA(At, 1, 0); WAIT_V(2); BAR; WAIT_L(0); MMA(0, 0, At, B0); BAR;
      LDB(B1, 1, 1); WAIT_V(0); BAR; WAIT_L(0); MMA(0, 1, At, B1); BAR;
      LDA(At, 1, 1); BAR; WAIT_L(0); MMA(1, 0, At, B0); MMA(1, 1, At, B1); BAR; }
    if (wr == 0) BAR;
#undef SAo
#undef SBo
#undef STAGE_A
#undef STAGE_B
#undef LDA
#undef LDB
#undef MMA
#undef WAIT_V
#undef WAIT_L
#undef BAR
#undef SCHED
}
#define OPAQUE_WS(name) char* name = get_kp()->ws
#define EPI_IDS int tid_ = threadIdx.x; asm volatile("" : "+v"(tid_)); const int wid_ = tid_ >> 6, lane_ = tid_ & 63, wr_ = wid_ >> 2, wc_ = wid_ & 3, fr_ = lane_ & 15, fq_ = lane_ >> 4

__device__ __forceinline__ void tile_map(int L, int nM, int nN, int& pm, int& pn) {
    const int nwg = nM * nN; int wgid = L;
    { const int q = nwg / 8, r = nwg % 8, xcd = wgid % 8, off = wgid / 8; wgid = (xcd < r ? xcd * (q + 1) : r * (q + 1) + (xcd - r) * q) + off; }
    const int nig = 8 * nN, gid = wgid / nig, fm = gid * 8, gsz = (nM - fm) < 8 ? (nM - fm) : 8;
    pm = fm + ((wgid % nig) % gsz); pn = (wgid % nig) / gsz;
}

__device__ __forceinline__ void store8bf(bf16_t* p, f32x4 v0, f32x4 v1) { u32x4 o; o.x = pk2(v0[0], v0[1]); o.y = pk2(v0[2], v0[3]); o.z = pk2(v1[0], v1[1]); o.w = pk2(v1[2], v1[3]); *(u32x4*)p = o; }
__device__ __forceinline__ void load8bf(const bf16_t* p, f32x4& v0, f32x4& v1) { const u32x4 w = *(const u32x4*)p; v0[0] = blo(w.x); v0[1] = bhi(w.x); v0[2] = blo(w.y); v0[3] = bhi(w.y); v1[0] = blo(w.z); v1[1] = bhi(w.z); v1[2] = blo(w.w); v1[3] = bhi(w.w); }
__device__ __forceinline__ f32x4 silu4(f32x4 v) { f32x4 o; for (int j = 0; j < 4; ++j) o[j] = v[j] * sigmoidf_(v[j]); return o; }
__device__ __forceinline__ f32x4 sigm4(f32x4 v) { f32x4 o; for (int j = 0; j < 4; ++j) o[j] = sigmoidf_(v[j]); return o; }
__device__ __forceinline__ float sq4(f32x4 v) { return v[0] * v[0] + v[1] * v[1] + v[2] * v[2] + v[3] * v[3]; }

struct EpiProj {
    bf16_t* proj; bf16_t* krope; float* rsq; const float *cosr, *sinr, *cosm, *sinm; int brow, bcol;
    __device__ __forceinline__ void operator()(f32x4 (&acc)[8][4], int wr, int wc, int fr, int fq) const {
        const int c0 = bcol + wc * 64;
        int type;
        if (bcol < 1024) type = 0; else if (bcol < 2048) type = 1; else if (bcol < 3072) type = 2; else if (bcol < 4096) type = 3;
        else if (bcol < 5120) type = 2; else if (bcol < 6144) type = 3; else if (bcol < 7168) type = 4; else if (bcol < 8192) type = 3;
        else if (bcol < 14336) type = 5; else type = 6;
#pragma unroll
        for (int m = 0; m < 8; ++m) {
            const int t = brow + ROWOFF(wr, m) + fr;
            bf16_t* rowp = proj + (size_t)t * LDP + c0 + 8 * fq;
            if (type == 0 || type == 1) {
                const int blk = (c0 >> 6) & 1; const float sc = type == 0 ? RQSCALE : 1.0f;
                f32x4 o1[2], o2[2];
#pragma unroll
                for (int n = 0; n < 2; ++n) {
                    const int f0 = 32 * blk + 8 * fq + 4 * n;
                    const f32x4 cs = *(const f32x4*)(cosr + (size_t)t * 64 + f0), sn = *(const f32x4*)(sinr + (size_t)t * 64 + f0);
                    const f32x4 x1 = acc[m][n], x2 = acc[m][n + 2];
                    o1[n] = (x1 * cs - x2 * sn) * sc; o2[n] = (x2 * cs + x1 * sn) * sc;
                }
                store8bf(rowp, o1[0], o1[1]); store8bf(rowp + 32, o2[0], o2[1]);
            } else if (type == 2) {
                store8bf(rowp, acc[m][0], acc[m][1]); store8bf(rowp + 32, acc[m][2], acc[m][3]);
            } else if (type == 3) {
                store8bf(rowp, silu4(acc[m][0]), silu4(acc[m][1])); store8bf(rowp + 32, silu4(acc[m][2]), silu4(acc[m][3]));
            } else if (type == 4) {
                float s = sq4(acc[m][0]) + sq4(acc[m][1]) + sq4(acc[m][2]) + sq4(acc[m][3]);
                store8bf(rowp, acc[m][0], acc[m][1]); store8bf(rowp + 32, acc[m][2], acc[m][3]);
                { const int ln_ = fq * 16 + fr; s += shx(s, ln_, 16); s += shx(s, ln_, 32); }
                if (fq == 0) rsq[(size_t)t * 16 + ((c0 - 6144) >> 6)] = s;
            } else if (type == 5) {
                store8bf(rowp, sigm4(acc[m][0]), sigm4(acc[m][1])); store8bf(rowp + 32, sigm4(acc[m][2]), sigm4(acc[m][3]));
            } else {
                if (wc == 0) {
                    f32x4 o1[2], o2[2];
#pragma unroll
                    for (int n = 0; n < 2; ++n) {
                        const int f0 = 8 * fq + 4 * n;
                        const f32x4 cs = *(const f32x4*)(cosm + (size_t)t * 32 + f0), sn = *(const f32x4*)(sinm + (size_t)t * 32 + f0);
                        const f32x4 x1 = acc[m][n], x2 = acc[m][n + 2];
                        o1[n] = x1 * cs - x2 * sn; o2[n] = x2 * cs + x1 * sn;
                    }
                    store8bf(krope + (size_t)t * 64 + 8 * fq, o1[0], o1[1]); store8bf(krope + (size_t)t * 64 + 32 + 8 * fq, o2[0], o2[1]);
                }
            }
        }
    }
};

struct EpiQ {
    bf16_t* qm; const float* rsq; const float *cosm, *sinm; int brow, bcol;
    __device__ __forceinline__ void operator()(f32x4 (&acc)[8][4], int wr, int wc, int fr, int fq) const {
        const int c0 = bcol + wc * 64, head = c0 / 192, within = c0 - head * 192;
        float rsv[8];
#pragma unroll
        for (int m = 0; m < 8; ++m) {
            const int t = brow + ROWOFF(wr, m) + fr;
            const f32x4 r0 = *(const f32x4*)(rsq + (size_t)t * 16), r1 = *(const f32x4*)(rsq + (size_t)t * 16 + 4);
            const float ss = r0[0] + r0[1] + r0[2] + r0[3] + r1[0] + r1[1] + r1[2] + r1[3];
            rsv[m] = rsqrtf(ss * (1.0f / 512.0f) + EPS) * QSCALE;
        }
#pragma unroll
        for (int m = 0; m < 8; ++m) {
            const int t = brow + ROWOFF(wr, m) + fr, b = t >> 11, s = t & 2047;
            const float rs = rsv[m];
            bf16_t* base = qm + ((size_t)((b * 8 + head) * 2048 + s)) * 192 + within + 8 * fq;
            if (within != 128) {
                store8bf(base, acc[m][0] * rs, acc[m][1] * rs); store8bf(base + 32, acc[m][2] * rs, acc[m][3] * rs);
            } else {
                f32x4 o1[2], o2[2];
#pragma unroll
                for (int n = 0; n < 2; ++n) {
                    const int f0 = 8 * fq + 4 * n;
                    const f32x4 cs = *(const f32x4*)(cosm + (size_t)t * 32 + f0), sn = *(const f32x4*)(sinm + (size_t)t * 32 + f0);
                    const f32x4 x1 = acc[m][n] * rs, x2 = acc[m][n + 2] * rs;
                    o1[n] = x1 * cs - x2 * sn; o2[n] = x2 * cs + x1 * sn;
                }
                store8bf(base, o1[0], o1[1]); store8bf(base + 32, o2[0], o2[1]);
            }
        }
    }
};

struct EpiKV {
    bf16_t* kn; bf16_t* vt; const float* rsq; int brow, head;
    __device__ __forceinline__ void operator()(f32x4 (&acc)[8][4], int wr, int wc, int fr, int fq) const {
        float rsv[8];
#pragma unroll
        for (int m = 0; m < 8; ++m) {
            const int t = brow + ROWOFF(wr, m) + fr;
            const f32x4 r0 = *(const f32x4*)(rsq + (size_t)t * 16 + 8), r1 = *(const f32x4*)(rsq + (size_t)t * 16 + 12);
            const float ss = r0[0] + r0[1] + r0[2] + r0[3] + r1[0] + r1[1] + r1[2] + r1[3];
            rsv[m] = rsqrtf(ss * (1.0f / 512.0f) + EPS);
        }
#pragma unroll
        for (int m = 0; m < 8; ++m) {
            const int t = brow + ROWOFF(wr, m) + fr, b = t >> 11, s = t & 2047;
            const float rs = rsv[m];
            if (wc < 2) {
                bf16_t* base = kn + ((size_t)((b * 8 + head) * 2048 + s)) * 128 + wc * 64 + 8 * fq;
                store8bf(base, acc[m][0] * rs, acc[m][1] * rs); store8bf(base + 32, acc[m][2] * rs, acc[m][3] * rs);
            } else {
#pragma unroll
                for (int n = 0; n < 4; ++n)
#pragma unroll
                    for (int j = 0; j < 4; j += 2) {
                        const int d = (wc - 2) * 64 + (n >> 1) * 32 + 8 * fq + 4 * (n & 1) + j;
                        const unsigned pv_ = pk2(acc[m][n][j] * rs, acc[m][n][j + 1] * rs);
                        vt[((size_t)((b * 8 + head) * 128 + d)) * 2048 + s] = (bf16_t)pv_;
                        vt[((size_t)((b * 8 + head) * 128 + d + 1)) * 2048 + s] = (bf16_t)(pv_ >> 16);
                    }
            }
        }
    }
};

struct EpiBranch {
    const bf16_t* gates; bf16_t* merged; int mode, brow, bcol;
    __device__ __forceinline__ void operator()(f32x4 (&acc)[8][4], int wr, int wc, int fr, int fq) const {
        const int col0 = bcol + wc * 64 + 8 * fq;
        const size_t t0 = (size_t)(brow + fr);
#pragma unroll
        for (int m = 0; m < 8; ++m) {
            const size_t t = t0 + ROWOFF(wr, m);
#pragma unroll
            for (int bj = 0; bj < 2; ++bj) {
                const bf16_t* gp = gates + t * LDP + col0 + bj * 32 + mode * 2048;
                f32x4 g0, g1; load8bf(gp, g0, g1);
                if (mode != 2) {
                    f32x4 h0, h1; load8bf(gp + 2048, h0, h1);
#pragma unroll
                    for (int j = 0; j < 4; ++j) {
                        acc[m][2 * bj][j] *= g0[j] * __builtin_amdgcn_rcpf(fmaxf(h0[j], 1e-30f));
                        acc[m][2 * bj + 1][j] *= g1[j] * __builtin_amdgcn_rcpf(fmaxf(h1[j], 1e-30f));
                    }
                } else {
                    store8bf(merged + t * D + col0 + bj * 32, acc[m][2 * bj] * g0, acc[m][2 * bj + 1] * g1);
                }
            }
        }
    }
};

struct EpiOut {
    bf16_t* y; int brow, bcol;
    __device__ __forceinline__ void operator()(f32x4 (&acc)[8][4], int wr, int wc, int fr, int fq) const {
#pragma unroll
        for (int m = 0; m < 8; ++m) {
            const int t = brow + ROWOFF(wr, m) + fr;
            bf16_t* yp = y + (size_t)t * D + bcol + wc * 64 + 8 * fq;
            store8bf(yp, acc[m][0], acc[m][1]); store8bf(yp + 32, acc[m][2], acc[m][3]);
        }
    }
};

__device__ __forceinline__ int win_map(int np) {
    if (np < 2048) { const int base = np & ~127, p = np & 127, blk = p >> 6, half = (p >> 5) & 1, r = p & 31; return base + 32 * blk + 64 * half + r; }
    if (np < 7168) return np;
    if (np < 14336) return np + 64;
    if (np < 14400) return 7168 + (np - 14336);
    return -1;
}

struct ConvArgs { const float* src; const float* gain; bf16_t* dst; int ld, Kt, k0, np0, wmap; };
__device__ __forceinline__ ConvArgs conv_decode(KP p, int ci) {
    char* ws = p->ws;
    constexpr int NCONV_L = 1824 + 48 + 64 + 384 + 256 + 8 + 8;
    ConvArgs a; const int l = ci / NCONV_L; ci -= l * NCONV_L; a.gain = nullptr; a.wmap = 0;
    if (ci < 1824) { const int nt = ci % 114, kt = ci / 114; a.src = p->in[7] + (size_t)l * 2048 * NIN; a.ld = NIN; a.Kt = 2048; a.k0 = kt * 128; a.np0 = nt * 128; a.wmap = 1; a.dst = (bf16_t*)(ws + WS_WI) + (size_t)l * NP1 * 2048; }
    else if ((ci -= 1824) < 48) { const int nt = ci % 12, kt = ci / 12; a.src = p->in[17] + (size_t)l * 512 * 1536; a.ld = 1536; a.Kt = 512; a.k0 = kt * 128; a.np0 = nt * 128; a.gain = p->in[16] + l * 512; a.dst = (bf16_t*)(ws + WS_WUQ) + (size_t)l * 1536 * 512; }
    else if ((ci -= 48) < 64) { const int nt = ci % 16, kt = ci / 16; a.src = p->in[19] + (size_t)l * 512 * 2048; a.ld = 2048; a.Kt = 512; a.k0 = kt * 128; a.np0 = nt * 128; a.gain = p->in[18] + l * 512; a.dst = (bf16_t*)(ws + WS_WUKV) + (size_t)l * 2048 * 512; }
    else if ((ci -= 64) < 384) { const int nt = ci % 16, kt = ci / 16; a.src = p->in[20] + (size_t)l * 3072 * 2048; a.ld = 2048; a.Kt = 3072; a.k0 = kt * 128; a.np0 = nt * 128; a.dst = (bf16_t*)(ws + WS_WB) + (size_t)l * 2048 * 3072; }
    else if ((ci -= 384) < 256) { const int nt = ci % 16, kt = ci / 16; a.src = p->in[21] + (size_t)l * 2048 * 2048; a.ld = 2048; a.Kt = 2048; a.k0 = kt * 128; a.np0 = nt * 128; a.dst = (bf16_t*)(ws + WS_WO) + (size_t)l * 2048 * 2048; }
    else if ((ci -= 256) < 8) { a.src = p->in[11] + (size_t)(l * 8 + ci) * 16384; a.ld = 128; a.Kt = 128; a.k0 = 0; a.np0 = 0; a.dst = (bf16_t*)(ws + WS_WA) + (size_t)(l * 8 + ci) * 16384; }
    else { ci -= 8; a.src = p->in[13] + (size_t)(l * 8 + ci) * 16384; a.ld = 128; a.Kt = 128; a.k0 = 0; a.np0 = 0; a.dst = (bf16_t*)(ws + WS_WX) + (size_t)(l * 8 + ci) * 16384; }
    return a;
}
__device__ __forceinline__ void conv_load(const ConvArgs& c, int tid, f32x4 (&a)[4], f32x4 (&b)[4]) {
    const int c8 = (tid & 15) * 8, np = c.np0 + c8;
    const int n = c.wmap ? win_map(np) : np;
#pragma unroll
    for (int r = 0; r < 4; ++r) {
        const int kl = (tid >> 4) + 32 * r;
        a[r] = (f32x4){0.f, 0.f, 0.f, 0.f}; b[r] = a[r];
        if (n >= 0) { const float* sp = c.src + (size_t)(c.k0 + kl) * c.ld + n; a[r] = __builtin_nontemporal_load((const f32x4*)sp); b[r] = __builtin_nontemporal_load((const f32x4*)(sp + 4)); }
    }
}
__device__ __forceinline__ void conv_finish(LAS char* lds, const ConvArgs& c, int tid, const f32x4 (&a)[4], const f32x4 (&b)[4]) {
    LAS bf16_t* tl = (LAS bf16_t*)lds;
    const int c8 = (tid & 15) * 8;
    __syncthreads();
#pragma unroll
    for (int r = 0; r < 4; ++r) {
        const int kl = (tid >> 4) + 32 * r;
        const float g = c.gain ? c.gain[c.k0 + kl] : 1.0f;
#pragma unroll
        for (int e = 0; e < 4; e += 2) {
            const unsigned pa_ = pk2(a[r][e] * g, a[r][e + 1] * g), pb_ = pk2(b[r][e] * g, b[r][e + 1] * g);
            tl[(c8 + e) * 130 + kl] = (bf16_t)pa_; tl[(c8 + e + 1) * 130 + kl] = (bf16_t)(pa_ >> 16);
            tl[(c8 + 4 + e) * 130 + kl] = (bf16_t)pb_; tl[(c8 + 5 + e) * 130 + kl] = (bf16_t)(pb_ >> 16);
        }
    }
    __syncthreads();
#pragma unroll
    for (int r = 0; r < 4; ++r) {
        const int nl = (tid >> 4) + 32 * r, kc = (tid & 15) * 8;
        const LAS unsigned* rp = (const LAS unsigned*)(tl + nl * 130 + kc);
        u32x4 o; o.x = rp[0]; o.y = rp[1]; o.z = rp[2]; o.w = rp[3];
        *(u32x4*)(c.dst + (size_t)(c.np0 + nl) * c.Kt + c.k0 + kc) = o;
    }
}

__device__ __forceinline__ void conv4(LAS char* lds, KP p, int base) {
    int tid = threadIdx.x; asm volatile("" : "+v"(tid));
    f32x4 a0[4], b0[4], a1[4], b1[4];
    ConvArgs c0 = conv_decode(p, base), c1 = conv_decode(p, base + 1);
    conv_load(c0, tid, a0, b0); conv_load(c1, tid, a1, b1);
    conv_finish(lds, c0, tid, a0, b0);
    c0 = conv_decode(p, base + 2); conv_load(c0, tid, a0, b0);
    conv_finish(lds, c1, tid, a1, b1);
    c1 = conv_decode(p, base + 3); conv_load(c1, tid, a1, b1);
    conv_finish(lds, c0, tid, a0, b0);
    conv_finish(lds, c1, tid, a1, b1);
}

__device__ void phase0(LAS char* lds, KP p) {
    char* ws = p->ws;
    int tid = threadIdx.x; asm volatile("" : "+v"(tid)); const int wid = tid >> 6, lane = tid & 63;
    constexpr int NCONV_L = 1824 + 48 + 64 + 384 + 256 + 8 + 8;
    constexpr int N_ADA = 384, N_ROPE = 128, N_ITEMS = N_ADA + N_ROPE;
    for (int it = blockIdx.x; it < N_ITEMS; it += gridDim.x) {
        if (it < N_ADA) {
            const int l = it / 96, j0 = (it % 96) * 64;
            LAS float* cact = (LAS float*)lds;
            LAS float* red = (LAS float*)(lds + 32768);
            __syncthreads();
            for (int i = tid; i < 8192; i += 512) { const float v = p->in[1][i]; cact[i] = v * sigmoidf_(v); }
            __syncthreads();
            const int cg = lane & 15, kq = lane >> 4;
            const float* wp = p->in[3] + (size_t)l * 2048 * 6144 + j0 + 4 * cg;
            f32x4 a0 = (f32x4){0.f, 0.f, 0.f, 0.f}, a1 = a0, a2 = a0, a3 = a0;
#pragma unroll 16
            for (int j = 0; j < 64; ++j) {
                const int k = wid * 256 + 4 * j + kq;
                const f32x4 w = *(const f32x4*)(wp + (size_t)k * 6144);
                a0 += w * cact[k]; a1 += w * cact[2048 + k]; a2 += w * cact[4096 + k]; a3 += w * cact[6144 + k];
            }
#pragma unroll
            for (int e = 0; e < 4; ++e) {
                a0[e] += shx(a0[e], lane, 16); a0[e] += shx(a0[e], lane, 32); a1[e] += shx(a1[e], lane, 16); a1[e] += shx(a1[e], lane, 32);
                a2[e] += shx(a2[e], lane, 16); a2[e] += shx(a2[e], lane, 32); a3[e] += shx(a3[e], lane, 16); a3[e] += shx(a3[e], lane, 32);
            }
            if (kq == 0) {
                *(LAS f32x4*)(red + (wid * 4 + 0) * 64 + 4 * cg) = a0; *(LAS f32x4*)(red + (wid * 4 + 1) * 64 + 4 * cg) = a1;
                *(LAS f32x4*)(red + (wid * 4 + 2) * 64 + 4 * cg) = a2; *(LAS f32x4*)(red + (wid * 4 + 3) * 64 + 4 * cg) = a3;
            }
            __syncthreads();
            if (tid < 256) {
                const int b = tid >> 6, jl = tid & 63; float s = 0.f;
#pragma unroll
                for (int w = 0; w < 8; ++w) s += red[(w * 4 + b) * 64 + jl];
                ((float*)(ws + WS_MOD))[(size_t)(l * 4 + b) * 6144 + j0 + jl] = s + p->in[4][(size_t)l * 6144 + j0 + jl];
            }
        } else if (it < N_ADA + N_ROPE) {
            const int t0 = (it - N_ADA) * 64;
            for (int e = tid; e < 64 * 96; e += 512) {
                const int tl = e / 96, f = e % 96, t = t0 + tl;
                const float pos = (float)p->pos[t];
                float invf; if (f < 64) invf = exp2f(-(float)(2 * f) * (1.0f / 128.0f) * 13.287712379549449f); else invf = exp2f(-(float)(2 * (f - 64)) * (1.0f / 64.0f) * 13.287712379549449f);
                const float ang = pos * invf;
                double rev = (double)ang * 0.15915494309189535; rev -= rint(rev);
                const float rv = (float)rev;
                const float sn = __builtin_amdgcn_sinf(rv), cs = __builtin_amdgcn_cosf(rv);
                if (f < 64) { ((float*)(ws + WS_COSR))[(size_t)t * 64 + f] = cs; ((float*)(ws + WS_SINR))[(size_t)t * 64 + f] = sn; }
                else { ((float*)(ws + WS_COSM))[(size_t)t * 32 + f - 64] = cs; ((float*)(ws + WS_SINM))[(size_t)t * 32 + f - 64] = sn; }
            }
        }
    }
    {
        constexpr int NCONV = NCONV_L;
        int ci = blockIdx.x;
        f32x4 a0[4], b0[4], a1[4], b1[4];
        ConvArgs c0 = conv_decode(p, ci < NCONV ? ci : 0), c1 = c0;
        if (ci < NCONV) conv_load(c0, tid, a0, b0);
        while (ci < NCONV) {
            const int cn = ci + gridDim.x, cnn = cn + gridDim.x;
            if (cn < NCONV) { c1 = conv_decode(p, cn); conv_load(c1, tid, a1, b1); }
            conv_finish(lds, c0, tid, a0, b0);
            if (cn >= NCONV) break;
            if (cnn < NCONV) { c0 = conv_decode(p, cnn); conv_load(c0, tid, a0, b0); }
            conv_finish(lds, c1, tid, a1, b1);
            ci = cnn;
        }
    }
}

__device__ __forceinline__ float wave_sum(float v, int lane) {
    v = row16_sum(v); v += shx(v, lane, 16); v += shx(v, lane, 32); return v;
}
__device__ void rowpass(KP p, int l  ) {
    char* ws = p->ws;
    int tid = threadIdx.x; asm volatile("" : "+v"(tid));
    const int lane = tid & 63, gw = blockIdx.x * 8 + (tid >> 6), nw = gridDim.x * 8;
    const float* mod = (const float*)(ws + WS_MOD);
    float* xcur = (float*)(ws + WS_XCUR);
    const bf16_t* ybuf = (const bf16_t*)(ws + WS_YBUF);
    bf16_t* hbuf = (bf16_t*)(ws + WS_HBUF);
    for (int g4 = gw; g4 < T / 4; g4 += nw) {
        const int r0 = g4 * 4, b = r0 >> 11;
        f32x4 pa[8], pb[8], pc[8];
        if (l >= 0) {
#pragma unroll
            for (int i = 0; i < 8; ++i) {
                const int c = i * 256 + lane * 4;
                pa[i] = (*(const f32x4*)(mod + (size_t)(l * 4 + b) * 6144 + 4096 + c) + 1.0f) * *(const f32x4*)(p->in[6] + (size_t)l * D + c);
            }
        }
        if (l < DEPTH - 1) {
            const int ln = l + 1;
#pragma unroll
            for (int i = 0; i < 8; ++i) {
                const int c = i * 256 + lane * 4;
                pb[i] = (*(const f32x4*)(mod + (size_t)(ln * 4 + b) * 6144 + 2048 + c) + 1.0f) * *(const f32x4*)(p->in[5] + (size_t)ln * D + c);
                pc[i] = *(const f32x4*)(mod + (size_t)(ln * 4 + b) * 6144 + c);
            }
        }
        const float* xprev = (l <= 0) ? p->in[0] : xcur;
        float* dst = (l == DEPTH - 1) ? p->out : xcur;
#pragma unroll 1
        for (int rr = 0; rr < 4; ++rr) {
            const int row = r0 + rr;
            f32x4 xv[8], yv[8];
#pragma unroll
            for (int i = 0; i < 8; ++i) {
                xv[i] = *(const f32x4*)(xprev + (size_t)row * D + i * 256 + lane * 4);
                if (l >= 0) yv[i] = load4bf(ybuf + (size_t)row * D + i * 256 + lane * 4);
            }
            if (l >= 0) {
                float ss = 0.f;
#pragma unroll
                for (int i = 0; i < 8; ++i) ss += yv[i][0] * yv[i][0] + yv[i][1] * yv[i][1] + yv[i][2] * yv[i][2] + yv[i][3] * yv[i][3];
                ss = wave_sum(ss, lane);
                const float rs = rsqrtf(ss * (1.0f / D) + EPS);
#pragma unroll
                for (int i = 0; i < 8; ++i) {
                    xv[i] = xv[i] + pa[i] * (yv[i] * rs);
                    *(f32x4*)(dst + (size_t)row * D + i * 256 + lane * 4) = xv[i];
                }
            }
            if (l < DEPTH - 1) {
                float ss = 0.f;
#pragma unroll
                for (int i = 0; i < 8; ++i) ss += xv[i][0] * xv[i][0] + xv[i][1] * xv[i][1] + xv[i][2] * xv[i][2] + xv[i][3] * xv[i][3];
                ss = wave_sum(ss, lane);
                const float rs = rsqrtf(ss * (1.0f / D) + EPS);
#pragma unroll
                for (int i = 0; i < 8; ++i) store4bf(hbuf + (size_t)row * D + i * 256 + lane * 4, xv[i] * rs * pb[i] + pc[i]);
            }
        }
    }
}

__device__ __forceinline__ int tix(int row, int col) { return row * 72 + (col ^ (((row >> 3) & 3) << 4)); }
template <bool OUT>
__device__ void ret_item(LAS char* lds, KP p, int l, int item) {
    char* ws = p->ws;
    int tid = threadIdx.x; asm volatile("" : "+v"(tid)); const int wid = tid >> 6, lane = tid & 63, fr = lane & 15, fq = lane >> 4;
    const int g = item & 7, h = (item >> 3) & 7, b = item >> 6;
    LAS bf16_t* Qs = (LAS bf16_t*)(lds);
    LAS bf16_t* Ks = (LAS bf16_t*)(lds + 17408);
    LAS bf16_t* Kt = (LAS bf16_t*)(lds + 34816);
    LAS bf16_t* Vt = (LAS bf16_t*)(lds + 53248);
    LAS bf16_t* St = (LAS bf16_t*)(lds + 71680);
    LAS bf16_t* Ps = (LAS bf16_t*)(lds + 106496);
    LAS float* Os = (LAS float*)(lds);
    const bf16_t* proj = (const bf16_t*)(ws + WS_PROJ);
    float* tot = (float*)(ws + WS_TOT);
    const float gy = __builtin_amdgcn_exp2f(-5.0f - (float)h);
    const float lg2 = -gy * (1.0f + gy * (0.5f + gy * (0.33333334f + gy * (0.25f + gy * 0.2f)))) * 1.4426950408889634f;
    const float d64 = __builtin_amdgcn_exp2f(lg2 * 64.0f), d256 = __builtin_amdgcn_exp2f(lg2 * 256.0f);
    f32x4 sacc[8];
#pragma unroll
    for (int nf = 0; nf < 8; ++nf) sacc[nf] = (f32x4){0.f, 0.f, 0.f, 0.f};
    if (OUT) {
        float w = 1.0f;
        for (int gp = g - 1; gp >= 0; --gp) {
            const float* tp = tot + (size_t)((b * 8 + h) * 8 + gp) * 16384;
            float tv[8][4];
#pragma unroll
            for (int nf = 0; nf < 8; ++nf)
#pragma unroll
                for (int j = 0; j < 4; ++j) tv[nf][j] = tp[(16 * wid + 4 * fq + j) * 128 + 16 * nf + fr];
#pragma unroll
            for (int nf = 0; nf < 8; ++nf)
#pragma unroll
                for (int j = 0; j < 4; ++j) sacc[nf][j] += w * tv[nf][j];
            w *= d256;
        }
    }
    int li[2], lc[2];
#pragma unroll
    for (int r = 0; r < 2; ++r) { const int wt = wid + 8 * r; li[r] = 16 * (wt & 3) + (lane & 15); lc[r] = 8 * (4 * (wt >> 2) + (lane >> 4)); }
    if (!OUT) {
        LAS bf16_t* Kt2 = (LAS bf16_t*)(lds);
        LAS bf16_t* Vt2 = (LAS bf16_t*)(lds + 71680);
        u32x4 pk_[2][2], pv_[2][2];
#define RET_LOAD2(n_) do { _Pragma("unroll") for (int cc = 0; cc < 2; ++cc) { const int t0_ = b * 2048 + ((n_) + cc) * 64; _Pragma("unroll") for (int r = 0; r < 2; ++r) { \
            const bf16_t* rowp = proj + (size_t)(t0_ + li[r]) * LDP + h * 128 + lc[r]; \
            pk_[cc][r] = *(const u32x4*)(rowp + 1024); pv_[cc][r] = *(const u32x4*)(rowp + 2048); } } } while (0)
        RET_LOAD2(g * 4);
        for (int cp = 0; cp < 2; ++cp) {
            __syncthreads();
#pragma unroll
            for (int cc = 0; cc < 2; ++cc) {
                LAS bf16_t* Kd = cc ? Kt2 : Kt; LAS bf16_t* Vd = cc ? Vt2 : Vt;
#pragma unroll
                for (int r = 0; r < 2; ++r) {
                    const int i = li[r], c8 = lc[r];
                    const float dec = __builtin_amdgcn_exp2f(lg2 * (float)(63 - i));
#pragma unroll
                    for (int e = 0; e < 4; ++e) {
                        Kd[tix(c8 + 2 * e, i)] = f2bf(blo(pk_[cc][r][e]) * dec); Kd[tix(c8 + 2 * e + 1, i)] = f2bf(bhi(pk_[cc][r][e]) * dec);
                        Vd[tix(c8 + 2 * e, i)] = (bf16_t)(pv_[cc][r][e] & 0xffffu); Vd[tix(c8 + 2 * e + 1, i)] = (bf16_t)(pv_[cc][r][e] >> 16);
                    }
                }
            }
            if (cp == 0) RET_LOAD2(g * 4 + 2);
            __syncthreads();
#pragma unroll
            for (int cc = 0; cc < 2; ++cc) {
                const LAS bf16_t* Ks_ = cc ? Kt2 : Kt; const LAS bf16_t* Vs_ = cc ? Vt2 : Vt;
#pragma unroll
                for (int nf = 0; nf < 8; ++nf) sacc[nf] *= d64;
                __builtin_amdgcn_sched_barrier(0);
                {
                    bf16x8 va[2], kb[2][8];
#pragma unroll
                    for (int kk = 0; kk < 2; ++kk) {
                        va[kk] = *(const LAS bf16x8*)(Vs_ + tix(16 * wid + fr, kk * 32 + fq * 8));
#pragma unroll
                        for (int nf = 0; nf < 8; ++nf) kb[kk][nf] = *(const LAS bf16x8*)(Ks_ + tix(16 * nf + fr, kk * 32 + fq * 8));
                    }
#pragma unroll
                    for (int kk = 0; kk < 2; ++kk)
#pragma unroll
                        for (int nf = 0; nf < 8; ++nf) sacc[nf] = MFMA16(va[kk], kb[kk][nf], sacc[nf]);
                    __builtin_amdgcn_sched_group_barrier(0x100, 18, 0); __builtin_amdgcn_sched_group_barrier(0x008, 16, 0);
                }
                __builtin_amdgcn_sched_barrier(0);
            }
        }
#undef RET_LOAD2
        float* tp = tot + (size_t)item * 16384;
#pragma unroll
        for (int nf = 0; nf < 8; ++nf)
#pragma unroll
            for (int j = 0; j < 4; ++j) tp[(16 * wid + 4 * fq + j) * 128 + 16 * nf + fr] = sacc[nf][j];
        return;
    }
    u32x4 gq[2], gk[2], gv[2];
#define RET_LOAD(n_) do { const int t0_ = b * 2048 + (n_) * 64; _Pragma("unroll") for (int r = 0; r < 2; ++r) { \
        const bf16_t* rowp = proj + (size_t)(t0_ + li[r]) * LDP + h * 128 + lc[r]; \
        gk[r] = *(const u32x4*)(rowp + 1024); gv[r] = *(const u32x4*)(rowp + 2048); if (OUT) gq[r] = *(const u32x4*)(rowp); } } while (0)
    RET_LOAD(g * 4);
    const int ni = tid >> 3, npart = tid & 7, ncol = h * 128 + npart * 16;
    f32x4 gv4[4]; u32x4 sgp[2];
    if (OUT) {
#pragma unroll
        for (int e = 0; e < 4; ++e) gv4[e] = *(const f32x4*)(p->in[8] + (size_t)l * 1024 + ncol + e * 4);
    }
    for (int c = 0; c < 4; ++c) {
        const int n = g * 4 + c, t0 = b * 2048 + n * 64;
        if (OUT) { const bf16_t* gp_ = proj + (size_t)(t0 + ni) * LDP + 3072 + ncol; sgp[0] = *(const u32x4*)gp_; sgp[1] = *(const u32x4*)(gp_ + 8); }
        __syncthreads();
#pragma unroll
        for (int r = 0; r < 2; ++r) {
            const int i = li[r], c8 = lc[r];
            if (OUT) { *(LAS u32x4*)(Qs + i * 136 + c8) = gq[r]; *(LAS u32x4*)(Ks + i * 136 + c8) = gk[r]; }
            const float dec = __builtin_amdgcn_exp2f(lg2 * (float)(63 - i));
#pragma unroll
            for (int e = 0; e < 4; ++e) {
                Kt[tix(c8 + 2 * e, i)] = f2bf(blo(gk[r][e]) * dec); Kt[tix(c8 + 2 * e + 1, i)] = f2bf(bhi(gk[r][e]) * dec);
                Vt[tix(c8 + 2 * e, i)] = (bf16_t)(gv[r][e] & 0xffffu); Vt[tix(c8 + 2 * e + 1, i)] = (bf16_t)(gv[r][e] >> 16);
            }
        }
        if (OUT) {
#pragma unroll
            for (int nf = 0; nf < 8; ++nf)
#pragma unroll
                for (int j = 0; j < 4; ++j) St[(16 * wid + 4 * fq + j) * 136 + 16 * nf + fr] = f2bf(sacc[nf][j]);
        }
        if (c + 1 < 4) RET_LOAD(n + 1);
        __syncthreads();
        const int mf = wid & 3, nh = wid >> 2;
        f32x4 o1[4], o2[4];
#pragma unroll
        for (int nf = 0; nf < 4; ++nf) { o1[nf] = (f32x4){0.f, 0.f, 0.f, 0.f}; o2[nf] = (f32x4){0.f, 0.f, 0.f, 0.f}; }
        if (OUT) {
            f32x4 s2[2] = {(f32x4){0.f, 0.f, 0.f, 0.f}, (f32x4){0.f, 0.f, 0.f, 0.f}};
            {
                bf16x8 fa[4], fb0[4], fb1[4];
#pragma unroll
                for (int kk = 0; kk < 4; ++kk) {
                    fa[kk] = *(const LAS bf16x8*)(Qs + (16 * mf + fr) * 136 + kk * 32 + fq * 8);
                    fb0[kk] = *(const LAS bf16x8*)(Ks + (32 * nh + fr) * 136 + kk * 32 + fq * 8);
                    fb1[kk] = *(const LAS bf16x8*)(Ks + (32 * nh + 16 + fr) * 136 + kk * 32 + fq * 8);
                }
#pragma unroll
                for (int kk = 0; kk < 4; ++kk) { s2[0] = MFMA16(fa[kk], fb0[kk], s2[0]); s2[1] = MFMA16(fa[kk], fb1[kk], s2[1]); }
                __builtin_amdgcn_sched_group_barrier(0x100, 12, 0); __builtin_amdgcn_sched_group_barrier(0x008, 8, 0);
            }
            __builtin_amdgcn_sched_barrier(0);
#pragma unroll
            for (int nf = 0; nf < 2; ++nf)
#pragma unroll
                for (int j = 0; j < 4; ++j) {
                    const int i = 16 * mf + 4 * fq + j, jj = 32 * nh + 16 * nf + fr;
                    Ps[i * 72 + jj] = f2bf(s2[nf][j] * __builtin_amdgcn_exp2f(lg2 * fabsf((float)(i - jj))));
                }
            __builtin_amdgcn_sched_barrier(0);
            {
                bf16x8 qa[4], sb[4][4];
#pragma unroll
                for (int kk = 0; kk < 4; ++kk) {
                    qa[kk] = *(const LAS bf16x8*)(Qs + (16 * mf + fr) * 136 + kk * 32 + fq * 8);
#pragma unroll
                    for (int nf = 0; nf < 4; ++nf) sb[kk][nf] = *(const LAS bf16x8*)(St + (64 * nh + 16 * nf + fr) * 136 + kk * 32 + fq * 8);
                }
#pragma unroll
                for (int kk = 0; kk < 4; ++kk)
#pragma unroll
                    for (int nf = 0; nf < 4; ++nf) o2[nf] = MFMA16(qa[kk], sb[kk][nf], o2[nf]);
                __builtin_amdgcn_sched_group_barrier(0x100, 20, 0); __builtin_amdgcn_sched_group_barrier(0x008, 16, 0);
            }
            __builtin_amdgcn_sched_barrier(0);
        }
#pragma unroll
        for (int nf = 0; nf < 8; ++nf) sacc[nf] *= d64;
        __builtin_amdgcn_sched_barrier(0);
        {
            bf16x8 va[2], kb[2][8];
#pragma unroll
            for (int kk = 0; kk < 2; ++kk) {
                va[kk] = *(const LAS bf16x8*)(Vt + tix(16 * wid + fr, kk * 32 + fq * 8));
#pragma unroll
                for (int nf = 0; nf < 8; ++nf) kb[kk][nf] = *(const LAS bf16x8*)(Kt + tix(16 * nf + fr, kk * 32 + fq * 8));
            }
#pragma unroll
            for (int kk = 0; kk < 2; ++kk)
#pragma unroll
                for (int nf = 0; nf < 8; ++nf) sacc[nf] = MFMA16(va[kk], kb[kk][nf], sacc[nf]);
            __builtin_amdgcn_sched_group_barrier(0x100, 18, 0); __builtin_amdgcn_sched_group_barrier(0x008, 16, 0);
        }
        __builtin_amdgcn_sched_barrier(0);
        if (OUT) {
            __syncthreads();
            {
                bf16x8 pa[2], vb[2][4];
#pragma unroll
                for (int kk = 0; kk < 2; ++kk) {
                    pa[kk] = *(const LAS bf16x8*)(Ps + (16 * mf + fr) * 72 + kk * 32 + fq * 8);
#pragma unroll
                    for (int nf = 0; nf < 4; ++nf) vb[kk][nf] = *(const LAS bf16x8*)(Vt + tix(64 * nh + 16 * nf + fr, kk * 32 + fq * 8));
                }
#pragma unroll
                for (int kk = 0; kk < 2; ++kk)
#pragma unroll
                    for (int nf = 0; nf < 4; ++nf) o1[nf] = MFMA16(pa[kk], vb[kk][nf], o1[nf]);
                __builtin_amdgcn_sched_group_barrier(0x100, 10, 0); __builtin_amdgcn_sched_group_barrier(0x008, 8, 0);
            }
            __builtin_amdgcn_sched_barrier(0);
            __builtin_amdgcn_sched_barrier(0);
#pragma unroll
            for (int j = 0; j < 4; ++j) {
                const int i = 16 * mf + 4 * fq + j; const float dq = __builtin_amdgcn_exp2f(lg2 * (float)(i + 1));
#pragma unroll
                for (int nf = 0; nf < 4; ++nf) Os[i * 132 + 64 * nh + 16 * nf + fr] = o1[nf][j] + dq * o2[nf][j];
            }
        }
        if (OUT) {
            __syncthreads();
            const int i = tid >> 3, part = tid & 7, t = t0 + i;
            f32x4 v[4]; float sum = 0.f;
#pragma unroll
            for (int e = 0; e < 4; ++e) { v[e] = *(const LAS f32x4*)(Os + i * 132 + part * 16 + e * 4); sum += v[e][0] + v[e][1] + v[e][2] + v[e][3]; }
            sum += dppf(sum, 0); sum += dppf(sum, 1); sum += shx(sum, lane, 4);
            const float mean = sum * (1.0f / 128.0f);
            float sq = 0.f;
#pragma unroll
            for (int e = 0; e < 4; ++e) { v[e] = v[e] - mean; sq += v[e][0] * v[e][0] + v[e][1] * v[e][1] + v[e][2] * v[e][2] + v[e][3] * v[e][3]; }
            sq += dppf(sq, 0); sq += dppf(sq, 1); sq += shx(sq, lane, 4);
            const float rs = rsqrtf(sq * (1.0f / 128.0f) + EPS);
            bf16_t* yp = (bf16_t*)(ws + WS_YCAT) + (size_t)t * 3072 + ncol;
            f32x4 sg4[4];
            sg4[0][0] = blo(sgp[0].x); sg4[0][1] = bhi(sgp[0].x); sg4[0][2] = blo(sgp[0].y); sg4[0][3] = bhi(sgp[0].y);
            sg4[1][0] = blo(sgp[0].z); sg4[1][1] = bhi(sgp[0].z); sg4[1][2] = blo(sgp[0].w); sg4[1][3] = bhi(sgp[0].w);
            sg4[2][0] = blo(sgp[1].x); sg4[2][1] = bhi(sgp[1].x); sg4[2][2] = blo(sgp[1].y); sg4[2][3] = bhi(sgp[1].y);
            sg4[3][0] = blo(sgp[1].z); sg4[3][1] = bhi(sgp[1].z); sg4[3][2] = blo(sgp[1].w); sg4[3][3] = bhi(sgp[1].w);
            store8bf(yp, v[0] * rs * gv4[0] * sg4[0], v[1] * rs * gv4[1] * sg4[1]);
            store8bf(yp + 8, v[2] * rs * gv4[2] * sg4[2], v[3] * rs * gv4[3] * sg4[3]);
        }
    }
#undef RET_LOAD
    if (!OUT) {
        float* tp = tot + (size_t)item * 16384;
#pragma unroll
        for (int nf = 0; nf < 8; ++nf)
#pragma unroll
            for (int j = 0; j < 4; ++j) tp[(16 * wid + 4 * fq + j) * 128 + 16 * nf + fr] = sacc[nf][j];
    }
}

__device__ void lru_item(LAS char* lds, KP p, int l, int item) {
    char* ws = p->ws;
    int tid = threadIdx.x; asm volatile("" : "+v"(tid)); const int wid = tid >> 6, lane = tid & 63, fr = lane & 15, fq = lane >> 4;
    const int nb = item & 7, np_ = (item >> 3) & 15, b = item >> 7;
    LAS bf16_t* Xs = (LAS bf16_t*)(lds);
    LAS float* Xf = (LAS float*)(lds + 17408);
    LAS bf16_t* Wa = (LAS bf16_t*)(lds + 50176);
    LAS bf16_t* Wx = (LAS bf16_t*)(lds + 84992);
    LAS bf16_t* Oa = (LAS bf16_t*)(lds);
    LAS float* Bs_ = Xf;
    LAS float* Cq = (LAS float*)(lds + 119808);
    const bf16_t* proj = (const bf16_t*)(ws + WS_PROJ);
    const bf16_t* wat = (const bf16_t*)(ws + WS_WA) + (size_t)(l * 8 + nb) * 16384;
    const bf16_t* wxt = (const bf16_t*)(ws + WS_WX) + (size_t)(l * 8 + nb) * 16384;
    float pba[4], pbx[4], plam[4];
#pragma unroll
    for (int nf = 0; nf < 4; ++nf) { const int ch_ = l * 1024 + nb * 128 + 64 * (wid >> 2) + 16 * nf + fr; pba[nf] = p->in[12][ch_]; pbx[nf] = p->in[14][ch_]; plam[nf] = p->in[15][ch_]; }
    __syncthreads();
    {
        u32x4 wa4[4], wx4[4];
#pragma unroll
        for (int r = 0; r < 4; ++r) { const int q = tid + 512 * r, d = q >> 4, c8 = (q & 15) * 8; wa4[r] = *(const u32x4*)(wat + d * 128 + c8); wx4[r] = *(const u32x4*)(wxt + d * 128 + c8); }
#pragma unroll
        for (int r = 0; r < 4; ++r) { const int q = tid + 512 * r, d = q >> 4, c8 = (q & 15) * 8; *(LAS u32x4*)(Wa + d * 136 + c8) = wa4[r]; *(LAS u32x4*)(Wx + d * 136 + c8) = wx4[r]; }
    }
  for (int cc_ = 0; cc_ < 2; ++cc_) {
    const int n = np_ * 2 + cc_, t0 = b * 2048 + n * 64, s0 = n * 64;
    __syncthreads();
#pragma unroll
    for (int r = 0; r < 2; ++r) {
        const int q = tid + 512 * r, i = q >> 4, c8 = (q & 15) * 8, ch = nb * 128 + c8;
        f32x4 x0 = *(const f32x4*)(p->in[10] + (size_t)l * 1024 + ch), x1 = *(const f32x4*)(p->in[10] + (size_t)l * 1024 + ch + 4);
        u32x4 xv4[4]; f32x4 w04[4], w14[4];
#pragma unroll
        for (int k = 0; k < 4; ++k) {
            const int sk = s0 + i - 3 + k, tk = sk >= 0 ? (t0 + i - 3 + k) : t0;
            xv4[k] = *(const u32x4*)(proj + (size_t)tk * LDP + 4096 + ch);
            w04[k] = *(const f32x4*)(p->in[9] + (size_t)(l * 4 + k) * 1024 + ch); w14[k] = *(const f32x4*)(p->in[9] + (size_t)(l * 4 + k) * 1024 + ch + 4);
        }
#pragma unroll
        for (int k = 0; k < 4; ++k) {
            const float mk = (s0 + i - 3 + k >= 0) ? 1.0f : 0.0f;
            const f32x4 w0 = w04[k] * mk, w1 = w14[k] * mk; const u32x4 xv = xv4[k];
            x0[0] += w0[0] * blo(xv[0]); x0[1] += w0[1] * bhi(xv[0]); x0[2] += w0[2] * blo(xv[1]); x0[3] += w0[3] * bhi(xv[1]);
            x1[0] += w1[0] * blo(xv[2]); x1[1] += w1[1] * bhi(xv[2]); x1[2] += w1[2] * blo(xv[3]); x1[3] += w1[3] * bhi(xv[3]);
        }
        u32x4 o; o.x = pk2(x0[0], x0[1]); o.y = pk2(x0[2], x0[3]); o.z = pk2(x1[0], x1[1]); o.w = pk2(x1[2], x1[3]);
        *(LAS u32x4*)(Xs + i * 136 + c8) = o;
        *(LAS f32x4*)(Xf + i * 128 + c8) = x0; *(LAS f32x4*)(Xf + i * 128 + c8 + 4) = x1;
    }
    __syncthreads();
    const int mf = wid & 3, nh = wid >> 2;
    f32x4 accA[4], accX[4];
#pragma unroll
    for (int nf = 0; nf < 4; ++nf) { accA[nf] = (f32x4){0.f, 0.f, 0.f, 0.f}; accX[nf] = (f32x4){0.f, 0.f, 0.f, 0.f}; }
    __builtin_amdgcn_sched_barrier(0);
#pragma unroll
    for (int half = 0; half < 2; ++half) {
        bf16x8 xa[2], wa_[2][4], wx_[2][4];
#pragma unroll
        for (int kk = 0; kk < 2; ++kk) {
            const int k0 = (half * 2 + kk) * 32;
            xa[kk] = *(const LAS bf16x8*)(Xs + (16 * mf + fr) * 136 + k0 + fq * 8);
#pragma unroll
            for (int nf = 0; nf < 4; ++nf) {
                wa_[kk][nf] = *(const LAS bf16x8*)(Wa + (64 * nh + 16 * nf + fr) * 136 + k0 + fq * 8);
                wx_[kk][nf] = *(const LAS bf16x8*)(Wx + (64 * nh + 16 * nf + fr) * 136 + k0 + fq * 8);
            }
        }
#pragma unroll
        for (int kk = 0; kk < 2; ++kk)
#pragma unroll
            for (int nf = 0; nf < 4; ++nf) { accA[nf] = MFMA16(xa[kk], wa_[kk][nf], accA[nf]); accX[nf] = MFMA16(xa[kk], wx_[kk][nf], accX[nf]); }
        __builtin_amdgcn_sched_group_barrier(0x100, 18, 0); __builtin_amdgcn_sched_group_barrier(0x008, 16, 0);
        __builtin_amdgcn_sched_barrier(0);
    }
    __syncthreads();
#pragma unroll
    for (int nf = 0; nf < 4; ++nf) {
        const int d = 64 * nh + 16 * nf + fr;
        const float ba = pba[nf], bx = pbx[nf], lam = plam[nf];
        const float em = __expf(-fabsf(lam));
        const float l1p = em < 0.01f ? em * (1.0f - em * (0.5f - em * 0.33333334f)) : __logf(1.0f + em);
        const float sp = fmaxf(-lam, 0.0f) + l1p;
#pragma unroll
        for (int j = 0; j < 4; ++j) {
            const int i = 16 * mf + 4 * fq + j;
            const float r = sigmoidf_(accA[nf][j] + ba), ig = sigmoidf_(accX[nf][j] + bx);
            const float la = -8.0f * r * sp;
            Oa[i * 128 + d] = f2bf(la > -0.05f ? -la * (1.0f + la * (0.5f + la * (0.16666667f + la * 0.041666668f))) : 1.0f - __expf(la));
            const float x2 = 2.0f * la;
            const float om = x2 > -0.1f ? -x2 * (1.0f + x2 * (0.5f + x2 * (0.16666667f + x2 * 0.041666668f))) : 1.0f - __expf(x2);
            Bs_[i * 128 + d] = sqrtf(om) * (ig * Xf[i * 128 + d]);
        }
    }
    __syncthreads();
    {
        const int d = tid & 127, q = tid >> 7;
        float h = 0.f, A = 1.f;
#pragma unroll 4
        for (int ii = 0; ii < 16; ++ii) { const int i = 16 * q + ii; const float a = 1.0f - bf2f(Oa[i * 128 + d]); h = a * h + Bs_[i * 128 + d]; A *= a; }
        Cq[(q * 128 + d) * 2] = A; Cq[(q * 128 + d) * 2 + 1] = h;
        __syncthreads();
        float hin = 0.f, Ain = 1.f;
        for (int qq = 0; qq < q; ++qq) { const float Aq = Cq[(qq * 128 + d) * 2], hq = Cq[(qq * 128 + d) * 2 + 1]; hin = Aq * hin + hq; Ain *= Aq; }
        h = hin; A = Ain;
        bf16_t* hl = (bf16_t*)(ws + WS_HLOC) + (size_t)t0 * 1024 + nb * 128 + d;
        bf16_t* ac = (bf16_t*)(ws + WS_ACUM) + (size_t)t0 * 1024 + nb * 128 + d;
#pragma unroll 4
        for (int ii = 0; ii < 16; ++ii) {
            const int i = 16 * q + ii; const float a = 1.0f - bf2f(Oa[i * 128 + d]); h = a * h + Bs_[i * 128 + d]; A *= a;
            hl[(size_t)i * 1024] = f2bf(h); ac[(size_t)i * 1024] = f2bf(A);
        }
        if (q == 3) {
            float* lt = (float*)(ws + WS_LTOT) + (size_t)(b * 32 + n) * 1024 + nb * 128 + d;
            lt[0] = A; lt[(size_t)128 * 1024] = h;
        }
    }
  }
}

__device__ void lru_out_item(KP p, int item) {
    char* ws = p->ws;
    int tid = threadIdx.x; asm volatile("" : "+v"(tid));
    const int n = item & 31, b = item >> 5, t0 = b * 2048 + n * 64, ch = tid * 2;
    const bf16_t* hl = (const bf16_t*)(ws + WS_HLOC); const bf16_t* ac = (const bf16_t*)(ws + WS_ACUM);
    const float* lt = (const float*)(ws + WS_LTOT);
    const bf16_t* proj = (const bf16_t*)(ws + WS_PROJ);
    bf16_t* ycat = (bf16_t*)(ws + WS_YCAT);
    f32x2 carry = (f32x2){0.f, 0.f};
    for (int m0 = 0; m0 < n; m0 += 8) {
        f32x2 A2[8], H2[8];
#pragma unroll
        for (int u = 0; u < 8; ++u) {
            const int m = (m0 + u < n) ? (m0 + u) : (n - 1);
            const size_t tl = (size_t)(b * 32 + m) * 1024 + ch;
            A2[u] = *(const f32x2*)(lt + tl); H2[u] = *(const f32x2*)(lt + (size_t)128 * 1024 + tl);
        }
#pragma unroll
        for (int u = 0; u < 8; ++u) if (m0 + u < n) carry = A2[u] * carry + H2[u];
    }
    for (int i0 = 0; i0 < 64; i0 += 8) {
        unsigned h2[8], a2[8], gw[8];
#pragma unroll
        for (int u = 0; u < 8; ++u) {
            const size_t t = t0 + i0 + u;
            h2[u] = *(const unsigned*)(hl + t * 1024 + ch); a2[u] = *(const unsigned*)(ac + t * 1024 + ch);
            gw[u] = *(const unsigned*)(proj + t * LDP + 5120 + ch);
        }
#pragma unroll
        for (int u = 0; u < 8; ++u) {
            const size_t t = t0 + i0 + u;
            const float y0 = blo(h2[u]) + blo(a2[u]) * carry.x, y1 = bhi(h2[u]) + bhi(a2[u]) * carry.y;
            *(unsigned*)(ycat + t * 3072 + 1024 + ch) = pk2(y0 * blo(gw[u]), y1 * bhi(gw[u]));
        }
    }
}

__device__ void attn_item(LAS char* lds, KP p, int b, int h, int Pp) {
    char* ws = p->ws;
    int tid = threadIdx.x; asm volatile("" : "+v"(tid)); const int wid = tid >> 6, lane = tid & 63, fr = lane & 15, fq = lane >> 4;
    LAS bf16_t* Pw = (LAS bf16_t*)(lds + 81920 + wid * 4608);
    const bf16_t* qm = (const bf16_t*)(ws + WS_QM);
    const bf16_t* kn = (const bf16_t*)(ws + WS_KN) + (size_t)(b * 8 + h) * 2048 * 128;
    const bf16_t* kr = (const bf16_t*)(ws + WS_KROPE) + (size_t)b * 2048 * 64;
    const bf16_t* vt = (const bf16_t*)(ws + WS_VT) + (size_t)(b * 8 + h) * 128 * 2048;
    const int s0 = Pp * 256 + wid * 32, nkt = 4 * Pp + 4, qc = 4 * Pp + (wid >> 1);
    bf16x8 qf[2][6];
#pragma unroll
    for (int mi = 0; mi < 2; ++mi)
#pragma unroll
        for (int ks = 0; ks < 6; ++ks) qf[mi][ks] = *(const bf16x8*)(qm + ((size_t)((b * 8 + h) * 2048 + s0 + 16 * mi + fr)) * 192 + ks * 32 + fq * 8);
    f32x4 o[2][8];
#pragma unroll
    for (int mi = 0; mi < 2; ++mi)
#pragma unroll
        for (int nd = 0; nd < 8; ++nd) o[mi][nd] = (f32x4){0.f, 0.f, 0.f, 0.f};
    float mrow[2][4], lsum[2][4];
#pragma unroll
    for (int mi = 0; mi < 2; ++mi)
#pragma unroll
        for (int j = 0; j < 4; ++j) { mrow[mi][j] = -1e30f; lsum[mi][j] = 0.f; }
    const bf16_t* ksrc[3]; int kstep[3];
#pragma unroll
    for (int r = 0; r < 3; ++r) {
        const int q = tid + 512 * r, row = q / 24, pc = q - row * 24, lc = pc ^ ((row >> 1) & 7);
        if (lc < 16) { ksrc[r] = kn + (size_t)row * 128 + lc * 8; kstep[r] = 64 * 128; } else { ksrc[r] = kr + (size_t)row * 64 + (lc - 16) * 8; kstep[r] = 64 * 64; }
    }
    const bf16_t* vsrc[2];
#pragma unroll
    for (int r = 0; r < 2; ++r) { const int q = tid + 512 * r, d = q >> 3, pc = q & 7; vsrc[r] = vt + (size_t)d * 2048 + ((pc ^ ((d >> 1) & 7)) * 8); }
    const int ldsw = wid * 1024;
#define ATT_STAGE(kt, buf) do { _Pragma("unroll") for (int r_ = 0; r_ < 3; ++r_) \
        __builtin_amdgcn_global_load_lds((const unsigned*)(ksrc[r_] + (size_t)(kt) * kstep[r_]), (LAS unsigned*)(lds + (buf) * 24576 + ldsw + r_ * 8192), 16, 0, 0); \
      _Pragma("unroll") for (int r_ = 0; r_ < 2; ++r_) \
        __builtin_amdgcn_global_load_lds((const unsigned*)(vsrc[r_] + (kt) * 64), (LAS unsigned*)(lds + 49152 + (buf) * 16384 + ldsw + r_ * 8192), 16, 0, 0); } while (0)
    const int f7 = (fr >> 1) & 7, xq = fq ^ (f7 & 3), yq = f7 >> 2;
    const int ka0 = fr * 384 + xq * 16 + yq * 64, ka1 = fr * 384 + xq * 16 + (1 - yq) * 64;
    const int va0 = fr * 128 + xq * 16 + yq * 64, va1 = fr * 128 + xq * 16 + (1 - yq) * 64;
    __syncthreads();
    ATT_STAGE(0, 0); WAIT_V0(); __syncthreads();
    for (int kt = 0; kt < nkt; ++kt) {
        const int cur = kt & 1;
        if (kt + 1 < nkt) ATT_STAGE(kt + 1, cur ^ 1);
        if (kt <= qc) {
            const LAS char* Kb = (const LAS char*)(lds + cur * 24576);
            const LAS char* Vb = (const LAS char*)(lds + 49152 + cur * 16384);
            f32x4 s[2][4];
#pragma unroll
            for (int mi = 0; mi < 2; ++mi)
#pragma unroll
                for (int n = 0; n < 4; ++n) s[mi][n] = (f32x4){0.f, 0.f, 0.f, 0.f};
            __builtin_amdgcn_sched_barrier(0);
            __builtin_amdgcn_s_setprio(1);
            {
                bf16x8 kf[6][4];
#pragma unroll
                for (int ks = 0; ks < 6; ++ks)
#pragma unroll
                    for (int n = 0; n < 4; ++n) kf[ks][n] = *(const LAS bf16x8*)(Kb + ((ks & 1) ? ka1 : ka0) + n * 6144 + (ks >> 1) * 128);
#pragma unroll
                for (int ks = 0; ks < 6; ++ks)
#pragma unroll
                    for (int n = 0; n < 4; ++n) { s[0][n] = MFMA16(qf[0][ks], kf[ks][n], s[0][n]); s[1][n] = MFMA16(qf[1][ks], kf[ks][n], s[1][n]); }
                __builtin_amdgcn_sched_group_barrier(0x100, 8, 0);
                __builtin_amdgcn_sched_group_barrier(0x008, 8, 0); __builtin_amdgcn_sched_group_barrier(0x100, 4, 0);
                __builtin_amdgcn_sched_group_barrier(0x008, 8, 0); __builtin_amdgcn_sched_group_barrier(0x100, 4, 0);
                __builtin_amdgcn_sched_group_barrier(0x008, 8, 0); __builtin_amdgcn_sched_group_barrier(0x100, 4, 0);
                __builtin_amdgcn_sched_group_barrier(0x008, 8, 0); __builtin_amdgcn_sched_group_barrier(0x100, 4, 0);
                __builtin_amdgcn_sched_group_barrier(0x008, 16, 0);
            }
            __builtin_amdgcn_s_setprio(0);
            __builtin_amdgcn_sched_barrier(0);
#pragma unroll
            for (int mi = 0; mi < 2; ++mi)
#pragma unroll
                for (int j = 0; j < 4; ++j) {
                    float mx = fmaxf(fmaxf(s[mi][0][j], s[mi][1][j]), fmaxf(s[mi][2][j], s[mi][3][j]));
                    mx = row16_max(mx);
                    const float mnew = fmaxf(mrow[mi][j], mx);
                    if (__builtin_amdgcn_ballot_w64(mnew != mrow[mi][j]) != 0ull) {
                        const float alpha = __builtin_amdgcn_exp2f(mrow[mi][j] - mnew);
                        mrow[mi][j] = mnew; lsum[mi][j] *= alpha;
#pragma unroll
                        for (int nd = 0; nd < 8; ++nd) o[mi][nd][j] *= alpha;
                    }
#pragma unroll
                    for (int n = 0; n < 4; ++n) { const float pe = __builtin_amdgcn_exp2f(s[mi][n][j] - mnew); lsum[mi][j] += pe; Pw[(16 * mi + 4 * fq + j) * 72 + n * 16 + fr] = (bf16_t)pk2(pe, 0.f); }
                }
            WAIT_L0(); __builtin_amdgcn_wave_barrier();
            __builtin_amdgcn_sched_barrier(0);
            __builtin_amdgcn_s_setprio(1);
            {
                bf16x8 pa[2][2], vb[2][8];
#pragma unroll
                for (int ks2 = 0; ks2 < 2; ++ks2)
#pragma unroll
                    for (int mi = 0; mi < 2; ++mi) pa[mi][ks2] = *(const LAS bf16x8*)(Pw + (16 * mi + fr) * 72 + ks2 * 32 + fq * 8);
#pragma unroll
                for (int ks2 = 0; ks2 < 2; ++ks2)
#pragma unroll
                    for (int nd = 0; nd < 8; ++nd) vb[ks2][nd] = *(const LAS bf16x8*)(Vb + (ks2 ? va1 : va0) + nd * 2048);
#pragma unroll
                for (int ks2 = 0; ks2 < 2; ++ks2)
#pragma unroll
                    for (int nd = 0; nd < 8; ++nd) { o[0][nd] = MFMA16(pa[0][ks2], vb[ks2][nd], o[0][nd]); o[1][nd] = MFMA16(pa[1][ks2], vb[ks2][nd], o[1][nd]); }
                __builtin_amdgcn_sched_group_barrier(0x100, 12, 0);
                __builtin_amdgcn_sched_group_barrier(0x008, 4, 0); __builtin_amdgcn_sched_group_barrier(0x100, 2, 0);
                __builtin_amdgcn_sched_group_barrier(0x008, 4, 0); __builtin_amdgcn_sched_group_barrier(0x100, 2, 0);
                __builtin_amdgcn_sched_group_barrier(0x008, 4, 0); __builtin_amdgcn_sched_group_barrier(0x100, 2, 0);
                __builtin_amdgcn_sched_group_barrier(0x008, 4, 0); __builtin_amdgcn_sched_group_barrier(0x100, 2, 0);
                __builtin_amdgcn_sched_group_barrier(0x008, 16, 0);
            }
            __builtin_amdgcn_s_setprio(0);
            __builtin_amdgcn_sched_barrier(0);
        }
        WAIT_V0(); __syncthreads();
    }
#undef ATT_STAGE
    const bf16_t* proj = (const bf16_t*)(ws + WS_PROJ);
    bf16_t* ycat = (bf16_t*)(ws + WS_YCAT);
    LAS bf16_t* Ow = (LAS bf16_t*)(lds + wid * 8704);
#pragma unroll
    for (int mi = 0; mi < 2; ++mi)
#pragma unroll
        for (int j = 0; j < 4; ++j) {
            const float ls = row16_sum(lsum[mi][j]);
            const float inv = 1.0f / ls;
#pragma unroll
            for (int nd = 0; nd < 8; ++nd) Ow[(16 * mi + 4 * fq + j) * 136 + nd * 16 + fr] = f2bf(o[mi][nd][j] * inv);
        }
    WAIT_L0(); __builtin_amdgcn_wave_barrier();
#pragma unroll
    for (int r = 0; r < 8; ++r) {
        const int q = lane + 64 * r, row = q >> 4, c8 = (q & 15) * 8;
        const size_t t = (size_t)b * 2048 + s0 + row;
        const u32x4 ov = *(const LAS u32x4*)(Ow + row * 136 + c8);
        const u32x4 gv = *(const u32x4*)(proj + t * LDP + 7168 + h * 128 + c8);
        u32x4 y;
#pragma unroll
        for (int e = 0; e < 4; ++e) y[e] = pk2(blo(ov[e]) * blo(gv[e]), bhi(ov[e]) * bhi(gv[e]));
        *(u32x4*)(ycat + t * 3072 + 2048 + h * 128 + c8) = y;
    }
}

#define XB_TMO      128
#define XB_XCNT(j)  (256  + 64 * (j))
#define XB_XSUB(j)  (1280 + 64 * (j))
#define XB_XGEN(j)  (2304 + 64 * (j))
#define XB_TOP      3328
#define XB_TOPGEN   3392
#define XCD_BAR_WORDS 3456
#define XB_SPIN_CAP (1u << 18)
__device__ __forceinline__ unsigned xb_ld(unsigned* p)              { return __hip_atomic_load(p, __ATOMIC_RELAXED, __HIP_MEMORY_SCOPE_AGENT); }
__device__ __forceinline__ unsigned xb_add(unsigned* p, unsigned v) { return __hip_atomic_fetch_add(p, v, __ATOMIC_RELAXED, __HIP_MEMORY_SCOPE_AGENT); }
__device__ __forceinline__ unsigned xb_xcc_id() { return (unsigned)__builtin_amdgcn_s_getreg((3 << 11) | 20) & 0xFu; }
#define XB_SPIN(cond, bar) do { unsigned _sp = 0; while (cond) { __builtin_amdgcn_s_sleep(1); \
    if ((++_sp & 255u) == 0u) { if (xb_ld(&(bar)[XB_TMO])) break; if (_sp > XB_SPIN_CAP) { atomicAdd(&(bar)[XB_TMO], 1u); break; } } } } while (0)
struct XcdBarrier { unsigned* bar; unsigned x; volatile LAS unsigned* st; };
__device__ __forceinline__ XcdBarrier xcd_barrier_post(unsigned* bar, volatile LAS unsigned* st) {
    XcdBarrier b; b.bar = bar; b.x = xb_xcc_id(); b.st = st;
    if (threadIdx.x == 0) (void)xb_add(&bar[XB_XCNT(b.x)], 1u);
    return b;
}
__device__ __forceinline__ void xcd_barrier_complete(unsigned* bar, unsigned x, unsigned& nloc, unsigned& nx) {
    const unsigned G = gridDim.x * gridDim.y * gridDim.z;
    unsigned sum, cnt, mine, sp = 0u;
    for (;;) {
        sum = 0u; cnt = 0u; mine = 0u;
#pragma unroll
        for (unsigned j = 0; j < 16; ++j) { const unsigned c = xb_ld(&bar[XB_XCNT(j)]); sum += c; cnt += (c > 0u) ? 1u : 0u; mine = (j == x) ? c : mine; }
        if (sum == G) break;
        __builtin_amdgcn_s_sleep(1);
        if ((++sp & 255u) == 0u) { if (xb_ld(&bar[XB_TMO])) break; if (sp > XB_SPIN_CAP) { atomicAdd(&bar[XB_TMO], 1u); break; } }
    }
    nloc = mine > 0u ? mine : 1u; nx = cnt > 0u ? cnt : 1u;
}
__device__ __forceinline__ void xcd_barrier(const XcdBarrier& b) {
    asm volatile("s_waitcnt vmcnt(0)" ::: "memory");
    __syncthreads();
    if (threadIdx.x == 0) {
        unsigned* bar = b.bar; asm volatile("" : "+s"(bar));
        __builtin_amdgcn_s_waitcnt(0);
        unsigned nloc = b.st[0], nx = b.st[1];
        if (nloc == 0u) { xcd_barrier_complete(bar, b.x, nloc, nx); b.st[0] = nloc; b.st[1] = nx; }
        const unsigned old = xb_add(&bar[XB_XSUB(b.x)], 1u);
        const unsigned gen = old / nloc;
        if (old + 1u == (gen + 1u) * nloc) {
            __builtin_amdgcn_fence(__ATOMIC_RELEASE, "agent");
            asm volatile("s_waitcnt vmcnt(0)" ::: "memory");
            const unsigned og = xb_add(&bar[XB_TOP], 1u);
            const unsigned tg = og / nx;
            if (og + 1u == (tg + 1u) * nx) xb_add(&bar[XB_TOPGEN], 1u);
            else XB_SPIN(xb_ld(&bar[XB_TOPGEN]) == tg, bar);
            __builtin_amdgcn_fence(__ATOMIC_ACQUIRE, "agent");
            xb_add(&bar[XB_XGEN(b.x)], 1u);
            asm volatile("s_waitcnt vmcnt(0)" ::: "memory");
        } else {
            XB_SPIN(xb_ld(&bar[XB_XGEN(b.x)]) == gen, bar);
            __builtin_amdgcn_fence(__ATOMIC_ACQUIRE, "agent");
            asm volatile("s_waitcnt vmcnt(0)" ::: "memory");
        }
    }
    __syncthreads();
}

#define Q_BEGIN(ctrp) unsigned* qctr_ = (ctrp); volatile LAS int* qslot_ = (volatile LAS int*)(lds + 131072 + 8); int qnxt_ = 0
#define Q_ISSUE() do { int r_ = 0; if (threadIdx.x == 0) r_ = (int)__hip_atomic_fetch_add(qctr_, 1u, __ATOMIC_RELAXED, __HIP_MEMORY_SCOPE_AGENT); qnxt_ = r_; } while (0)
#define Q_TAKE(it) do { __syncthreads(); if (threadIdx.x == 0) *qslot_ = G + qnxt_; __syncthreads(); (it) = *qslot_; } while (0)

__global__ void __launch_bounds__(512) fwd_megakernel(Params parg) {
    __shared__ __attribute__((aligned(1024))) char shm[131072 + 16];
    LAS char* lds = (LAS char*)shm;
    const int G = gridDim.x, c = blockIdx.x;
    volatile LAS unsigned* xst = (volatile LAS unsigned*)(lds + 131072);
    unsigned* xbar = (unsigned*)(parg.ws + WS_BAR);
    if (threadIdx.x == 0) { xst[0] = 0u; xst[1] = 0u; }
    __syncthreads();
    XcdBarrier xb = xcd_barrier_post(xbar, xst);
    if (parg.ph_lo > 1000) cg::this_grid().sync();
#define GRID_SYNC() xcd_barrier(xb)
    for (int ph = parg.ph_lo; ph < parg.ph_hi; ++ph) {
      const int ptype = ph < 2 ? ph : 2 + (ph - 2) % 6;
      const int nrep = 1 + ((REPMASK >> ptype) & 1);
      for (int rep = 0; rep < nrep; ++rep) {
        if (rep) GRID_SYNC();
        const bool skip_epi = VAR_NOEPI && (rep + 1 < nrep);
        KP p = get_kp();
        char* ws = p->ws;
        if (ph == 0) {
            if (PMASK & 1) phase0(lds, p);
        } else if (ph == 1) {
            if (PMASK & 2) rowpass(p, -1);
        } else {
            const int l = (ph - 2) / 6, sub = (ph - 2) % 6;
            if (sub == 0 && (PMASK & 4)) {
                const bf16_t* A = (const bf16_t*)(ws + WS_HBUF);
                const bf16_t* Bt = (const bf16_t*)(ws + WS_WI) + (size_t)l * NP1 * 2048;
                for (int L = c; L < 32 * 56; L += G) {
                    int pm, pn; tile_map(L, 32, 56, pm, pn);
                    f32x4 acc[8][4];
                    gemm256(lds, A + (size_t)pm * 256 * 2048, 2048, Bt + (size_t)pn * 256 * 2048, 2048, 2048, acc);
                    OPAQUE_WS(wx); EPI_IDS;
                    EpiProj e{(bf16_t*)(wx + WS_PROJ), (bf16_t*)(wx + WS_KROPE), (float*)(wx + WS_RSQ), (const float*)(wx + WS_COSR), (const float*)(wx + WS_SINR),
                              (const float*)(wx + WS_COSM), (const float*)(wx + WS_SINM), pm * 256, pn * 256};
                    if (!skip_epi) e(acc, wr_, wc_, fr_, fq_);
                }
            } else if (sub == 1 && (PMASK & 8)) {
                Q_BEGIN(xbar + 3520 + (ph * 2 + rep) * 8);
                const int nP2 = 32 + 192 + 256 + 256 + 512 + (l + 1 < DEPTH ? 324 : 0);
                for (int it = c; it < nP2;) {
                    KP p = get_kp(); char* ws = p->ws;
                    if (it >= 480) Q_ISSUE();
                    if (it < 32) {
                        const int pm = it;
                        f32x4 acc[8][4];
                        gemm256(lds, (const bf16_t*)(ws + WS_HBUF) + (size_t)pm * 256 * 2048, 2048, (const bf16_t*)(ws + WS_WI) + (size_t)l * NP1 * 2048 + (size_t)14336 * 2048, 2048, 2048, acc);
                        Q_ISSUE();
                        OPAQUE_WS(wx); EPI_IDS;
                        EpiProj e{(bf16_t*)(wx + WS_PROJ), (bf16_t*)(wx + WS_KROPE), (float*)(wx + WS_RSQ), (const float*)(wx + WS_COSR), (const float*)(wx + WS_SINR),
                                  (const float*)(wx + WS_COSM), (const float*)(wx + WS_SINM), pm * 256, 14336};
                        if (!skip_epi) e(acc, wr_, wc_, fr_, fq_);
                    } else if (it < 224) {
                        const int i2 = it - 32, pm = i2 & 31, pn = i2 >> 5;
                        f32x4 acc[8][4];
                        gemm256(lds, (const bf16_t*)(ws + WS_PROJ) + (size_t)pm * 256 * LDP + 6144, LDP, (const bf16_t*)(ws + WS_WUQ) + (size_t)l * 1536 * 512 + (size_t)pn * 256 * 512, 512, 512, acc);
                        Q_ISSUE();
                        OPAQUE_WS(wx); EPI_IDS;
                        EpiQ e{(bf16_t*)(wx + WS_QM), (const float*)(wx + WS_RSQ), (const float*)(wx + WS_COSM), (const float*)(wx + WS_SINM), pm * 256, pn * 256};
                        if (!skip_epi) e(acc, wr_, wc_, fr_, fq_);
                    } else if (it < 480) {
                        const int i2 = it - 224, pm = i2 & 31, pn = i2 >> 5;
                        f32x4 acc[8][4];
                        gemm256(lds, (const bf16_t*)(ws + WS_PROJ) + (size_t)pm * 256 * LDP + 6656, LDP, (const bf16_t*)(ws + WS_WUKV) + (size_t)l * 2048 * 512 + (size_t)pn * 256 * 512, 512, 512, acc);
                        Q_ISSUE();
                        OPAQUE_WS(wx); EPI_IDS;
                        EpiKV e{(bf16_t*)(wx + WS_KN), (bf16_t*)(wx + WS_VT), (const float*)(wx + WS_RSQ), pm * 256, pn};
                        if (!skip_epi) e(acc, wr_, wc_, fr_, fq_);
                    } else if (it < 736) {
                        ret_item<false>(lds, p, l, it - 480);
                    } else if (it < 1248) {
                        lru_item(lds, p, l, it - 736);
                    } else {
                        conv4(lds, p, (l + 1) * 2592 + (it - 1248) * 4);
                    }
                    Q_TAKE(it);
                }
            } else if (sub == 2 && (PMASK & 16)) {
                Q_BEGIN(xbar + 3520 + (ph * 2 + rep) * 8);
                const int nP3 = 256 + 256 + 128 + (l + 1 < DEPTH ? 324 : 0);
                for (int it = c; it < nP3;) {
                    KP p = get_kp();
                    Q_ISSUE();
                    if (it < 256) {
                        const int bh = it & 31, Pp = 7 - (it >> 5);
                        attn_item(lds, p, bh >> 3, bh & 7, Pp);
                    } else if (it < 512) {
                        ret_item<true>(lds, p, l, it - 256);
                    } else if (it < 640) {
                        lru_out_item(p, it - 512);
                    } else {
                        conv4(lds, p, (l + 1) * 2592 + 1296 + (it - 640) * 4);
                    }
                    Q_TAKE(it);
                }
            } else if (sub == 3 && (PMASK & 32)) {
                for (int L = c; L < 256; L += G) {
                    int pm, pn; tile_map(L, 32, 8, pm, pn);
                    f32x4 acc[8][4];
#pragma unroll
                    for (int m_ = 0; m_ < 8; ++m_)
#pragma unroll
                        for (int n_ = 0; n_ < 4; ++n_) acc[m_][n_] = (f32x4){0.f, 0.f, 0.f, 0.f};
#pragma unroll 1
                    for (int i = 0; i < 3; ++i) {
                        gemm256(lds, (const bf16_t*)(ws + WS_YCAT) + (size_t)pm * 256 * 3072 + i * 1024, 3072,
                                (const bf16_t*)(ws + WS_WB) + (size_t)l * 2048 * 3072 + (size_t)pn * 256 * 3072 + i * 1024, 3072, 1024, acc, false);
                        OPAQUE_WS(wx); EPI_IDS;
                        EpiBranch e{(const bf16_t*)(wx + WS_PROJ) + 8192, (bf16_t*)(wx + WS_MERGED), i, pm * 256, pn * 256};
                        if (!skip_epi || i < 2) e(acc, wr_, wc_, fr_, fq_);
                    }
                }
            } else if (sub == 4 && (PMASK & 64)) {
                for (int L = c; L < 256; L += G) {
                    int pm, pn; tile_map(L, 32, 8, pm, pn);
                    f32x4 acc[8][4];
                    gemm256(lds, (const bf16_t*)(ws + WS_MERGED) + (size_t)pm * 256 * 2048, 2048, (const bf16_t*)(ws + WS_WO) + (size_t)l * 2048 * 2048 + (size_t)pn * 256 * 2048, 2048, 2048, acc);
                    OPAQUE_WS(wx); EPI_IDS;
                    EpiOut e{(bf16_t*)(wx + WS_YBUF), pm * 256, pn * 256};
                    if (!skip_epi) e(acc, wr_, wc_, fr_, fq_);
                }
            } else if (sub == 5 && (PMASK & 128)) {
                rowpass(p, l);
            }
        }
      }
        if (ph + 1 < parg.ph_hi) GRID_SYNC();
    }
}

extern "C" void kernel_launch(void* const* d_in, const int* in_sizes, int n_in, void* d_out, int out_size, void* d_ws, size_t ws_size, hipStream_t stream) {
    static int grid_blocks = 0;
    if (!grid_blocks) {
        int dev = 0, cus = 0, per_cu = 0;
        hipGetDevice(&dev);
        hipDeviceGetAttribute(&cus, hipDeviceAttributeMultiprocessorCount, dev);
        hipOccupancyMaxActiveBlocksPerMultiprocessor(&per_cu, fwd_megakernel, 512, 0);
        if (per_cu < 1) { fprintf(stderr, "kernel_launch: occupancy query returned %d\n", per_cu); per_cu = 1; }
        if (per_cu > 1) per_cu = 1;
        grid_blocks = cus * per_cu;
        if (ws_size < WS_END) fprintf(stderr, "kernel_launch: workspace too small: %zu < %zu\n", ws_size, (size_t)WS_END);
    }
    if (n_in != 22 || ws_size < WS_END) return;
    Params p{};
    for (int i = 0; i < 22; ++i) p.in[i] = (const float*)d_in[i];
    p.pos = (const int*)d_in[2];
    p.out = (float*)d_out;
    p.ws = (char*)d_ws;
    constexpr int NPH = 2 + 6 * DEPTH;
#if MULTI_LAUNCH
    for (int ph = 0; ph < NPH; ++ph) {
        p.ph_lo = ph; p.ph_hi = ph + 1;
        hipLaunchKernelGGL(fwd_megakernel, dim3(grid_blocks), dim3(512), 0, stream, p);
    }
#else
    p.ph_lo = 0; p.ph_hi = NPH;
    if (hipMemsetAsync((char*)d_ws + WS_BAR, 0, 4096 * 4, stream) != hipSuccess) { fprintf(stderr, "kernel_launch: hipMemsetAsync failed\n"); return; }
    void* args[] = {&p};
    hipError_t e = hipLaunchCooperativeKernel((void*)fwd_megakernel, dim3(grid_blocks), dim3(512), args, 0, stream);
    if (e != hipSuccess) fprintf(stderr, "cooperative launch failed: %s (grid %d)\n", hipGetErrorString(e), grid_blocks);
#endif
}
```

```cpp
#include <hip/hip_runtime.h>
#include <hip/hip_cooperative_groups.h>
#include <cstdio>
namespace cg = cooperative_groups;

#ifndef MULTI_LAUNCH
#define MULTI_LAUNCH 0
#endif

#ifndef PMASK
#define PMASK 0xff
#endif
#ifndef VAR_NOEPI
#define VAR_NOEPI 0
#endif
#ifndef REPMASK
#define REPMASK 0
#endif
#define LAS __attribute__((address_space(3)))
typedef unsigned short bf16_t;
typedef short bf16x8 __attribute__((ext_vector_type(8)));
typedef float f32x4 __attribute__((ext_vector_type(4)));
typedef float f32x2 __attribute__((ext_vector_type(2)));
typedef unsigned u32x4 __attribute__((ext_vector_type(4)));
typedef unsigned u32x2 __attribute__((ext_vector_type(2)));

constexpr int T = 8192, D = 2048, SEQ = 2048, DEPTH = 4;
constexpr int LDP = 14336;
constexpr int NP1 = 14592;
constexpr int NIN = 14400;
constexpr float EPS = 1e-6f;
constexpr float QSCALE = 0.07216878364870322f * 1.4426950408889634f;
constexpr float RQSCALE = 0.08838834764831845f;

constexpr size_t al256(size_t x) { return (x + 255) & ~(size_t)255; }
constexpr size_t WS_WI = 0;
constexpr size_t WS_WUQ = WS_WI + al256((size_t)DEPTH * NP1 * 2048 * 2);
constexpr size_t WS_WUKV = WS_WUQ + al256((size_t)DEPTH * 1536 * 512 * 2);
constexpr size_t WS_WB = WS_WUKV + al256((size_t)DEPTH * 2048 * 512 * 2);
constexpr size_t WS_WO = WS_WB + al256((size_t)DEPTH * 2048 * 3072 * 2);
constexpr size_t WS_WA = WS_WO + al256((size_t)DEPTH * 2048 * 2048 * 2);
constexpr size_t WS_WX = WS_WA + al256((size_t)DEPTH * 8 * 128 * 128 * 2);
constexpr size_t WS_MOD = WS_WX + al256((size_t)DEPTH * 8 * 128 * 128 * 2);
constexpr size_t WS_COSR = WS_MOD + al256((size_t)DEPTH * 4 * 6144 * 4);
constexpr size_t WS_SINR = WS_COSR + al256((size_t)T * 64 * 4);
constexpr size_t WS_COSM = WS_SINR + al256((size_t)T * 64 * 4);
constexpr size_t WS_SINM = WS_COSM + al256((size_t)T * 32 * 4);
constexpr size_t WS_XCUR = WS_SINM + al256((size_t)T * 32 * 4);
constexpr size_t WS_HBUF = WS_XCUR + al256((size_t)T * D * 4);
constexpr size_t WS_PROJ = WS_HBUF + al256((size_t)T * D * 2);
constexpr size_t WS_KROPE = WS_PROJ + al256((size_t)T * LDP * 2);
constexpr size_t WS_RSQ = WS_KROPE + al256((size_t)T * 64 * 2);
constexpr size_t WS_QM = WS_RSQ + al256((size_t)T * 16 * 4);
constexpr size_t WS_KN = WS_QM + al256((size_t)T * 8 * 192 * 2);
constexpr size_t WS_VT = WS_KN + al256((size_t)T * 8 * 128 * 2);
constexpr size_t WS_TOT = WS_VT + al256((size_t)T * 8 * 128 * 2);
constexpr size_t WS_HLOC = WS_TOT + al256((size_t)4 * 8 * 8 * 16384 * 4);
constexpr size_t WS_ACUM = WS_HLOC + al256((size_t)T * 1024 * 4);
constexpr size_t WS_YCAT = WS_ACUM + al256((size_t)T * 1024 * 4);
constexpr size_t WS_MACC = WS_YCAT + al256((size_t)T * 3072 * 2);
constexpr size_t WS_MERGED = WS_MACC + al256((size_t)T * D * 4);
constexpr size_t WS_YBUF = WS_MERGED + al256((size_t)T * D * 2);
constexpr size_t WS_BAR = WS_YBUF + al256((size_t)T * D * 4);
constexpr size_t WS_LTOT = WS_BAR + al256((size_t)4096 * 4);
constexpr size_t WS_END = WS_LTOT + al256((size_t)2 * 128 * 1024 * 4);

struct Params {
    const float* in[22];
    const int* pos;
    float* out;
    char* ws;
    int ph_lo, ph_hi;
};

typedef const Params __attribute__((address_space(4)))* KP;
__device__ __forceinline__ KP get_kp() { KP k = (KP)__builtin_amdgcn_kernarg_segment_ptr(); asm volatile("" : "+s"(k)); return k; }

__device__ __forceinline__ float bf2f(unsigned h) { return __uint_as_float(h << 16); }
__device__ __forceinline__ bf16_t f2bf(float f) { unsigned u = __float_as_uint(f); return (bf16_t)((u + 0x7fffu + ((u >> 16) & 1u)) >> 16); }
__device__ __forceinline__ unsigned pk2(float lo, float hi) { unsigned r; asm("s_nop 1\n\tv_cvt_pk_bf16_f32 %0, %1, %2" : "=v"(r) : "v"(lo), "v"(hi)); return r; }
__device__ __forceinline__ float blo(unsigned w) { return __uint_as_float(w << 16); }
__device__ __forceinline__ float bhi(unsigned w) { return __uint_as_float(w & 0xffff0000u); }
__device__ __forceinline__ float sigmoidf_(float x) { return __builtin_amdgcn_rcpf(1.0f + __builtin_amdgcn_exp2f(-1.4426950408889634f * x)); }
__device__ __forceinline__ float shx(float v, int lane, int k) { return __int_as_float(__builtin_amdgcn_ds_bpermute((lane ^ k) << 2, __float_as_int(v))); }
__device__ __forceinline__ float dppf(float v, const int ctrl_sel) {
    int r;
    if (ctrl_sel == 0) r = __builtin_amdgcn_update_dpp(0, __float_as_int(v), 0xB1, 0xf, 0xf, true);
    else if (ctrl_sel == 1) r = __builtin_amdgcn_update_dpp(0, __float_as_int(v), 0x4E, 0xf, 0xf, true);
    else if (ctrl_sel == 2) r = __builtin_amdgcn_update_dpp(0, __float_as_int(v), 0x124, 0xf, 0xf, true);
    else r = __builtin_amdgcn_update_dpp(0, __float_as_int(v), 0x128, 0xf, 0xf, true);
    return __int_as_float(r);
}
__device__ __forceinline__ float row16_max(float v) { v = fmaxf(v, dppf(v, 0)); v = fmaxf(v, dppf(v, 1)); v = fmaxf(v, dppf(v, 2)); v = fmaxf(v, dppf(v, 3)); return v; }
__device__ __forceinline__ float row16_sum(float v) { v += dppf(v, 0); v += dppf(v, 1); v += dppf(v, 2); v += dppf(v, 3); return v; }

__device__ __forceinline__ void store4bf(bf16_t* p, f32x4 v) { u32x2 o; o.x = pk2(v[0], v[1]); o.y = pk2(v[2], v[3]); *(u32x2*)p = o; }
__device__ __forceinline__ f32x4 load4bf(const bf16_t* p) { u32x2 w = *(const u32x2*)p; f32x4 r; r[0] = blo(w.x); r[1] = bhi(w.x); r[2] = blo(w.y); r[3] = bhi(w.y); return r; }
#define MFMA16(a, b, c) __builtin_amdgcn_mfma_f32_16x16x32_bf16((a), (b), (c), 0, 0, 0)
#define WAIT_V0() asm volatile("s_waitcnt vmcnt(0)" ::: "memory")
#define WAIT_L0() asm volatile("s_waitcnt lgkmcnt(0)" ::: "memory")

__device__ __forceinline__ int lds_byte2(int r, int c) { int st = (r >> 4) * 2 + (c >> 5), ob = (r & 15) * 64 + (c & 31) * 2; return st * 1024 + (ob ^ (((ob >> 9) & 1) << 5)); }
__device__ __forceinline__ void stage_rc2(int b, int& R, int& C) { int st = b >> 10, sb = b & 1023, swz = sb ^ (((sb >> 9) & 1) << 5); R = (st >> 1) * 16 + swz / 64; C = (st & 1) * 32 + (swz % 64) / 2; }

#define ROWOFF(wr, mi) ((((mi) >> 2) * 128) + (wr) * 64 + (((mi) & 3) * 16))
__device__ __forceinline__ void gemm256(LAS char* lds, const bf16_t* __restrict__ Ab, int lda, const bf16_t* __restrict__ Bb, int ldb, int K, f32x4 (&acc)[8][4], bool zero_acc = true) {
    int tid = threadIdx.x; asm volatile("" : "+v"(tid));
    const int wid = tid >> 6, lane = tid & 63, wr = wid >> 2, wc = wid & 3, fr = lane & 15, fq = lane >> 4;
    unsigned voA[2], voB[2];
#pragma unroll
    for (int i = 0; i < 2; ++i) {
        int R, C; stage_rc2(tid * 16 + i * 8192, R, C);
        voA[i] = (unsigned)(R * lda + C) * 2u;
        { const int rho = R & 31; voB[i] = (unsigned)(((R >> 5) * 64 + 8 * ((rho & 15) >> 2) + 4 * (rho >> 4) + (rho & 3)) * ldb + C) * 2u; }
    }
    const int swz = fr * 64 + ((fq * 16) ^ ((fr >> 3) << 5));
    const int aoff = wr * 8192 + swz, boff = wc * 4096 + swz, ldsw = wid * 1024;
    const size_t ahalf = (size_t)128 * lda * 2, bhalf = (size_t)32 * ldb * 2;
    if (zero_acc) {
#pragma unroll
        for (int m = 0; m < 8; ++m)
#pragma unroll
            for (int n = 0; n < 4; ++n) acc[m][n] = (f32x4){0.f, 0.f, 0.f, 0.f};
    }
#define SAo(b, h) (((b) * 2 + (h)) * 16384)
#define SBo(b, h) ((4 + (b) * 2 + (h)) * 16384)
#define STAGE_A(b, h, kt) do { const char* g_ = (const char*)Ab + (h) * ahalf + (size_t)(kt) * 128; _Pragma("unroll") for (int i_ = 0; i_ < 2; ++i_) \
        __builtin_amdgcn_global_load_lds((const unsigned*)(g_ + voA[i_]), (LAS unsigned*)(lds + SAo(b, h) + ldsw + i_ * 8192), 16, 0, 0); } while (0)
#define STAGE_B(b, h, kt) do { const char* g_ = (const char*)Bb + (h) * bhalf + (size_t)(kt) * 128; _Pragma("unroll") for (int i_ = 0; i_ < 2; ++i_) \
        __builtin_amdgcn_global_load_lds((const unsigned*)(g_ + voB[i_]), (LAS unsigned*)(lds + SBo(b, h) + ldsw + i_ * 8192), 16, 0, 0); } while (0)
#define LDA(dst, b, h) _Pragma("unroll") for (int m_ = 0; m_ < 4; ++m_) _Pragma("unroll") for (int k_ = 0; k_ < 2; ++k_) \
        dst[m_][k_] = *(const LAS bf16x8*)(lds + SAo(b, h) + aoff + m_ * 2048 + k_ * 1024)
#define LDB(dst, b, h) _Pragma("unroll") for (int n_ = 0; n_ < 2; ++n_) _Pragma("unroll") for (int k_ = 0; k_ < 2; ++k_) \
        dst[n_][k_] = *(const LAS bf16x8*)(lds + SBo(b, h) + boff + n_ * 2048 + k_ * 1024)
#define MMA(ai, bj, A_, B_) do { __builtin_amdgcn_s_setprio(1); \
        _Pragma("unroll") for (int m_ = 0; m_ < 4; ++m_) _Pragma("unroll") for (int n_ = 0; n_ < 2; ++n_) _Pragma("unroll") for (int k_ = 0; k_ < 2; ++k_) \
            acc[(ai) * 4 + m_][(bj) * 2 + n_] = MFMA16(B_[n_][k_], A_[m_][k_], acc[(ai) * 4 + m_][(bj) * 2 + n_]); \
        __builtin_amdgcn_s_setprio(0); } while (0)
#define WAIT_V(n) asm volatile("s_waitcnt vmcnt(" #n ")" ::: "memory")
#define WAIT_L(n) asm volatile("s_waitcnt lgkmcnt(" #n ")" ::: "memory")
#define BAR __builtin_amdgcn_s_barrier()
#define SCHED __builtin_amdgcn_sched_barrier(0)
    bf16x8 At[4][2], B0[2][2], B1[2][2];
    const int nt = K >> 6;
    __syncthreads();
    STAGE_B(0, 0, 0); STAGE_A(0, 0, 0); STAGE_B(0, 1, 0); STAGE_A(0, 1, 0);
    if (wr == 1) BAR;
    WAIT_V(4); BAR;
    STAGE_B(1, 0, 1); STAGE_A(1, 0, 1); STAGE_B(1, 1, 1);
    WAIT_V(6); BAR;
    for (int t = 0; t < nt - 2; t += 2) {
        LDB(B0, 0, 0); SCHED; LDA(At, 0, 0); STAGE_A(1, 1, t + 1);
        WAIT_L(8); BAR; WAIT_L(0); MMA(0, 0, At, B0); BAR; SCHED;
        LDB(B1, 0, 1); STAGE_B(0, 0, t + 2);
        BAR; WAIT_L(0); MMA(0, 1, At, B1); BAR;
        LDA(At, 0, 1); STAGE_A(0, 0, t + 2);
        BAR; WAIT_L(0); MMA(1, 0, At, B0); BAR; SCHED;
        STAGE_B(0, 1, t + 2);
        WAIT_V(6); BAR; MMA(1, 1, At, B1); BAR;
        LDB(B0, 1, 0); SCHED; LDA(At, 1, 0); STAGE_A(0, 1, t + 2);
        WAIT_L(8); BAR; WAIT_L(0); MMA(0, 0, At, B0); BAR; SCHED;
        LDB(B1, 1, 1); STAGE_B(1, 0, t + 3);
        BAR; WAIT_L(0); MMA(0, 1, At, B1); BAR;
        LDA(At, 1, 1); STAGE_A(1, 0, t + 3);
        BAR; WAIT_L(0); MMA(1, 0, At, B0); BAR; SCHED;
        STAGE_B(1, 1, t + 3);
        WAIT_V(6); BAR; MMA(1, 1, At, B1); BAR;
    }
    { LDB(B0, 0, 0); LDA(At, 0, 0); STAGE_A(1, 1, nt - 1);
      BAR; WAIT_L(0); MMA(0, 0, At, B0); BAR;
      LDB(B1, 0, 1); BAR; WAIT_L(0); MMA(0, 1, At, B1); BAR;
      LDA(At, 0, 1); WAIT_V(4); BAR; WAIT_L(0); MMA(1, 0, At, B0); MMA(1, 1, At, B1); BAR; }
    { LDB(B0, 1, 0); LDA(At, 1, 0); WAIT_V(2); BAR; WAIT_L(0); MMA(0, 0, At, B0); BAR;
      LDB(B1, 1, 1); WAIT_V(0); BAR; WAIT_L(0); MMA(0, 1, At, B1); BAR;
      LDA(At, 1, 1); BAR; WAIT_L(0); MMA(1, 0, At, B0); MMA(1, 1, At, B1); BAR; }
    if (wr == 0) BAR;
#undef SAo
#undef SBo
#undef STAGE_A
#undef STAGE_B
#undef LDA
#undef LDB
#undef MMA
#undef WAIT_V
#undef WAIT_L
#undef BAR
#undef SCHED
}
#define OPAQUE_WS(name) char* name = get_kp()->ws
#define EPI_IDS int tid_ = threadIdx.x; asm volatile("" : "+v"(tid_)); const int wid_ = tid_ >> 6, lane_ = tid_ & 63, wr_ = wid_ >> 2, wc_ = wid_ & 3, fr_ = lane_ & 15, fq_ = lane_ >> 4

__device__ __forceinline__ void tile_map(int L, int nM, int nN, int& pm, int& pn) {
    const int nwg = nM * nN; int wgid = L;
    { const int q = nwg / 8, r = nwg % 8, xcd = wgid % 8, off = wgid / 8; wgid = (xcd < r ? xcd * (q + 1) : r * (q + 1) + (xcd - r) * q) + off; }
    const int nig = 8 * nN, gid = wgid / nig, fm = gid * 8, gsz = (nM - fm) < 8 ? (nM - fm) : 8;
    pm = fm + ((wgid % nig) % gsz); pn = (wgid % nig) / gsz;
}

__device__ __forceinline__ void store8bf(bf16_t* p, f32x4 v0, f32x4 v1) { u32x4 o; o.x = pk2(v0[0], v0[1]); o.y = pk2(v0[2], v0[3]); o.z = pk2(v1[0], v1[1]); o.w = pk2(v1[2], v1[3]); *(u32x4*)p = o; }
__device__ __forceinline__ void load8bf(const bf16_t* p, f32x4& v0, f32x4& v1) { const u32x4 w = *(const u32x4*)p; v0[0] = blo(w.x); v0[1] = bhi(w.x); v0[2] = blo(w.y); v0[3] = bhi(w.y); v1[0] = blo(w.z); v1[1] = bhi(w.z); v1[2] = blo(w.w); v1[3] = bhi(w.w); }
__device__ __forceinline__ f32x4 silu4(f32x4 v) { f32x4 o; for (int j = 0; j < 4; ++j) o[j] = v[j] * sigmoidf_(v[j]); return o; }
__device__ __forceinline__ f32x4 sigm4(f32x4 v) { f32x4 o; for (int j = 0; j < 4; ++j) o[j] = sigmoidf_(v[j]); return o; }
__device__ __forceinline__ float sq4(f32x4 v) { return v[0] * v[0] + v[1] * v[1] + v[2] * v[2] + v[3] * v[3]; }

struct EpiProj {
    bf16_t* proj; bf16_t* krope; float* rsq; const float *cosr, *sinr, *cosm, *sinm; int brow, bcol;
    __device__ __forceinline__ void operator()(f32x4 (&acc)[8][4], int wr, int wc, int fr, int fq) const {
        const int c0 = bcol + wc * 64;
        int type;
        if (bcol < 1024) type = 0; else if (bcol < 2048) type = 1; else if (bcol < 3072) type = 2; else if (bcol < 4096) type = 3;
        else if (bcol < 5120) type = 2; else if (bcol < 6144) type = 3; else if (bcol < 7168) type = 4; else if (bcol < 8192) type = 3;
        else if (bcol < 14336) type = 5; else type = 6;
#pragma unroll
        for (int m = 0; m < 8; ++m) {
            const int t = brow + ROWOFF(wr, m) + fr;
            bf16_t* rowp = proj + (size_t)t * LDP + c0 + 8 * fq;
            if (type == 0 || type == 1) {
                const int blk = (c0 >> 6) & 1; const float sc = type == 0 ? RQSCALE : 1.0f;
                f32x4 o1[2], o2[2];
#pragma unroll
                for (int n = 0; n < 2; ++n) {
                    const int f0 = 32 * blk + 8 * fq + 4 * n;
                    const f32x4 cs = *(const f32x4*)(cosr + (size_t)t * 64 + f0), sn = *(const f32x4*)(sinr + (size_t)t * 64 + f0);
                    const f32x4 x1 = acc[m][n], x2 = acc[m][n + 2];
                    o1[n] = (x1 * cs - x2 * sn) * sc; o2[n] = (x2 * cs + x1 * sn) * sc;
                }
                store8bf(rowp, o1[0], o1[1]); store8bf(rowp + 32, o2[0], o2[1]);
            } else if (type == 2) {
                store8bf(rowp, acc[m][0], acc[m][1]); store8bf(rowp + 32, acc[m][2], acc[m][3]);
            } else if (type == 3) {
                store8bf(rowp, silu4(acc[m][0]), silu4(acc[m][1])); store8bf(rowp + 32, silu4(acc[m][2]), silu4(acc[m][3]));
            } else if (type == 4) {
                float s = sq4(acc[m][0]) + sq4(acc[m][1]) + sq4(acc[m][2]) + sq4(acc[m][3]);
                store8bf(rowp, acc[m][0], acc[m][1]); store8bf(rowp + 32, acc[m][2], acc[m][3]);
                { const int ln_ = fq * 16 + fr; s += shx(s, ln_, 16); s += shx(s, ln_, 32); }
                if (fq == 0) rsq[(size_t)t * 16 + ((c0 - 6144) >> 6)] = s;
            } else if (type == 5) {
                store8bf(rowp, sigm4(acc[m][0]), sigm4(acc[m][1])); store8bf(rowp + 32, sigm4(acc[m][2]), sigm4(acc[m][3]));
            } else {
                if (wc == 0) {
                    f32x4 o1[2], o2[2];
#pragma unroll
                    for (int n = 0; n < 2; ++n) {
                        const int f0 = 8 * fq + 4 * n;
                        const f32x4 cs = *(const f32x4*)(cosm + (size_t)t * 32 + f0), sn = *(const f32x4*)(sinm + (size_t)t * 32 + f0);
                        const f32x4 x1 = acc[m][n], x2 = acc[m][n + 2];
                        o1[n] = x1 * cs - x2 * sn; o2[n] = x2 * cs + x1 * sn;
                    }
                    store8bf(krope + (size_t)t * 64 + 8 * fq, o1[0], o1[1]); store8bf(krope + (size_t)t * 64 + 32 + 8 * fq, o2[0], o2[1]);
                }
            }
        }
    }
};

struct EpiQ {
    bf16_t* qm; const float* rsq; const float *cosm, *sinm; int brow, bcol;
    __device__ __forceinline__ void operator()(f32x4 (&acc)[8][4], int wr, int wc, int fr, int fq) const {
        const int c0 = bcol + wc * 64, head = c0 / 192, within = c0 - head * 192;
        float rsv[8];
#pragma unroll
        for (int m = 0; m < 8; ++m) {
            const int t = brow + ROWOFF(wr, m) + fr;
            const f32x4 r0 = *(const f32x4*)(rsq + (size_t)t * 16), r1 = *(const f32x4*)(rsq + (size_t)t * 16 + 4);
            const float ss = r0[0] + r0[1] + r0[2] + r0[3] + r1[0] + r1[1] + r1[2] + r1[3];
            rsv[m] = rsqrtf(ss * (1.0f / 512.0f) + EPS) * QSCALE;
        }
#pragma unroll
        for (int m = 0; m < 8; ++m) {
            const int t = brow + ROWOFF(wr, m) + fr, b = t >> 11, s = t & 2047;
            const float rs = rsv[m];
            bf16_t* base = qm + ((size_t)((b * 8 + head) * 2048 + s)) * 192 + within + 8 * fq;
            if (within != 128) {
                store8bf(base, acc[m][0] * rs, acc[m][1] * rs); store8bf(base + 32, acc[m][2] * rs, acc[m][3] * rs);
            } else {
                f32x4 o1[2], o2[2];
#pragma unroll
                for (int n = 0; n < 2; ++n) {
                    const int f0 = 8 * fq + 4 * n;
                    const f32x4 cs = *(const f32x4*)(cosm + (size_t)t * 32 + f0), sn = *(const f32x4*)(sinm + (size_t)t * 32 + f0);
                    const f32x4 x1 = acc[m][n] * rs, x2 = acc[m][n + 2] * rs;
                    o1[n] = x1 * cs - x2 * sn; o2[n] = x2 * cs + x1 * sn;
                }
                store8bf(base, o1[0], o1[1]); store8bf(base + 32, o2[0], o2[1]);
            }
        }
    }
};

struct EpiKV {
    bf16_t* kn; bf16_t* vt; const float* rsq; int brow, head;
    __device__ __forceinline__ void operator()(f32x4 (&acc)[8][4], int wr, int wc, int fr, int fq) const {
        float rsv[8];
#pragma unroll
        for (int m = 0; m < 8; ++m) {
            const int t = brow + ROWOFF(wr, m) + fr;
            const f32x4 r0 = *(const f32x4*)(rsq + (size_t)t * 16 + 8), r1 = *(const f32x4*)(rsq + (size_t)t * 16 + 12);
            const float ss = r0[0] + r0[1] + r0[2] + r0[3] + r1[0] + r1[1] + r1[2] + r1[3];
            rsv[m] = rsqrtf(ss * (1.0f / 512.0f) + EPS);
        }
#pragma unroll
        for (int m = 0; m < 8; ++m) {
            const int t = brow + ROWOFF(wr, m) + fr, b = t >> 11, s = t & 2047;
            const float rs = rsv[m];
            if (wc < 2) {
                bf16_t* base = kn + ((size_t)((b * 8 + head) * 2048 + s)) * 128 + wc * 64 + 8 * fq;
                store8bf(base, acc[m][0] * rs, acc[m][1] * rs); store8bf(base + 32, acc[m][2] * rs, acc[m][3] * rs);
            } else {
#pragma unroll
                for (int n = 0; n < 4; ++n)
#pragma unroll
                    for (int j = 0; j < 4; j += 2) {
                        const int d = (wc - 2) * 64 + (n >> 1) * 32 + 8 * fq + 4 * (n & 1) + j;
                        const unsigned pv_ = pk2(acc[m][n][j] * rs, acc[m][n][j + 1] * rs);
                        vt[((size_t)((b * 8 + head) * 128 + d)) * 2048 + s] = (bf16_t)pv_;
                        vt[((size_t)((b * 8 + head) * 128 + d + 1)) * 2048 + s] = (bf16_t)(pv_ >> 16);
                    }
            }
        }
    }
};

struct EpiBranch {
    const bf16_t* gates; bf16_t* merged; int mode, brow, bcol;
    __device__ __forceinline__ void operator()(f32x4 (&acc)[8][4], int wr, int wc, int fr, int fq) const {
        const int col0 = bcol + wc * 64 + 8 * fq;
        const size_t t0 = (size_t)(brow + fr);
#pragma unroll
        for (int m = 0; m < 8; ++m) {
            const size_t t = t0 + ROWOFF(wr, m);
#pragma unroll
            for (int bj = 0; bj < 2; ++bj) {
                const bf16_t* gp = gates + t * LDP + col0 + bj * 32 + mode * 2048;
                f32x4 g0, g1; load8bf(gp, g0, g1);
                if (mode != 2) {
                    f32x4 h0, h1; load8bf(gp + 2048, h0, h1);
#pragma unroll
                    for (int j = 0; j < 4; ++j) {
                        acc[m][2 * bj][j] *= g0[j] * __builtin_amdgcn_rcpf(fmaxf(h0[j], 1e-30f));
                        acc[m][2 * bj + 1][j] *= g1[j] * __builtin_amdgcn_rcpf(fmaxf(h1[j], 1e-30f));
                    }
                } else {
                    store8bf(merged + t * D + col0 + bj * 32, acc[m][2 * bj] * g0, acc[m][2 * bj + 1] * g1);
                }
            }
        }
    }
};

struct EpiOut {
    bf16_t* y; int brow, bcol;
    __device__ __forceinline__ void operator()(f32x4 (&acc)[8][4], int wr, int wc, int fr, int fq) const {
#pragma unroll
        for (int m = 0; m < 8; ++m) {
            const int t = brow + ROWOFF(wr, m) + fr;
            bf16_t* yp = y + (size_t)t * D + bcol + wc * 64 + 8 * fq;
            store8bf(yp, acc[m][0], acc[m][1]); store8bf(yp + 32, acc[m][2], acc[m][3]);
        }
    }
};

__device__ __forceinline__ int win_map(int np) {
    if (np < 2048) { const int base = np & ~127, p = np & 127, blk = p >> 6, half = (p >> 5) & 1, r = p & 31; return base + 32 * blk + 64 * half + r; }
    if (np < 7168) return np;
    if (np < 14336) return np + 64;
    if (np < 14400) return 7168 + (np - 14336);
    return -1;
}

struct ConvArgs { const float* src; const float* gain; bf16_t* dst; int ld, Kt, k0, np0, wmap; };
__device__ __forceinline__ ConvArgs conv_decode(KP p, int ci) {
    char* ws = p->ws;
    constexpr int NCONV_L = 1824 + 48 + 64 + 384 + 256 + 8 + 8;
    ConvArgs a; const int l = ci / NCONV_L; ci -= l * NCONV_L; a.gain = nullptr; a.wmap = 0;
    if (ci < 1824) { const int nt = ci % 114, kt = ci / 114; a.src = p->in[7] + (size_t)l * 2048 * NIN; a.ld = NIN; a.Kt = 2048; a.k0 = kt * 128; a.np0 = nt * 128; a.wmap = 1; a.dst = (bf16_t*)(ws + WS_WI) + (size_t)l * NP1 * 2048; }
    else if ((ci -= 1824) < 48) { const int nt = ci % 12, kt = ci / 12; a.src = p->in[17] + (size_t)l * 512 * 1536; a.ld = 1536; a.Kt = 512; a.k0 = kt * 128; a.np0 = nt * 128; a.gain = p->in[16] + l * 512; a.dst = (bf16_t*)(ws + WS_WUQ) + (size_t)l * 1536 * 512; }
    else if ((ci -= 48) < 64) { const int nt = ci % 16, kt = ci / 16; a.src = p->in[19] + (size_t)l * 512 * 2048; a.ld = 2048; a.Kt = 512; a.k0 = kt * 128; a.np0 = nt * 128; a.gain = p->in[18] + l * 512; a.dst = (bf16_t*)(ws + WS_WUKV) + (size_t)l * 2048 * 512; }
    else if ((ci -= 64) < 384) { const int nt = ci % 16, kt = ci / 16; a.src = p->in[20] + (size_t)l * 3072 * 2048; a.ld = 2048; a.Kt = 3072; a.k0 = kt * 128; a.np0 = nt * 128; a.dst = (bf16_t*)(ws + WS_WB) + (size_t)l * 2048 * 3072; }
    else if ((ci -= 384) < 256) { const int nt = ci % 16, kt = ci / 16; a.src = p->in[21] + (size_t)l * 2048 * 2048; a.ld = 2048; a.Kt = 2048; a.k0 = kt * 128; a.np0 = nt * 128; a.dst = (bf16_t*)(ws + WS_WO) + (size_t)l * 2048 * 2048; }
    else if ((ci -= 256) < 8) { a.src = p->in[11] + (size_t)(l * 8 + ci) * 16384; a.ld = 128; a.Kt = 128; a.k0 = 0; a.np0 = 0; a.dst = (bf16_t*)(ws + WS_WA) + (size_t)(l * 8 + ci) * 16384; }
    else { ci -= 8; a.src = p->in[13] + (size_t)(l * 8 + ci) * 16384; a.ld = 128; a.Kt = 128; a.k0 = 0; a.np0 = 0; a.dst = (bf16_t*)(ws + WS_WX) + (size_t)(l * 8 + ci) * 16384; }
    return a;
}
__device__ __forceinline__ void conv_load(const ConvArgs& c, int tid, f32x4 (&a)[4], f32x4 (&b)[4]) {
    const int c8 = (tid & 15) * 8, np = c.np0 + c8;
    const int n = c.wmap ? win_map(np) : np;
#pragma unroll
    for (int r = 0; r < 4; ++r) {
        const int kl = (tid >> 4) + 32 * r;
        a[r] = (f32x4){0.f, 0.f, 0.f, 0.f}; b[r] = a[r];
        if (n >= 0) { const float* sp = c.src + (size_t)(c.k0 + kl) * c.ld + n; a[r] = __builtin_nontemporal_load((const f32x4*)sp); b[r] = __builtin_nontemporal_load((const f32x4*)(sp + 4)); }
    }
}
__device__ __forceinline__ void conv_finish(LAS char* lds, const ConvArgs& c, int tid, const f32x4 (&a)[4], const f32x4 (&b)[4]) {
    LAS bf16_t* tl = (LAS bf16_t*)lds;
    const int c8 = (tid & 15) * 8;
    __syncthreads();
#pragma unroll
    for (int r = 0; r < 4; ++r) {
        const int kl = (tid >> 4) + 32 * r;
        const float g = c.gain ? c.gain[c.k0 + kl] : 1.0f;
#pragma unroll
        for (int e = 0; e < 4; e += 2) {
            const unsigned pa_ = pk2(a[r][e] * g, a[r][e + 1] * g), pb_ = pk2(b[r][e] * g, b[r][e + 1] * g);
            tl[(c8 + e) * 130 + kl] = (bf16_t)pa_; tl[(c8 + e + 1) * 130 + kl] = (bf16_t)(pa_ >> 16);
            tl[(c8 + 4 + e) * 130 + kl] = (bf16_t)pb_; tl[(c8 + 5 + e) * 130 + kl] = (bf16_t)(pb_ >> 16);
        }
    }
    __syncthreads();
#pragma unroll
    for (int r = 0; r < 4; ++r) {
        const int nl = (tid >> 4) + 32 * r, kc = (tid & 15) * 8;
        const LAS unsigned* rp = (const LAS unsigned*)(tl + nl * 130 + kc);
        u32x4 o; o.x = rp[0]; o.y = rp[1]; o.z = rp[2]; o.w = rp[3];
        *(u32x4*)(c.dst + (size_t)(c.np0 + nl) * c.Kt + c.k0 + kc) = o;
    }
}

__device__ __forceinline__ void conv2(LAS char* lds, KP p, int base) {
    int tid = threadIdx.x; asm volatile("" : "+v"(tid));
    f32x4 a0[4], b0[4], a1[4], b1[4];
    const ConvArgs c0 = conv_decode(p, base), c1 = conv_decode(p, base + 1);
    conv_load(c0, tid, a0, b0); conv_load(c1, tid, a1, b1);
    conv_finish(lds, c0, tid, a0, b0);
    conv_finish(lds, c1, tid, a1, b1);
}
__device__ __forceinline__ void conv4(LAS char* lds, KP p, int base) {
    int tid = threadIdx.x; asm volatile("" : "+v"(tid));
    f32x4 a0[4], b0[4], a1[4], b1[4];
    ConvArgs c0 = conv_decode(p, base), c1 = conv_decode(p, base + 1);
    conv_load(c0, tid, a0, b0); conv_load(c1, tid, a1, b1);
    conv_finish(lds, c0, tid, a0, b0);
    c0 = conv_decode(p, base + 2); conv_load(c0, tid, a0, b0);
    conv_finish(lds, c1, tid, a1, b1);
    c1 = conv_decode(p, base + 3); conv_load(c1, tid, a1, b1);
    conv_finish(lds, c0, tid, a0, b0);
    conv_finish(lds, c1, tid, a1, b1);
}

__device__ void phase0(LAS char* lds, KP p) {
    char* ws = p->ws;
    int tid = threadIdx.x; asm volatile("" : "+v"(tid)); const int wid = tid >> 6, lane = tid & 63;
    constexpr int NCONV_L = 1824 + 48 + 64 + 384 + 256 + 8 + 8;
    constexpr int N_ADA = 384, N_ROPE = 128, N_ITEMS = N_ADA + N_ROPE;
    for (int it = blockIdx.x; it < N_ITEMS; it += gridDim.x) {
        if (it < N_ADA) {
            const int l = it / 96, j0 = (it % 96) * 64;
            LAS float* cact = (LAS float*)lds;
            LAS float* red = (LAS float*)(lds + 32768);
            __syncthreads();
            for (int i = tid; i < 8192; i += 512) { const float v = p->in[1][i]; cact[i] = v * sigmoidf_(v); }
            __syncthreads();
            const int cg = lane & 15, kq = lane >> 4;
            const float* wp = p->in[3] + (size_t)l * 2048 * 6144 + j0 + 4 * cg;
            f32x4 a0 = (f32x4){0.f, 0.f, 0.f, 0.f}, a1 = a0, a2 = a0, a3 = a0;
#pragma unroll 16
            for (int j = 0; j < 64; ++j) {
                const int k = wid * 256 + 4 * j + kq;
                const f32x4 w = *(const f32x4*)(wp + (size_t)k * 6144);
                a0 += w * cact[k]; a1 += w * cact[2048 + k]; a2 += w * cact[4096 + k]; a3 += w * cact[6144 + k];
            }
#pragma unroll
            for (int e = 0; e < 4; ++e) {
                a0[e] += shx(a0[e], lane, 16); a0[e] += shx(a0[e], lane, 32); a1[e] += shx(a1[e], lane, 16); a1[e] += shx(a1[e], lane, 32);
                a2[e] += shx(a2[e], lane, 16); a2[e] += shx(a2[e], lane, 32); a3[e] += shx(a3[e], lane, 16); a3[e] += shx(a3[e], lane, 32);
            }
            if (kq == 0) {
                *(LAS f32x4*)(red + (wid * 4 + 0) * 64 + 4 * cg) = a0; *(LAS f32x4*)(red + (wid * 4 + 1) * 64 + 4 * cg) = a1;
                *(LAS f32x4*)(red + (wid * 4 + 2) * 64 + 4 * cg) = a2; *(LAS f32x4*)(red + (wid * 4 + 3) * 64 + 4 * cg) = a3;
            }
            __syncthreads();
            if (tid < 256) {
                const int b = tid >> 6, jl = tid & 63; float s = 0.f;
#pragma unroll
                for (int w = 0; w < 8; ++w) s += red[(w * 4 + b) * 64 + jl];
                ((float*)(ws + WS_MOD))[(size_t)(l * 4 + b) * 6144 + j0 + jl] = s + p->in[4][(size_t)l * 6144 + j0 + jl];
            }
        } else if (it < N_ADA + N_ROPE) {
            const int t0 = (it - N_ADA) * 64;
            for (int e = tid; e < 64 * 96; e += 512) {
                const int tl = e / 96, f = e % 96, t = t0 + tl;
                const float pos = (float)p->pos[t];
                float invf; if (f < 64) invf = exp2f(-(float)(2 * f) * (1.0f / 128.0f) * 13.287712379549449f); else invf = exp2f(-(float)(2 * (f - 64)) * (1.0f / 64.0f) * 13.287712379549449f);
                const float ang = pos * invf;
                double rev = (double)ang * 0.15915494309189535; rev -= rint(rev);
                const float rv = (float)rev;
                const float sn = __builtin_amdgcn_sinf(rv), cs = __builtin_amdgcn_cosf(rv);
                if (f < 64) { ((float*)(ws + WS_COSR))[(size_t)t * 64 + f] = cs; ((float*)(ws + WS_SINR))[(size_t)t * 64 + f] = sn; }
                else { ((float*)(ws + WS_COSM))[(size_t)t * 32 + f - 64] = cs; ((float*)(ws + WS_SINM))[(size_t)t * 32 + f - 64] = sn; }
            }
        }
    }
    {
        constexpr int NCONV = NCONV_L;
        int ci = blockIdx.x;
        f32x4 a0[4], b0[4], a1[4], b1[4];
        ConvArgs c0 = conv_decode(p, ci < NCONV ? ci : 0), c1 = c0;
        if (ci < NCONV) conv_load(c0, tid, a0, b0);
        while (ci < NCONV) {
            const int cn = ci + gridDim.x, cnn = cn + gridDim.x;
            if (cn < NCONV) { c1 = conv_decode(p, cn); conv_load(c1, tid, a1, b1); }
            conv_finish(lds, c0, tid, a0, b0);
            if (cn >= NCONV) break;
            if (cnn < NCONV) { c0 = conv_decode(p, cnn); conv_load(c0, tid, a0, b0); }
            conv_finish(lds, c1, tid, a1, b1);
            ci = cnn;
        }
    }
}

__device__ __forceinline__ float wave_sum(float v, int lane) {
    v = row16_sum(v); v += shx(v, lane, 16); v += shx(v, lane, 32); return v;
}
__device__ void rowpass(KP p, int l  ) {
    char* ws = p->ws;
    int tid = threadIdx.x; asm volatile("" : "+v"(tid));
    const int lane = tid & 63, gw = blockIdx.x * 8 + (tid >> 6), nw = gridDim.x * 8;
    const float* mod = (const float*)(ws + WS_MOD);
    float* xcur = (float*)(ws + WS_XCUR);
    const bf16_t* ybuf = (const bf16_t*)(ws + WS_YBUF);
    bf16_t* hbuf = (bf16_t*)(ws + WS_HBUF);
    for (int g4 = gw; g4 < T / 4; g4 += nw) {
        const int r0 = g4 * 4, b = r0 >> 11;
        f32x4 pa[8], pb[8], pc[8];
        if (l >= 0) {
#pragma unroll
            for (int i = 0; i < 8; ++i) {
                const int c = i * 256 + lane * 4;
                pa[i] = (*(const f32x4*)(mod + (size_t)(l * 4 + b) * 6144 + 4096 + c) + 1.0f) * *(const f32x4*)(p->in[6] + (size_t)l * D + c);
            }
        }
        if (l < DEPTH - 1) {
            const int ln = l + 1;
#pragma unroll
            for (int i = 0; i < 8; ++i) {
                const int c = i * 256 + lane * 4;
                pb[i] = (*(const f32x4*)(mod + (size_t)(ln * 4 + b) * 6144 + 2048 + c) + 1.0f) * *(const f32x4*)(p->in[5] + (size_t)ln * D + c);
                pc[i] = *(const f32x4*)(mod + (size_t)(ln * 4 + b) * 6144 + c);
            }
        }
        const float* xprev = (l <= 0) ? p->in[0] : xcur;
        float* dst = (l == DEPTH - 1) ? p->out : xcur;
#pragma unroll 1
        for (int rr = 0; rr < 4; ++rr) {
            const int row = r0 + rr;
            f32x4 xv[8], yv[8];
#pragma unroll
            for (int i = 0; i < 8; ++i) {
                xv[i] = *(const f32x4*)(xprev + (size_t)row * D + i * 256 + lane * 4);
                if (l >= 0) yv[i] = load4bf(ybuf + (size_t)row * D + i * 256 + lane * 4);
            }
            if (l >= 0) {
                float ss = 0.f;
#pragma unroll
                for (int i = 0; i < 8; ++i) ss += yv[i][0] * yv[i][0] + yv[i][1] * yv[i][1] + yv[i][2] * yv[i][2] + yv[i][3] * yv[i][3];
                ss = wave_sum(ss, lane);
                const float rs = rsqrtf(ss * (1.0f / D) + EPS);
#pragma unroll
                for (int i = 0; i < 8; ++i) {
                    xv[i] = xv[i] + pa[i] * (yv[i] * rs);
                    *(f32x4*)(dst + (size_t)row * D + i * 256 + lane * 4) = xv[i];
                }
            }
            if (l < DEPTH - 1) {
                float ss = 0.f;
#pragma unroll
                for (int i = 0; i < 8; ++i) ss += xv[i][0] * xv[i][0] + xv[i][1] * xv[i][1] + xv[i][2] * xv[i][2] + xv[i][3] * xv[i][3];
                ss = wave_sum(ss, lane);
                const float rs = rsqrtf(ss * (1.0f / D) + EPS);
#pragma unroll
                for (int i = 0; i < 8; ++i) store4bf(hbuf + (size_t)row * D + i * 256 + lane * 4, xv[i] * rs * pb[i] + pc[i]);
            }
        }
    }
}

__device__ __forceinline__ int tix(int row, int col) { return row * 72 + (col ^ (((row >> 3) & 3) << 4)); }
template <bool OUT>
__device__ void ret_item(LAS char* lds, KP p, int l, int item) {
    char* ws = p->ws;
    int tid = threadIdx.x; asm volatile("" : "+v"(tid)); const int wid = tid >> 6, lane = tid & 63, fr = lane & 15, fq = lane >> 4;
    const int g = item & 7, h = (item >> 3) & 7, b = item >> 6;
    LAS bf16_t* Qs = (LAS bf16_t*)(lds);
    LAS bf16_t* Ks = (LAS bf16_t*)(lds + 17408);
    LAS bf16_t* Kt = (LAS bf16_t*)(lds + 34816);
    LAS bf16_t* Vt = (LAS bf16_t*)(lds + 53248);
    LAS bf16_t* St = (LAS bf16_t*)(lds + 71680);
    LAS bf16_t* Ps = (LAS bf16_t*)(lds + 106496);
    LAS float* Os = (LAS float*)(lds);
    const bf16_t* proj = (const bf16_t*)(ws + WS_PROJ);
    float* tot = (float*)(ws + WS_TOT);
    const float gy = __builtin_amdgcn_exp2f(-5.0f - (float)h);
    const float lg2 = -gy * (1.0f + gy * (0.5f + gy * (0.33333334f + gy * (0.25f + gy * 0.2f)))) * 1.4426950408889634f;
    const float d64 = __builtin_amdgcn_exp2f(lg2 * 64.0f), d256 = __builtin_amdgcn_exp2f(lg2 * 256.0f);
    f32x4 sacc[8];
#pragma unroll
    for (int nf = 0; nf < 8; ++nf) sacc[nf] = (f32x4){0.f, 0.f, 0.f, 0.f};
    if (OUT) {
        float w = 1.0f;
        for (int gp = g - 1; gp >= 0; --gp) {
            const float* tp = tot + (size_t)((b * 8 + h) * 8 + gp) * 16384;
            float tv[8][4];
#pragma unroll
            for (int nf = 0; nf < 8; ++nf)
#pragma unroll
                for (int j = 0; j < 4; ++j) tv[nf][j] = tp[(16 * wid + 4 * fq + j) * 128 + 16 * nf + fr];
#pragma unroll
            for (int nf = 0; nf < 8; ++nf)
#pragma unroll
                for (int j = 0; j < 4; ++j) sacc[nf][j] += w * tv[nf][j];
            w *= d256;
        }
    }
    int li[2], lc[2];
#pragma unroll
    for (int r = 0; r < 2; ++r) { const int wt = wid + 8 * r; li[r] = 16 * (wt & 3) + (lane & 15); lc[r] = 8 * (4 * (wt >> 2) + (lane >> 4)); }
    if (!OUT) {
        LAS bf16_t* Kt2 = (LAS bf16_t*)(lds);
        LAS bf16_t* Vt2 = (LAS bf16_t*)(lds + 71680);
        u32x4 pk_[2][2], pv_[2][2];
#define RET_LOAD2(n_) do { _Pragma("unroll") for (int cc = 0; cc < 2; ++cc) { const int t0_ = b * 2048 + ((n_) + cc) * 64; _Pragma("unroll") for (int r = 0; r < 2; ++r) { \
            const bf16_t* rowp = proj + (size_t)(t0_ + li[r]) * LDP + h * 128 + lc[r]; \
            pk_[cc][r] = *(const u32x4*)(rowp + 1024); pv_[cc][r] = *(const u32x4*)(rowp + 2048); } } } while (0)
        RET_LOAD2(g * 4);
        for (int cp = 0; cp < 2; ++cp) {
            __syncthreads();
#pragma unroll
            for (int cc = 0; cc < 2; ++cc) {
                LAS bf16_t* Kd = cc ? Kt2 : Kt; LAS bf16_t* Vd = cc ? Vt2 : Vt;
#pragma unroll
                for (int r = 0; r < 2; ++r) {
                    const int i = li[r], c8 = lc[r];
                    const float dec = __builtin_amdgcn_exp2f(lg2 * (float)(63 - i));
#pragma unroll
                    for (int e = 0; e < 4; ++e) {
                        Kd[tix(c8 + 2 * e, i)] = f2bf(blo(pk_[cc][r][e]) * dec); Kd[tix(c8 + 2 * e + 1, i)] = f2bf(bhi(pk_[cc][r][e]) * dec);
                        Vd[tix(c8 + 2 * e, i)] = (bf16_t)(pv_[cc][r][e] & 0xffffu); Vd[tix(c8 + 2 * e + 1, i)] = (bf16_t)(pv_[cc][r][e] >> 16);
                    }
                }
            }
            if (cp == 0) RET_LOAD2(g * 4 + 2);
            __syncthreads();
#pragma unroll
            for (int cc = 0; cc < 2; ++cc) {
                const LAS bf16_t* Ks_ = cc ? Kt2 : Kt; const LAS bf16_t* Vs_ = cc ? Vt2 : Vt;
#pragma unroll
                for (int nf = 0; nf < 8; ++nf) sacc[nf] *= d64;
                __builtin_amdgcn_sched_barrier(0);
                {
                    bf16x8 va[2], kb[2][8];
#pragma unroll
                    for (int kk = 0; kk < 2; ++kk) {
                        va[kk] = *(const LAS bf16x8*)(Vs_ + tix(16 * wid + fr, kk * 32 + fq * 8));
#pragma unroll
                        for (int nf = 0; nf < 8; ++nf) kb[kk][nf] = *(const LAS bf16x8*)(Ks_ + tix(16 * nf + fr, kk * 32 + fq * 8));
                    }
#pragma unroll
                    for (int kk = 0; kk < 2; ++kk)
#pragma unroll
                        for (int nf = 0; nf < 8; ++nf) sacc[nf] = MFMA16(va[kk], kb[kk][nf], sacc[nf]);
                    __builtin_amdgcn_sched_group_barrier(0x100, 18, 0); __builtin_amdgcn_sched_group_barrier(0x008, 16, 0);
                }
                __builtin_amdgcn_sched_barrier(0);
            }
        }
#undef RET_LOAD2
        float* tp = tot + (size_t)item * 16384;
#pragma unroll
        for (int nf = 0; nf < 8; ++nf)
#pragma unroll
            for (int j = 0; j < 4; ++j) tp[(16 * wid + 4 * fq + j) * 128 + 16 * nf + fr] = sacc[nf][j];
        return;
    }
    u32x4 gq[2], gk[2], gv[2];
#define RET_LOAD(n_) do { const int t0_ = b * 2048 + (n_) * 64; _Pragma("unroll") for (int r = 0; r < 2; ++r) { \
        const bf16_t* rowp = proj + (size_t)(t0_ + li[r]) * LDP + h * 128 + lc[r]; \
        gk[r] = *(const u32x4*)(rowp + 1024); gv[r] = *(const u32x4*)(rowp + 2048); if (OUT) gq[r] = *(const u32x4*)(rowp); } } while (0)
    RET_LOAD(g * 4);
    const int ni = tid >> 3, npart = tid & 7, ncol = h * 128 + npart * 16;
    f32x4 gv4[4]; u32x4 sgp[2];
    if (OUT) {
#pragma unroll
        for (int e = 0; e < 4; ++e) gv4[e] = *(const f32x4*)(p->in[8] + (size_t)l * 1024 + ncol + e * 4);
    }
    for (int c = 0; c < 4; ++c) {
        const int n = g * 4 + c, t0 = b * 2048 + n * 64;
        if (OUT) { const bf16_t* gp_ = proj + (size_t)(t0 + ni) * LDP + 3072 + ncol; sgp[0] = *(const u32x4*)gp_; sgp[1] = *(const u32x4*)(gp_ + 8); }
        __syncthreads();
#pragma unroll
        for (int r = 0; r < 2; ++r) {
            const int i = li[r], c8 = lc[r];
            if (OUT) { *(LAS u32x4*)(Qs + i * 136 + c8) = gq[r]; *(LAS u32x4*)(Ks + i * 136 + c8) = gk[r]; }
            const float dec = __builtin_amdgcn_exp2f(lg2 * (float)(63 - i));
#pragma unroll
            for (int e = 0; e < 4; ++e) {
                Kt[tix(c8 + 2 * e, i)] = f2bf(blo(gk[r][e]) * dec); Kt[tix(c8 + 2 * e + 1, i)] = f2bf(bhi(gk[r][e]) * dec);
                Vt[tix(c8 + 2 * e, i)] = (bf16_t)(gv[r][e] & 0xffffu); Vt[tix(c8 + 2 * e + 1, i)] = (bf16_t)(gv[r][e] >> 16);
            }
        }
        if (OUT) {
#pragma unroll
            for (int nf = 0; nf < 8; ++nf)
#pragma unroll
                for (int j = 0; j < 4; ++j) St[(16 * wid + 4 * fq + j) * 136 + 16 * nf + fr] = f2bf(sacc[nf][j]);
        }
        if (c + 1 < 4) RET_LOAD(n + 1);
        __syncthreads();
        const int mf = wid & 3, nh = wid >> 2;
        f32x4 o1[4], o2[4];
#pragma unroll
        for (int nf = 0; nf < 4; ++nf) { o1[nf] = (f32x4){0.f, 0.f, 0.f, 0.f}; o2[nf] = (f32x4){0.f, 0.f, 0.f, 0.f}; }
        if (OUT) {
            f32x4 s2[2] = {(f32x4){0.f, 0.f, 0.f, 0.f}, (f32x4){0.f, 0.f, 0.f, 0.f}};
            {
                bf16x8 fa[4], fb0[4], fb1[4];
#pragma unroll
                for (int kk = 0; kk < 4; ++kk) {
                    fa[kk] = *(const LAS bf16x8*)(Qs + (16 * mf + fr) * 136 + kk * 32 + fq * 8);
                    fb0[kk] = *(const LAS bf16x8*)(Ks + (32 * nh + fr) * 136 + kk * 32 + fq * 8);
                    fb1[kk] = *(const LAS bf16x8*)(Ks + (32 * nh + 16 + fr) * 136 + kk * 32 + fq * 8);
                }
#pragma unroll
                for (int kk = 0; kk < 4; ++kk) { s2[0] = MFMA16(fa[kk], fb0[kk], s2[0]); s2[1] = MFMA16(fa[kk], fb1[kk], s2[1]); }
                __builtin_amdgcn_sched_group_barrier(0x100, 12, 0); __builtin_amdgcn_sched_group_barrier(0x008, 8, 0);
            }
            __builtin_amdgcn_sched_barrier(0);
#pragma unroll
            for (int nf = 0; nf < 2; ++nf)
#pragma unroll
                for (int j = 0; j < 4; ++j) {
                    const int i = 16 * mf + 4 * fq + j, jj = 32 * nh + 16 * nf + fr;
                    Ps[i * 72 + jj] = f2bf(s2[nf][j] * __builtin_amdgcn_exp2f(lg2 * fabsf((float)(i - jj))));
                }
            __builtin_amdgcn_sched_barrier(0);
            {
                bf16x8 qa[4], sb[4][4];
#pragma unroll
                for (int kk = 0; kk < 4; ++kk) {
                    qa[kk] = *(const LAS bf16x8*)(Qs + (16 * mf + fr) * 136 + kk * 32 + fq * 8);
#pragma unroll
                    for (int nf = 0; nf < 4; ++nf) sb[kk][nf] = *(const LAS bf16x8*)(St + (64 * nh + 16 * nf + fr) * 136 + kk * 32 + fq * 8);
                }
#pragma unroll
                for (int kk = 0; kk < 4; ++kk)
#pragma unroll
                    for (int nf = 0; nf < 4; ++nf) o2[nf] = MFMA16(qa[kk], sb[kk][nf], o2[nf]);
                __builtin_amdgcn_sched_group_barrier(0x100, 20, 0); __builtin_amdgcn_sched_group_barrier(0x008, 16, 0);
            }
            __builtin_amdgcn_sched_barrier(0);
        }
#pragma unroll
        for (int nf = 0; nf < 8; ++nf) sacc[nf] *= d64;
        __builtin_amdgcn_sched_barrier(0);
        {
            bf16x8 va[2], kb[2][8];
#pragma unroll
            for (int kk = 0; kk < 2; ++kk) {
                va[kk] = *(const LAS bf16x8*)(Vt + tix(16 * wid + fr, kk * 32 + fq * 8));
#pragma unroll
                for (int nf = 0; nf < 8; ++nf) kb[kk][nf] = *(const LAS bf16x8*)(Kt + tix(16 * nf + fr, kk * 32 + fq * 8));
            }
#pragma unroll
            for (int kk = 0; kk < 2; ++kk)
#pragma unroll
                for (int nf = 0; nf < 8; ++nf) sacc[nf] = MFMA16(va[kk], kb[kk][nf], sacc[nf]);
            __builtin_amdgcn_sched_group_barrier(0x100, 18, 0); __builtin_amdgcn_sched_group_barrier(0x008, 16, 0);
        }
        __builtin_amdgcn_sched_barrier(0);
        if (OUT) {
            __syncthreads();
            {
                bf16x8 pa[2], vb[2][4];
#pragma unroll
                for (int kk = 0; kk < 2; ++kk) {
                    pa[kk] = *(const LAS bf16x8*)(Ps + (16 * mf + fr) * 72 + kk * 32 + fq * 8);
#pragma unroll
                    for (int nf = 0; nf < 4; ++nf) vb[kk][nf] = *(const LAS bf16x8*)(Vt + tix(64 * nh + 16 * nf + fr, kk * 32 + fq * 8));
                }
#pragma unroll
                for (int kk = 0; kk < 2; ++kk)
#pragma unroll
                    for (int nf = 0; nf < 4; ++nf) o1[nf] = MFMA16(pa[kk], vb[kk][nf], o1[nf]);
                __builtin_amdgcn_sched_group_barrier(0x100, 10, 0); __builtin_amdgcn_sched_group_barrier(0x008, 8, 0);
            }
            __builtin_amdgcn_sched_barrier(0);
            __builtin_amdgcn_sched_barrier(0);
#pragma unroll
            for (int j = 0; j < 4; ++j) {
                const int i = 16 * mf + 4 * fq + j; const float dq = __builtin_amdgcn_exp2f(lg2 * (float)(i + 1));
#pragma unroll
                for (int nf = 0; nf < 4; ++nf) Os[i * 132 + 64 * nh + 16 * nf + fr] = o1[nf][j] + dq * o2[nf][j];
            }
        }
        if (OUT) {
            __syncthreads();
            const int i = tid >> 3, part = tid & 7, t = t0 + i;
            f32x4 v[4]; float sum = 0.f;
#pragma unroll
            for (int e = 0; e < 4; ++e) { v[e] = *(const LAS f32x4*)(Os + i * 132 + part * 16 + e * 4); sum += v[e][0] + v[e][1] + v[e][2] + v[e][3]; }
            sum += dppf(sum, 0); sum += dppf(sum, 1); sum += shx(sum, lane, 4);
            const float mean = sum * (1.0f / 128.0f);
            float sq = 0.f;
#pragma unroll
            for (int e = 0; e < 4; ++e) { v[e] = v[e] - mean; sq += v[e][0] * v[e][0] + v[e][1] * v[e][1] + v[e][2] * v[e][2] + v[e][3] * v[e][3]; }
            sq += dppf(sq, 0); sq += dppf(sq, 1); sq += shx(sq, lane, 4);
            const float rs = rsqrtf(sq * (1.0f / 128.0f) + EPS);
            bf16_t* yp = (bf16_t*)(ws + WS_YCAT) + (size_t)t * 3072 + ncol;
            f32x4 sg4[4];
            sg4[0][0] = blo(sgp[0].x); sg4[0][1] = bhi(sgp[0].x); sg4[0][2] = blo(sgp[0].y); sg4[0][3] = bhi(sgp[0].y);
            sg4[1][0] = blo(sgp[0].z); sg4[1][1] = bhi(sgp[0].z); sg4[1][2] = blo(sgp[0].w); sg4[1][3] = bhi(sgp[0].w);
            sg4[2][0] = blo(sgp[1].x); sg4[2][1] = bhi(sgp[1].x); sg4[2][2] = blo(sgp[1].y); sg4[2][3] = bhi(sgp[1].y);
            sg4[3][0] = blo(sgp[1].z); sg4[3][1] = bhi(sgp[1].z); sg4[3][2] = blo(sgp[1].w); sg4[3][3] = bhi(sgp[1].w);
            store8bf(yp, v[0] * rs * gv4[0] * sg4[0], v[1] * rs * gv4[1] * sg4[1]);
            store8bf(yp + 8, v[2] * rs * gv4[2] * sg4[2], v[3] * rs * gv4[3] * sg4[3]);
        }
    }
#undef RET_LOAD
    if (!OUT) {
        float* tp = tot + (size_t)item * 16384;
#pragma unroll
        for (int nf = 0; nf < 8; ++nf)
#pragma unroll
            for (int j = 0; j < 4; ++j) tp[(16 * wid + 4 * fq + j) * 128 + 16 * nf + fr] = sacc[nf][j];
    }
}

__device__ void lru_item(LAS char* lds, KP p, int l, int item) {
    char* ws = p->ws;
    int tid = threadIdx.x; asm volatile("" : "+v"(tid)); const int wid = tid >> 6, lane = tid & 63, fr = lane & 15, fq = lane >> 4;
    const int nb = item & 7, np_ = (item >> 3) & 15, b = item >> 7;
    LAS bf16_t* Xs = (LAS bf16_t*)(lds);
    LAS float* Xf = (LAS float*)(lds + 17408);
    LAS bf16_t* Wa = (LAS bf16_t*)(lds + 50176);
    LAS bf16_t* Wx = (LAS bf16_t*)(lds + 84992);
    LAS bf16_t* Oa = (LAS bf16_t*)(lds);
    LAS float* Bs_ = Xf;
    LAS float* Cq = (LAS float*)(lds + 119808);
    const bf16_t* proj = (const bf16_t*)(ws + WS_PROJ);
    const bf16_t* wat = (const bf16_t*)(ws + WS_WA) + (size_t)(l * 8 + nb) * 16384;
    const bf16_t* wxt = (const bf16_t*)(ws + WS_WX) + (size_t)(l * 8 + nb) * 16384;
    float pba[4], pbx[4], plam[4];
#pragma unroll
    for (int nf = 0; nf < 4; ++nf) { const int ch_ = l * 1024 + nb * 128 + 64 * (wid >> 2) + 16 * nf + fr; pba[nf] = p->in[12][ch_]; pbx[nf] = p->in[14][ch_]; plam[nf] = p->in[15][ch_]; }
    __syncthreads();
    {
        u32x4 wa4[4], wx4[4];
#pragma unroll
        for (int r = 0; r < 4; ++r) { const int q = tid + 512 * r, d = q >> 4, c8 = (q & 15) * 8; wa4[r] = *(const u32x4*)(wat + d * 128 + c8); wx4[r] = *(const u32x4*)(wxt + d * 128 + c8); }
#pragma unroll
        for (int r = 0; r < 4; ++r) { const int q = tid + 512 * r, d = q >> 4, c8 = (q & 15) * 8; *(LAS u32x4*)(Wa + d * 136 + c8) = wa4[r]; *(LAS u32x4*)(Wx + d * 136 + c8) = wx4[r]; }
    }
  for (int cc_ = 0; cc_ < 2; ++cc_) {
    const int n = np_ * 2 + cc_, t0 = b * 2048 + n * 64, s0 = n * 64;
    __syncthreads();
#pragma unroll
    for (int r = 0; r < 2; ++r) {
        const int q = tid + 512 * r, i = q >> 4, c8 = (q & 15) * 8, ch = nb * 128 + c8;
        f32x4 x0 = *(const f32x4*)(p->in[10] + (size_t)l * 1024 + ch), x1 = *(const f32x4*)(p->in[10] + (size_t)l * 1024 + ch + 4);
        u32x4 xv4[4]; f32x4 w04[4], w14[4];
#pragma unroll
        for (int k = 0; k < 4; ++k) {
            const int sk = s0 + i - 3 + k, tk = sk >= 0 ? (t0 + i - 3 + k) : t0;
            xv4[k] = *(const u32x4*)(proj + (size_t)tk * LDP + 4096 + ch);
            w04[k] = *(const f32x4*)(p->in[9] + (size_t)(l * 4 + k) * 1024 + ch); w14[k] = *(const f32x4*)(p->in[9] + (size_t)(l * 4 + k) * 1024 + ch + 4);
        }
#pragma unroll
        for (int k = 0; k < 4; ++k) {
            const float mk = (s0 + i - 3 + k >= 0) ? 1.0f : 0.0f;
            const f32x4 w0 = w04[k] * mk, w1 = w14[k] * mk; const u32x4 xv = xv4[k];
            x0[0] += w0[0] * blo(xv[0]); x0[1] += w0[1] * bhi(xv[0]); x0[2] += w0[2] * blo(xv[1]); x0[3] += w0[3] * bhi(xv[1]);
            x1[0] += w1[0] * blo(xv[2]); x1[1] += w1[1] * bhi(xv[2]); x1[2] += w1[2] * blo(xv[3]); x1[3] += w1[3] * bhi(xv[3]);
        }
        u32x4 o; o.x = pk2(x0[0], x0[1]); o.y = pk2(x0[2], x0[3]); o.z = pk2(x1[0], x1[1]); o.w = pk2(x1[2], x1[3]);
        *(LAS u32x4*)(Xs + i * 136 + c8) = o;
        *(LAS f32x4*)(Xf + i * 128 + c8) = x0; *(LAS f32x4*)(Xf + i * 128 + c8 + 4) = x1;
    }
    __syncthreads();
    const int mf = wid & 3, nh = wid >> 2;
    f32x4 accA[4], accX[4];
#pragma unroll
    for (int nf = 0; nf < 4; ++nf) { accA[nf] = (f32x4){0.f, 0.f, 0.f, 0.f}; accX[nf] = (f32x4){0.f, 0.f, 0.f, 0.f}; }
    __builtin_amdgcn_sched_barrier(0);
#pragma unroll
    for (int half = 0; half < 2; ++half) {
        bf16x8 xa[2], wa_[2][4], wx_[2][4];
#pragma unroll
        for (int kk = 0; kk < 2; ++kk) {
            const int k0 = (half * 2 + kk) * 32;
            xa[kk] = *(const LAS bf16x8*)(Xs + (16 * mf + fr) * 136 + k0 + fq * 8);
#pragma unroll
            for (int nf = 0; nf < 4; ++nf) {
                wa_[kk][nf] = *(const LAS bf16x8*)(Wa + (64 * nh + 16 * nf + fr) * 136 + k0 + fq * 8);
                wx_[kk][nf] = *(const LAS bf16x8*)(Wx + (64 * nh + 16 * nf + fr) * 136 + k0 + fq * 8);
            }
        }
#pragma unroll
        for (int kk = 0; kk < 2; ++kk)
#pragma unroll
            for (int nf = 0; nf < 4; ++nf) { accA[nf] = MFMA16(xa[kk], wa_[kk][nf], accA[nf]); accX[nf] = MFMA16(xa[kk], wx_[kk][nf], accX[nf]); }
        __builtin_amdgcn_sched_group_barrier(0x100, 18, 0); __builtin_amdgcn_sched_group_barrier(0x008, 16, 0);
        __builtin_amdgcn_sched_barrier(0);
    }
    __syncthreads();
#pragma unroll
    for (int nf = 0; nf < 4; ++nf) {
        const int d = 64 * nh + 16 * nf + fr;
        const float ba = pba[nf], bx = pbx[nf], lam = plam[nf];
        const float em = __expf(-fabsf(lam));
        const float l1p = em < 0.01f ? em * (1.0f - em * (0.5f - em * 0.33333334f)) : __logf(1.0f + em);
        const float sp = fmaxf(-lam, 0.0f) + l1p;
#pragma unroll
        for (int j = 0; j < 4; ++j) {
            const int i = 16 * mf + 4 * fq + j;
            const float r = sigmoidf_(accA[nf][j] + ba), ig = sigmoidf_(accX[nf][j] + bx);
            const float la = -8.0f * r * sp;
            Oa[i * 128 + d] = f2bf(la > -0.05f ? -la * (1.0f + la * (0.5f + la * (0.16666667f + la * 0.041666668f))) : 1.0f - __expf(la));
            const float x2 = 2.0f * la;
            const float om = x2 > -0.1f ? -x2 * (1.0f + x2 * (0.5f + x2 * (0.16666667f + x2 * 0.041666668f))) : 1.0f - __expf(x2);
            Bs_[i * 128 + d] = sqrtf(om) * (ig * Xf[i * 128 + d]);
        }
    }
    __syncthreads();
    {
        const int d = tid & 127, q = tid >> 7;
        float h = 0.f, A = 1.f;
#pragma unroll 4
        for (int ii = 0; ii < 16; ++ii) { const int i = 16 * q + ii; const float a = 1.0f - bf2f(Oa[i * 128 + d]); h = a * h + Bs_[i * 128 + d]; A *= a; }
        Cq[(q * 128 + d) * 2] = A; Cq[(q * 128 + d) * 2 + 1] = h;
        __syncthreads();
        float hin = 0.f, Ain = 1.f;
        for (int qq = 0; qq < q; ++qq) { const float Aq = Cq[(qq * 128 + d) * 2], hq = Cq[(qq * 128 + d) * 2 + 1]; hin = Aq * hin + hq; Ain *= Aq; }
        h = hin; A = Ain;
        bf16_t* hl = (bf16_t*)(ws + WS_HLOC) + (size_t)t0 * 1024 + nb * 128 + d;
        bf16_t* ac = (bf16_t*)(ws + WS_ACUM) + (size_t)t0 * 1024 + nb * 128 + d;
#pragma unroll 4
        for (int ii = 0; ii < 16; ++ii) {
            const int i = 16 * q + ii; const float a = 1.0f - bf2f(Oa[i * 128 + d]); h = a * h + Bs_[i * 128 + d]; A *= a;
            hl[(size_t)i * 1024] = f2bf(h); ac[(size_t)i * 1024] = f2bf(A);
        }
        if (q == 3) {
            float* lt = (float*)(ws + WS_LTOT) + (size_t)(b * 32 + n) * 1024 + nb * 128 + d;
            lt[0] = A; lt[(size_t)128 * 1024] = h;
        }
    }
  }
}

__device__ void lru_out_item(KP p, int item) {
    char* ws = p->ws;
    int tid = threadIdx.x; asm volatile("" : "+v"(tid));
    const int n = item & 31, b = item >> 5, t0 = b * 2048 + n * 64, ch = tid * 2;
    const bf16_t* hl = (const bf16_t*)(ws + WS_HLOC); const bf16_t* ac = (const bf16_t*)(ws + WS_ACUM);
    const float* lt = (const float*)(ws + WS_LTOT);
    const bf16_t* proj = (const bf16_t*)(ws + WS_PROJ);
    bf16_t* ycat = (bf16_t*)(ws + WS_YCAT);
    f32x2 carry = (f32x2){0.f, 0.f};
    for (int m0 = 0; m0 < n; m0 += 8) {
        f32x2 A2[8], H2[8];
#pragma unroll
        for (int u = 0; u < 8; ++u) {
            const int m = (m0 + u < n) ? (m0 + u) : (n - 1);
            const size_t tl = (size_t)(b * 32 + m) * 1024 + ch;
            A2[u] = *(const f32x2*)(lt + tl); H2[u] = *(const f32x2*)(lt + (size_t)128 * 1024 + tl);
        }
#pragma unroll
        for (int u = 0; u < 8; ++u) if (m0 + u < n) carry = A2[u] * carry + H2[u];
    }
    for (int i0 = 0; i0 < 64; i0 += 8) {
        unsigned h2[8], a2[8], gw[8];
#pragma unroll
        for (int u = 0; u < 8; ++u) {
            const size_t t = t0 + i0 + u;
            h2[u] = *(const unsigned*)(hl + t * 1024 + ch); a2[u] = *(const unsigned*)(ac + t * 1024 + ch);
            gw[u] = *(const unsigned*)(proj + t * LDP + 5120 + ch);
        }
#pragma unroll
        for (int u = 0; u < 8; ++u) {
            const size_t t = t0 + i0 + u;
            const float y0 = blo(h2[u]) + blo(a2[u]) * carry.x, y1 = bhi(h2[u]) + bhi(a2[u]) * carry.y;
            *(unsigned*)(ycat + t * 3072 + 1024 + ch) = pk2(y0 * blo(gw[u]), y1 * bhi(gw[u]));
        }
    }
}

__device__ void attn_item(LAS char* lds, KP p, int b, int h, int Pp) {
    char* ws = p->ws;
    int tid = threadIdx.x; asm volatile("" : "+v"(tid)); const int wid = tid >> 6, lane = tid & 63, fr = lane & 15, fq = lane >> 4;
    LAS bf16_t* Pw = (LAS bf16_t*)(lds + 81920 + wid * 4608);
    const bf16_t* qm = (const bf16_t*)(ws + WS_QM);
    const bf16_t* kn = (const bf16_t*)(ws + WS_KN) + (size_t)(b * 8 + h) * 2048 * 128;
    const bf16_t* kr = (const bf16_t*)(ws + WS_KROPE) + (size_t)b * 2048 * 64;
    const bf16_t* vt = (const bf16_t*)(ws + WS_VT) + (size_t)(b * 8 + h) * 128 * 2048;
    const int s0 = Pp * 256 + wid * 32, nkt = 4 * Pp + 4, qc = 4 * Pp + (wid >> 1);
    bf16x8 qf[2][6];
#pragma unroll
    for (int mi = 0; mi < 2; ++mi)
#pragma unroll
        for (int ks = 0; ks < 6; ++ks) qf[mi][ks] = *(const bf16x8*)(qm + ((size_t)((b * 8 + h) * 2048 + s0 + 16 * mi + fr)) * 192 + ks * 32 + fq * 8);
    f32x4 o[2][8];
#pragma unroll
    for (int mi = 0; mi < 2; ++mi)
#pragma unroll
        for (int nd = 0; nd < 8; ++nd) o[mi][nd] = (f32x4){0.f, 0.f, 0.f, 0.f};
    float mrow[2][4], lsum[2][4];
#pragma unroll
    for (int mi = 0; mi < 2; ++mi)
#pragma unroll
        for (int j = 0; j < 4; ++j) { mrow[mi][j] = -1e30f; lsum[mi][j] = 0.f; }
    const bf16_t* ksrc[3]; int kstep[3];
#pragma unroll
    for (int r = 0; r < 3; ++r) {
        const int q = tid + 512 * r, row = q / 24, pc = q - row * 24, lc = pc ^ ((row >> 1) & 7);
        if (lc < 16) { ksrc[r] = kn + (size_t)row * 128 + lc * 8; kstep[r] = 64 * 128; } else { ksrc[r] = kr + (size_t)row * 64 + (lc - 16) * 8; kstep[r] = 64 * 64; }
    }
    const bf16_t* vsrc[2];
#pragma unroll
    for (int r = 0; r < 2; ++r) { const int q = tid + 512 * r, d = q >> 3, pc = q & 7; vsrc[r] = vt + (size_t)d * 2048 + ((pc ^ ((d >> 1) & 7)) * 8); }
    const int ldsw = wid * 1024;
#define ATT_STAGE(kt, buf) do { _Pragma("unroll") for (int r_ = 0; r_ < 3; ++r_) \
        __builtin_amdgcn_global_load_lds((const unsigned*)(ksrc[r_] + (size_t)(kt) * kstep[r_]), (LAS unsigned*)(lds + (buf) * 24576 + ldsw + r_ * 8192), 16, 0, 0); \
      _Pragma("unroll") for (int r_ = 0; r_ < 2; ++r_) \
        __builtin_amdgcn_global_load_lds((const unsigned*)(vsrc[r_] + (kt) * 64), (LAS unsigned*)(lds + 49152 + (buf) * 16384 + ldsw + r_ * 8192), 16, 0, 0); } while (0)
    const int f7 = (fr >> 1) & 7, xq = fq ^ (f7 & 3), yq = f7 >> 2;
    const int ka0 = fr * 384 + xq * 16 + yq * 64, ka1 = fr * 384 + xq * 16 + (1 - yq) * 64;
    const int va0 = fr * 128 + xq * 16 + yq * 64, va1 = fr * 128 + xq * 16 + (1 - yq) * 64;
    __syncthreads();
    ATT_STAGE(0, 0); WAIT_V0(); __syncthreads();
    for (int kt = 0; kt < nkt; ++kt) {
        const int cur = kt & 1;
        if (kt + 1 < nkt) ATT_STAGE(kt + 1, cur ^ 1);
        if (kt <= qc) {
            const LAS char* Kb = (const LAS char*)(lds + cur * 24576);
            const LAS char* Vb = (const LAS char*)(lds + 49152 + cur * 16384);
            f32x4 s[2][4];
#pragma unroll
            for (int mi = 0; mi < 2; ++mi)
#pragma unroll
                for (int n = 0; n < 4; ++n) s[mi][n] = (f32x4){0.f, 0.f, 0.f, 0.f};
            __builtin_amdgcn_sched_barrier(0);
            __builtin_amdgcn_s_setprio(1);
            {
                bf16x8 kf[6][4];
#pragma unroll
                for (int ks = 0; ks < 6; ++ks)
#pragma unroll
                    for (int n = 0; n < 4; ++n) kf[ks][n] = *(const LAS bf16x8*)(Kb + ((ks & 1) ? ka1 : ka0) + n * 6144 + (ks >> 1) * 128);
#pragma unroll
                for (int ks = 0; ks < 6; ++ks)
#pragma unroll
                    for (int n = 0; n < 4; ++n) { s[0][n] = MFMA16(qf[0][ks], kf[ks][n], s[0][n]); s[1][n] = MFMA16(qf[1][ks], kf[ks][n], s[1][n]); }
                __builtin_amdgcn_sched_group_barrier(0x100, 8, 0);
                __builtin_amdgcn_sched_group_barrier(0x008, 8, 0); __builtin_amdgcn_sched_group_barrier(0x100, 4, 0);
                __builtin_amdgcn_sched_group_barrier(0x008, 8, 0); __builtin_amdgcn_sched_group_barrier(0x100, 4, 0);
                __builtin_amdgcn_sched_group_barrier(0x008, 8, 0); __builtin_amdgcn_sched_group_barrier(0x100, 4, 0);
                __builtin_amdgcn_sched_group_barrier(0x008, 8, 0); __builtin_amdgcn_sched_group_barrier(0x100, 4, 0);
                __builtin_amdgcn_sched_group_barrier(0x008, 16, 0);
            }
            __builtin_amdgcn_s_setprio(0);
            __builtin_amdgcn_sched_barrier(0);
#pragma unroll
            for (int mi = 0; mi < 2; ++mi)
#pragma unroll
                for (int j = 0; j < 4; ++j) {
                    float mx = fmaxf(fmaxf(s[mi][0][j], s[mi][1][j]), fmaxf(s[mi][2][j], s[mi][3][j]));
                    mx = row16_max(mx);
                    const float mnew = fmaxf(mrow[mi][j], mx);
                    if (__builtin_amdgcn_ballot_w64(mnew != mrow[mi][j]) != 0ull) {
                        const float alpha = __builtin_amdgcn_exp2f(mrow[mi][j] - mnew);
                        mrow[mi][j] = mnew; lsum[mi][j] *= alpha;
#pragma unroll
                        for (int nd = 0; nd < 8; ++nd) o[mi][nd][j] *= alpha;
                    }
#pragma unroll
                    for (int n = 0; n < 4; ++n) { const float pe = __builtin_amdgcn_exp2f(s[mi][n][j] - mnew); lsum[mi][j] += pe; Pw[(16 * mi + 4 * fq + j) * 72 + n * 16 + fr] = (bf16_t)pk2(pe, 0.f); }
                }
            WAIT_L0(); __builtin_amdgcn_wave_barrier();
            __builtin_amdgcn_sched_barrier(0);
            __builtin_amdgcn_s_setprio(1);
            {
                bf16x8 pa[2][2], vb[2][8];
#pragma unroll
                for (int ks2 = 0; ks2 < 2; ++ks2)
#pragma unroll
                    for (int mi = 0; mi < 2; ++mi) pa[mi][ks2] = *(const LAS bf16x8*)(Pw + (16 * mi + fr) * 72 + ks2 * 32 + fq * 8);
#pragma unroll
                for (int ks2 = 0; ks2 < 2; ++ks2)
#pragma unroll
                    for (int nd = 0; nd < 8; ++nd) vb[ks2][nd] = *(const LAS bf16x8*)(Vb + (ks2 ? va1 : va0) + nd * 2048);
#pragma unroll
                for (int ks2 = 0; ks2 < 2; ++ks2)
#pragma unroll
                    for (int nd = 0; nd < 8; ++nd) { o[0][nd] = MFMA16(pa[0][ks2], vb[ks2][nd], o[0][nd]); o[1][nd] = MFMA16(pa[1][ks2], vb[ks2][nd], o[1][nd]); }
                __builtin_amdgcn_sched_group_barrier(0x100, 12, 0);
                __builtin_amdgcn_sched_group_barrier(0x008, 4, 0); __builtin_amdgcn_sched_group_barrier(0x100, 2, 0);
                __builtin_amdgcn_sched_group_barrier(0x008, 4, 0); __builtin_amdgcn_sched_group_barrier(0x100, 2, 0);
                __builtin_amdgcn_sched_group_barrier(0x008, 4, 0); __builtin_amdgcn_sched_group_barrier(0x100, 2, 0);
                __builtin_amdgcn_sched_group_barrier(0x008, 4, 0); __builtin_amdgcn_sched_group_barrier(0x100, 2, 0);
                __builtin_amdgcn_sched_group_barrier(0x008, 16, 0);
            }
            __builtin_amdgcn_s_setprio(0);
            __builtin_amdgcn_sched_barrier(0);
        }
        WAIT_V0(); __syncthreads();
    }
#undef ATT_STAGE
    const bf16_t* proj = (const bf16_t*)(ws + WS_PROJ);
    bf16_t* ycat = (bf16_t*)(ws + WS_YCAT);
    LAS bf16_t* Ow = (LAS bf16_t*)(lds + wid * 8704);
#pragma unroll
    for (int mi = 0; mi < 2; ++mi)
#pragma unroll
        for (int j = 0; j < 4; ++j) {
            const float ls = row16_sum(lsum[mi][j]);
            const float inv = 1.0f / ls;
#pragma unroll
            for (int nd = 0; nd < 8; ++nd) Ow[(16 * mi + 4 * fq + j) * 136 + nd * 16 + fr] = f2bf(o[mi][nd][j] * inv);
        }
    WAIT_L0(); __builtin_amdgcn_wave_barrier();
#pragma unroll
    for (int r = 0; r < 8; ++r) {
        const int q = lane + 64 * r, row = q >> 4, c8 = (q & 15) * 8;
        const size_t t = (size_t)b * 2048 + s0 + row;
        const u32x4 ov = *(const LAS u32x4*)(Ow + row * 136 + c8);
        const u32x4 gv = *(const u32x4*)(proj + t * LDP + 7168 + h * 128 + c8);
        u32x4 y;
#pragma unroll
        for (int e = 0; e < 4; ++e) y[e] = pk2(blo(ov[e]) * blo(gv[e]), bhi(ov[e]) * bhi(gv[e]));
        *(u32x4*)(ycat + t * 3072 + 2048 + h * 128 + c8) = y;
    }
}

#define XB_TMO      128
#define XB_XCNT(j)  (256  + 64 * (j))
#define XB_XSUB(j)  (1280 + 64 * (j))
#define XB_XGEN(j)  (2304 + 64 * (j))
#define XB_TOP      3328
#define XB_TOPGEN   3392
#define XCD_BAR_WORDS 3456
#define XB_SPIN_CAP (1u << 18)
__device__ __forceinline__ unsigned xb_ld(unsigned* p)              { return __hip_atomic_load(p, __ATOMIC_RELAXED, __HIP_MEMORY_SCOPE_AGENT); }
__device__ __forceinline__ unsigned xb_add(unsigned* p, unsigned v) { return __hip_atomic_fetch_add(p, v, __ATOMIC_RELAXED, __HIP_MEMORY_SCOPE_AGENT); }
__device__ __forceinline__ unsigned xb_xcc_id() { return (unsigned)__builtin_amdgcn_s_getreg((3 << 11) | 20) & 0xFu; }
#define XB_SPIN(cond, bar) do { unsigned _sp = 0; while (cond) { __builtin_amdgcn_s_sleep(1); \
    if ((++_sp & 255u) == 0u) { if (xb_ld(&(bar)[XB_TMO])) break; if (_sp > XB_SPIN_CAP) { atomicAdd(&(bar)[XB_TMO], 1u); break; } } } } while (0)
struct XcdBarrier { unsigned* bar; unsigned x; volatile LAS unsigned* st; };
__device__ __forceinline__ XcdBarrier xcd_barrier_post(unsigned* bar, volatile LAS unsigned* st) {
    XcdBarrier b; b.bar = bar; b.x = xb_xcc_id(); b.st = st;
    if (threadIdx.x == 0) (void)xb_add(&bar[XB_XCNT(b.x)], 1u);
    return b;
}
__device__ __forceinline__ void xcd_barrier_complete(unsigned* bar, unsigned x, unsigned& nloc, unsigned& nx) {
    const unsigned G = gridDim.x * gridDim.y * gridDim.z;
    unsigned sum, cnt, mine, sp = 0u;
    for (;;) {
        sum = 0u; cnt = 0u; mine = 0u;
#pragma unroll
        for (unsigned j = 0; j < 16; ++j) { const unsigned c = xb_ld(&bar[XB_XCNT(j)]); sum += c; cnt += (c > 0u) ? 1u : 0u; mine = (j == x) ? c : mine; }
        if (sum == G) break;
        __builtin_amdgcn_s_sleep(1);
        if ((++sp & 255u) == 0u) { if (xb_ld(&bar[XB_TMO])) break; if (sp > XB_SPIN_CAP) { atomicAdd(&bar[XB_TMO], 1u); break; } }
    }
    nloc = mine > 0u ? mine : 1u; nx = cnt > 0u ? cnt : 1u;
}
__device__ __forceinline__ void xcd_barrier(const XcdBarrier& b) {
    asm volatile("s_waitcnt vmcnt(0)" ::: "memory");
    __syncthreads();
    if (threadIdx.x == 0) {
        unsigned* bar = b.bar; asm volatile("" : "+s"(bar));
        __builtin_amdgcn_s_waitcnt(0);
        unsigned nloc = b.st[0], nx = b.st[1];
        if (nloc == 0u) { xcd_barrier_complete(bar, b.x, nloc, nx); b.st[0] = nloc; b.st[1] = nx; }
        const unsigned old = xb_add(&bar[XB_XSUB(b.x)], 1u);
        const unsigned gen = old / nloc;
        if (old + 1u == (gen + 1u) * nloc) {
            __builtin_amdgcn_fence(__ATOMIC_RELEASE, "agent");
            asm volatile("s_waitcnt vmcnt(0)" ::: "memory");
            const unsigned og = xb_add(&bar[XB_TOP], 1u);
            const unsigned tg = og / nx;
            if (og + 1u == (tg + 1u) * nx) xb_add(&bar[XB_TOPGEN], 1u);
            else XB_SPIN(xb_ld(&bar[XB_TOPGEN]) == tg, bar);
            __builtin_amdgcn_fence(__ATOMIC_ACQUIRE, "agent");
            xb_add(&bar[XB_XGEN(b.x)], 1u);
            asm volatile("s_waitcnt vmcnt(0)" ::: "memory");
        } else {
            XB_SPIN(xb_ld(&bar[XB_XGEN(b.x)]) == gen, bar);
            __builtin_amdgcn_fence(__ATOMIC_ACQUIRE, "agent");
            asm volatile("s_waitcnt vmcnt(0)" ::: "memory");
        }
    }
    __syncthreads();
}

#define Q_BEGIN(ctrp) unsigned* qctr_ = (ctrp); volatile LAS int* qslot_ = (volatile LAS int*)(lds + 131072 + 8); int qnxt_ = 0
#define Q_ISSUE() do { int r_ = 0; if (threadIdx.x == 0) r_ = (int)__hip_atomic_fetch_add(qctr_, 1u, __ATOMIC_RELAXED, __HIP_MEMORY_SCOPE_AGENT); qnxt_ = r_; } while (0)
#define Q_TAKE(it) do { __syncthreads(); if (threadIdx.x == 0) *qslot_ = G + qnxt_; __syncthreads(); (it) = *qslot_; } while (0)

__global__ void __launch_bounds__(512) fwd_megakernel(Params parg) {
    __shared__ __attribute__((aligned(1024))) char shm[131072 + 16];
    LAS char* lds = (LAS char*)shm;
    const int G = gridDim.x, c = blockIdx.x;
    volatile LAS unsigned* xst = (volatile LAS unsigned*)(lds + 131072);
    unsigned* xbar = (unsigned*)(parg.ws + WS_BAR);
    if (threadIdx.x == 0) { xst[0] = 0u; xst[1] = 0u; }
    __syncthreads();
    XcdBarrier xb = xcd_barrier_post(xbar, xst);
    if (parg.ph_lo > 1000) cg::this_grid().sync();
#define GRID_SYNC() xcd_barrier(xb)
    for (int ph = parg.ph_lo; ph < parg.ph_hi; ++ph) {
      const int ptype = ph < 2 ? ph : 2 + (ph - 2) % 6;
      const int nrep = 1 + ((REPMASK >> ptype) & 1);
      for (int rep = 0; rep < nrep; ++rep) {
        if (rep) GRID_SYNC();
        const bool skip_epi = VAR_NOEPI && (rep + 1 < nrep);
        KP p = get_kp();
        char* ws = p->ws;
        if (ph == 0) {
            if (PMASK & 1) phase0(lds, p);
        } else if (ph == 1) {
            if (PMASK & 2) rowpass(p, -1);
        } else {
            const int l = (ph - 2) / 6, sub = (ph - 2) % 6;
            if (sub == 0 && (PMASK & 4)) {
                const bf16_t* A = (const bf16_t*)(ws + WS_HBUF);
                const bf16_t* Bt = (const bf16_t*)(ws + WS_WI) + (size_t)l * NP1 * 2048;
                for (int L = c; L < 32 * 56; L += G) {
                    int pm, pn; tile_map(L, 32, 56, pm, pn);
                    f32x4 acc[8][4];
                    gemm256(lds, A + (size_t)pm * 256 * 2048, 2048, Bt + (size_t)pn * 256 * 2048, 2048, 2048, acc);
                    OPAQUE_WS(wx); EPI_IDS;
                    EpiProj e{(bf16_t*)(wx + WS_PROJ), (bf16_t*)(wx + WS_KROPE), (float*)(wx + WS_RSQ), (const float*)(wx + WS_COSR), (const float*)(wx + WS_SINR),
                              (const float*)(wx + WS_COSM), (const float*)(wx + WS_SINM), pm * 256, pn * 256};
                    if (!skip_epi) e(acc, wr_, wc_, fr_, fq_);
                }
            } else if (sub == 1 && (PMASK & 8)) {
                Q_BEGIN(xbar + 3520 + (ph * 2 + rep) * 8);
                const int nP2 = 32 + 192 + 256 + 256 + 512 + (l + 1 < DEPTH ? 648 : 0);
                for (int it = c; it < nP2;) {
                    KP p = get_kp(); char* ws = p->ws;
                    if (it >= 480) Q_ISSUE();
                    if (it < 32) {
                        const int pm = it;
                        f32x4 acc[8][4];
                        gemm256(lds, (const bf16_t*)(ws + WS_HBUF) + (size_t)pm * 256 * 2048, 2048, (const bf16_t*)(ws + WS_WI) + (size_t)l * NP1 * 2048 + (size_t)14336 * 2048, 2048, 2048, acc);
                        Q_ISSUE();
                        OPAQUE_WS(wx); EPI_IDS;
                        EpiProj e{(bf16_t*)(wx + WS_PROJ), (bf16_t*)(wx + WS_KROPE), (float*)(wx + WS_RSQ), (const float*)(wx + WS_COSR), (const float*)(wx + WS_SINR),
                                  (const float*)(wx + WS_COSM), (const float*)(wx + WS_SINM), pm * 256, 14336};
                        if (!skip_epi) e(acc, wr_, wc_, fr_, fq_);
                    } else if (it < 224) {
                        const int i2 = it - 32, pm = i2 & 31, pn = i2 >> 5;
                        f32x4 acc[8][4];
                        gemm256(lds, (const bf16_t*)(ws + WS_PROJ) + (size_t)pm * 256 * LDP + 6144, LDP, (const bf16_t*)(ws + WS_WUQ) + (size_t)l * 1536 * 512 + (size_t)pn * 256 * 512, 512, 512, acc);
                        Q_ISSUE();
                        OPAQUE_WS(wx); EPI_IDS;
                        EpiQ e{(bf16_t*)(wx + WS_QM), (const float*)(wx + WS_RSQ), (const float*)(wx + WS_COSM), (const float*)(wx + WS_SINM), pm * 256, pn * 256};
                        if (!skip_epi) e(acc, wr_, wc_, fr_, fq_);
                    } else if (it < 480) {
                        const int i2 = it - 224, pm = i2 & 31, pn = i2 >> 5;
                        f32x4 acc[8][4];
                        gemm256(lds, (const bf16_t*)(ws + WS_PROJ) + (size_t)pm * 256 * LDP + 6656, LDP, (const bf16_t*)(ws + WS_WUKV) + (size_t)l * 2048 * 512 + (size_t)pn * 256 * 512, 512, 512, acc);
                        Q_ISSUE();
                        OPAQUE_WS(wx); EPI_IDS;
                        EpiKV e{(bf16_t*)(wx + WS_KN), (bf16_t*)(wx + WS_VT), (const float*)(wx + WS_RSQ), pm * 256, pn};
                        if (!skip_epi) e(acc, wr_, wc_, fr_, fq_);
                    } else if (it < 736) {
                        ret_item<false>(lds, p, l, it - 480);
                    } else if (it < 1248) {
                        lru_item(lds, p, l, it - 736);
                    } else {
                        conv2(lds, p, (l + 1) * 2592 + (it - 1248) * 2);
                    }
                    Q_TAKE(it);
                }
            } else if (sub == 2 && (PMASK & 16)) {
                Q_BEGIN(xbar + 3520 + (ph * 2 + rep) * 8);
                const int nP3 = 256 + 256 + 128 + (l + 1 < DEPTH ? 648 : 0);
                for (int it = c; it < nP3;) {
                    KP p = get_kp();
                    Q_ISSUE();
                    if (it < 256) {
                        const int bh = it & 31, Pp = 7 - (it >> 5);
                        attn_item(lds, p, bh >> 3, bh & 7, Pp);
                    } else if (it < 512) {
                        ret_item<true>(lds, p, l, it - 256);
                    } else if (it < 640) {
                        lru_out_item(p, it - 512);
                    } else {
                        conv2(lds, p, (l + 1) * 2592 + 1296 + (it - 640) * 2);
                    }
                    Q_TAKE(it);
                }
            } else if (sub == 3 && (PMASK & 32)) {
                for (int L = c; L < 256; L += G) {
                    int pm, pn; tile_map(L, 32, 8, pm, pn);
                    f32x4 acc[8][4];
#pragma unroll
                    for (int m_ = 0; m_ < 8; ++m_)
#pragma unroll
                        for (int n_ = 0; n_ < 4; ++n_) acc[m_][n_] = (f32x4){0.f, 0.f, 0.f, 0.f};
#pragma unroll 1
                    for (int i = 0; i < 3; ++i) {
                        gemm256(lds, (const bf16_t*)(ws + WS_YCAT) + (size_t)pm * 256 * 3072 + i * 1024, 3072,
                                (const bf16_t*)(ws + WS_WB) + (size_t)l * 2048 * 3072 + (size_t)pn * 256 * 3072 + i * 1024, 3072, 1024, acc, false);
                        OPAQUE_WS(wx); EPI_IDS;
                        EpiBranch e{(const bf16_t*)(wx + WS_PROJ) + 8192, (bf16_t*)(wx + WS_MERGED), i, pm * 256, pn * 256};
                        if (!skip_epi || i < 2) e(acc, wr_, wc_, fr_, fq_);
                    }
                }
            } else if (sub == 4 && (PMASK & 64)) {
                for (int L = c; L < 256; L += G) {
                    int pm, pn; tile_map(L, 32, 8, pm, pn);
                    f32x4 acc[8][4];
                    gemm256(lds, (const bf16_t*)(ws + WS_MERGED) + (size_t)pm * 256 * 2048, 2048, (const bf16_t*)(ws + WS_WO) + (size_t)l * 2048 * 2048 + (size_t)pn * 256 * 2048, 2048, 2048, acc);
                    OPAQUE_WS(wx); EPI_IDS;
                    EpiOut e{(bf16_t*)(wx + WS_YBUF), pm * 256, pn * 256};
                    if (!skip_epi) e(acc, wr_, wc_, fr_, fq_);
                }
            } else if (sub == 5 && (PMASK & 128)) {
                rowpass(p, l);
            }
        }
      }
        if (ph + 1 < parg.ph_hi) GRID_SYNC();
    }
}

extern "C" void kernel_launch(void* const* d_in, const int* in_sizes, int n_in, void* d_out, int out_size, void* d_ws, size_t ws_size, hipStream_t stream) {
    static int grid_blocks = 0;
    if (!grid_blocks) {
        int dev = 0, cus = 0, per_cu = 0;
        hipGetDevice(&dev);
        hipDeviceGetAttribute(&cus, hipDeviceAttributeMultiprocessorCount, dev);
        hipOccupancyMaxActiveBlocksPerMultiprocessor(&per_cu, fwd_megakernel, 512, 0);
        if (per_cu < 1) { fprintf(stderr, "kernel_launch: occupancy query returned %d\n", per_cu); per_cu = 1; }
        if (per_cu > 1) per_cu = 1;
        grid_blocks = cus * per_cu;
        if (ws_size < WS_END) fprintf(stderr, "kernel_launch: workspace too small: %zu < %zu\n", ws_size, (size_t)WS_END);
    }
    if (n_in != 22 || ws_size < WS_END) return;
    Params p{};
    for (int i = 0; i < 22; ++i) p.in[i] = (const float*)d_in[i];
    p.pos = (const int*)d_in[2];
    p.out = (float*)d_out;
    p.ws = (char*)d_ws;
    constexpr int NPH = 2 + 6 * DEPTH;
#if MULTI_LAUNCH
    for (int ph = 0; ph < NPH; ++ph) {
        p.ph_lo = ph; p.ph_hi = ph + 1;
        hipLaunchKernelGGL(fwd_megakernel, dim3(grid_blocks), dim3(512), 0, stream, p);
    }
#else
    p.ph_lo = 0; p.ph_hi = NPH;
    if (hipMemsetAsync((char*)d_ws + WS_BAR, 0, 4096 * 4, stream) != hipSuccess) { fprintf(stderr, "kernel_launch: hipMemsetAsync failed\n"); return; }
    void* args[] = {&p};
    hipError_t e = hipLaunchCooperativeKernel((void*)fwd_megakernel, dim3(grid_blocks), dim3(512), args, 0, stream);
    if (e != hipSuccess) fprintf(stderr, "cooperative launch failed: %s (grid %d)\n", hipGetErrorString(e), grid_blocks);
#endif
}
```
